# Optimizing an MI355X kernel written in HIP

```python
import math
import jax, jax.numpy as jnp
from jax import lax
import numpy as np

D_MODEL = 2048
BATCH = 2
SEQ = 4096
DEPTH = 2

GRID_W = 64
CTX_LEN = 256
EPS = 1e-6
NEG_INF = -1e30

NA_HEADS = 8
NA_HEAD_DIM = 128
NA_WIN_H = 8
NA_WIN_W = 16
NA_WIDTH = NA_HEADS * NA_HEAD_DIM
ML_HEADS = 8
ML_DK = 128
ML_DV = 128
ML_WIDTH = ML_HEADS * ML_DV
ML_CONV = 5
ML_CHUNK = 64
EVEN_IN_SIZES = (NA_WIDTH, NA_WIDTH, NA_WIDTH, 2 * ML_HEADS * ML_DK, ML_WIDTH, ML_WIDTH, 4 * ML_HEADS)
EVEN_IN_WIDTH = sum(EVEN_IN_SIZES)

DA_HEADS = 8
DA_DIM = 128
DA_VDIM = 2 * DA_DIM
DA_QK_WIDTH = DA_HEADS * 2 * DA_DIM
DA_V_WIDTH = DA_HEADS * DA_VDIM
Q_BLOCK = 128
ROPE_THETA = 10000.0

N_EXPERTS = 64
N_GROUPS = 8
TOPK_GROUPS = 4
TOP_K = 6
D_EXPERT = 512
ROUTED_SCALE = 2.5

kernel_name = 'hybrid_na_mlstm_diffattn_moe_dit'


def rmsnorm(x, gain):
    x32 = x.astype(jnp.float32)
    y = x32 * lax.rsqrt(jnp.mean(x32 * x32, axis=-1, keepdims=True) + EPS)
    return (y * gain.astype(jnp.float32)).astype(x.dtype)


def modulate(h, shift, scale):
    return h * (1.0 + scale) + shift


def axial_rope_tables(seq_len, dim):
    t = jnp.arange(seq_len)
    row = (t // GRID_W).astype(jnp.float32)
    col = (t % GRID_W).astype(jnp.float32)
    n_freq = dim // 4
    inv_freq = ROPE_THETA ** (-jnp.arange(n_freq, dtype=jnp.float32) / n_freq)
    ang = jnp.concatenate([row[:, None] * inv_freq, col[:, None] * inv_freq], axis=-1)
    ang = jnp.concatenate([ang, ang], axis=-1)
    return jnp.cos(ang), jnp.sin(ang)


def apply_rope(x, cos, sin):
    x1, x2 = jnp.split(x, 2, axis=-1)
    rot = jnp.concatenate([-x2, x1], axis=-1)
    return (x.astype(jnp.float32) * cos + rot.astype(jnp.float32) * sin).astype(x.dtype)


def centred_dwconv(t, w, b):
    y = lax.conv_general_dilated(t, w[:, None, :].astype(t.dtype), window_strides=(1,), padding='SAME',
                                 dimension_numbers=('NWC', 'WIO', 'NWC'), feature_group_count=t.shape[-1])
    return y + b


def neighbourhood_attention(q, k, v, q_c, k_c, v_c, rpb):
    bsz, n_h, seq, d = q.shape
    rows = seq // GRID_W
    kh = min(NA_WIN_H, rows)
    scale = d ** -0.5
    qg = q.reshape(bsz, n_h, rows, GRID_W, d)
    kg = k.reshape(bsz, n_h, rows, GRID_W, d)
    vg = v.reshape(bsz, n_h, rows, GRID_W, d)
    r = jnp.arange(rows)
    key_rows = jnp.clip(r - kh // 2, 0, rows - kh)[:, None] + jnp.arange(kh)[None, :]
    k_blk = kg[:, :, key_rows]
    v_blk = vg[:, :, key_rows]
    cols = jnp.arange(GRID_W)
    col_start = jnp.clip(cols - NA_WIN_W // 2, 0, GRID_W - NA_WIN_W)
    col_ok = (cols[None, :] >= col_start[:, None]) & (cols[None, :] < col_start[:, None] + NA_WIN_W)
    row_idx = (key_rows - r[:, None])[:, None, :, None] + (NA_WIN_H - 1)
    col_idx = jnp.clip(cols[None, :] - cols[:, None], 1 - NA_WIN_W, NA_WIN_W - 1)[None, :, None, :] + (NA_WIN_W - 1)
    bias = rpb.astype(jnp.float32)[:, row_idx, col_idx]
    bias = jnp.where(col_ok[None, None, :, None, :], bias, NEG_INF)
    s_loc = jnp.einsum('bhrwd,bhrjcd->bhrwjc', qg, k_blk).astype(jnp.float32) * scale + bias[None]
    s_ctx = jnp.einsum('bhrwd,bhnd->bhrwn', qg, k_c).astype(jnp.float32) * scale
    n_loc = kh * GRID_W
    p = jax.nn.softmax(jnp.concatenate([s_loc.reshape(bsz, n_h, rows, GRID_W, n_loc), s_ctx], axis=-1), axis=-1)
    p = p.astype(v.dtype)
    p_loc = p[..., :n_loc].reshape(bsz, n_h, rows, GRID_W, kh, GRID_W)
    o = jnp.einsum('bhrwjc,bhrjcd->bhrwd', p_loc, v_blk) + jnp.einsum('bhrwn,bhnd->bhrwd', p[..., n_loc:], v_c)
    s_cc = jnp.einsum('bhmd,bhnd->bhmn', q_c, k_c).astype(jnp.float32) * scale
    o_c = jnp.einsum('bhmn,bhnd->bhmd', jax.nn.softmax(s_cc, axis=-1).astype(v.dtype), v_c)
    return o.reshape(bsz, n_h, seq, d), o_c


def mlstm_scan(q, k, v, log_i, log_f, state):
    bsz, n_h, seq, _ = q.shape
    n_chunks = seq // ML_CHUNK

    def to_chunks(t):
        return jnp.moveaxis(t.reshape(t.shape[:2] + (n_chunks, ML_CHUNK) + t.shape[3:]), 2, 0)

    tri = jnp.tril(jnp.ones((ML_CHUNK, ML_CHUNK), dtype=bool))

    def step(carry, inp):
        c_mat, n_vec, m = carry
        qc, kc, vc, ic, fc = inp
        b = jnp.cumsum(fc, axis=-1)
        d_mat = jnp.where(tri, b[..., :, None] - b[..., None, :] + ic[..., None, :], -jnp.inf)
        inter = b + m[..., None]
        m_t = jnp.maximum(inter, jnp.max(d_mat, axis=-1))
        w_inter = jnp.exp(inter - m_t)
        qk = jnp.einsum('bhtd,bhsd->bhts', qc, kc) * jnp.exp(d_mat - m_t[..., None])
        num = w_inter[..., None] * jnp.einsum('bhtd,bhde->bhte', qc, c_mat) + jnp.einsum('bhts,bhse->bhte', qk, vc)
        den = w_inter * jnp.einsum('bhtd,bhd->bht', qc, n_vec) + jnp.sum(qk, axis=-1)
        h = num / jnp.maximum(jnp.abs(den), jnp.exp(-m_t))[..., None]
        b_last = b[..., -1]
        g = b_last[..., None] - b + ic
        m_new = jnp.maximum(b_last + m, jnp.max(g, axis=-1))
        decay = jnp.exp(b_last + m - m_new)
        wg = jnp.exp(g - m_new[..., None])
        c_new = decay[..., None, None] * c_mat + jnp.einsum('bhs,bhsd,bhse->bhde', wg, kc, vc)
        n_new = decay[..., None] * n_vec + jnp.einsum('bhs,bhsd->bhd', wg, kc)
        return (c_new, n_new, m_new), h

    xs = tuple(to_chunks(t) for t in (q, k, v, log_i, log_f))
    state, hs = lax.scan(step, state, xs)
    h = jnp.moveaxis(hs, 0, 2).reshape(bsz, n_h, seq, v.shape[-1])
    return h, state


def mlstm_prefix(q, k, v, log_i, log_f, n_ctx, reverse):
    def seg(t):
        a, b = t[:, :, :n_ctx], t[:, :, n_ctx:]
        if reverse:
            a, b = jnp.flip(a, axis=2), jnp.flip(b, axis=2)
        return a, b

    (qc, qx), (kc, kx), (vc, vx), (ic, ix), (fc, fx) = [seg(t) for t in (q, k, v, log_i, log_f)]
    bsz, n_h, _, dk = q.shape
    st = (jnp.zeros((bsz, n_h, dk, v.shape[-1]), jnp.float32), jnp.zeros((bsz, n_h, dk), jnp.float32),
          jnp.zeros((bsz, n_h), jnp.float32))
    h_c, st = mlstm_scan(qc, kc, vc, ic, fc, st)
    h_x, _ = mlstm_scan(qx, kx, vx, ix, fx, st)
    if reverse:
        h_c, h_x = jnp.flip(h_c, axis=2), jnp.flip(h_x, axis=2)
    return jnp.concatenate([h_c, h_x], axis=2)


def even_mixer(hx, hc, w_in, na_qnorm, na_knorm, na_rpb, ml_conv_w, ml_conv_b, ml_gate_b, ml_hnorm, w_out):
    bsz, seq, _ = hx.shape
    n_ctx = hc.shape[1]
    tot = n_ctx + seq
    h = jnp.concatenate([hc, hx], axis=1)
    cuts = [int(v) for v in np.cumsum(EVEN_IN_SIZES)[:-1]]
    na_q, na_k, na_v, ml_qk, ml_v, ml_o, ml_g = jnp.split(h @ w_in, cuts, axis=-1)

    def heads(t, n):
        return t.reshape(bsz, t.shape[1], n, -1).transpose(0, 2, 1, 3)

    q = rmsnorm(heads(na_q, NA_HEADS), na_qnorm)
    k = rmsnorm(heads(na_k, NA_HEADS), na_knorm)
    v = heads(na_v, NA_HEADS)
    na_x, na_c = neighbourhood_attention(q[:, :, n_ctx:], k[:, :, n_ctx:], v[:, :, n_ctx:],
                                         q[:, :, :n_ctx], k[:, :, :n_ctx], v[:, :, :n_ctx], na_rpb)
    na_h = jnp.concatenate([na_c, na_x], axis=2).transpose(0, 2, 1, 3).reshape(bsz, tot, NA_WIDTH)

    qk = jnp.concatenate([centred_dwconv(ml_qk[:, :n_ctx], ml_conv_w, ml_conv_b),
                          centred_dwconv(ml_qk[:, n_ctx:], ml_conv_w, ml_conv_b)], axis=1)
    mq, mk = jnp.split(jax.nn.silu(qk).astype(jnp.float32), 2, axis=-1)
    mq = heads(mq, ML_HEADS)
    mk = heads(mk, ML_HEADS) * (ML_DK ** -0.5)
    mv = heads(ml_v.astype(jnp.float32), ML_HEADS)
    g = ml_g.astype(jnp.float32).reshape(bsz, tot, 2, 2, ML_HEADS) + ml_gate_b.astype(jnp.float32)
    g = g.transpose(2, 3, 0, 4, 1)
    log_i = g[:, 0]
    log_f = jax.nn.log_sigmoid(g[:, 1])
    hm = (mlstm_prefix(mq, mk, mv, log_i[0], log_f[0], n_ctx, False)
          + mlstm_prefix(mq, mk, mv, log_i[1], log_f[1], n_ctx, True))
    ml_h = rmsnorm(hm.transpose(0, 2, 1, 3), ml_hnorm.reshape(ML_HEADS, ML_DV)).reshape(bsz, tot, ML_WIDTH)
    ml_h = ml_h.astype(hx.dtype) * jax.nn.sigmoid(ml_o)

    out = jnp.concatenate([na_h, ml_h], axis=-1) @ w_out
    return out[:, n_ctx:], out[:, :n_ctx]


def odd_mixer(hx, hc, w_in, qnorm, knorm, lam, subln, w_out, lambda_init, cos, sin, ctx_queries):
    bsz, seq, _ = hx.shape

    def qk_heads(t, gain):
        t = t.reshape(bsz, t.shape[1], DA_HEADS, 2, DA_DIM).transpose(0, 2, 3, 1, 4)
        return rmsnorm(t, gain)

    def v_heads(t):
        return t.reshape(bsz, t.shape[1], DA_HEADS, DA_VDIM).transpose(0, 2, 1, 3)

    q_x, k_x, v_x = jnp.split(hx @ w_in, [DA_QK_WIDTH, 2 * DA_QK_WIDTH], axis=-1)
    q_x = apply_rope(qk_heads(q_x, qnorm), cos, sin)
    k_x = apply_rope(qk_heads(k_x, knorm), cos, sin)
    v_x = v_heads(v_x)
    if ctx_queries:
        q_c, k_c, v_c = jnp.split(hc @ w_in, [DA_QK_WIDTH, 2 * DA_QK_WIDTH], axis=-1)
        q_c = qk_heads(q_c, qnorm)
    else:
        k_c, v_c = jnp.split(hc @ w_in[:, DA_QK_WIDTH:], [DA_QK_WIDTH], axis=-1)
    k_c = qk_heads(k_c, knorm)
    v_c = v_heads(v_c)

    lam32 = lam.astype(jnp.float32)
    lam_full = jnp.exp(jnp.sum(lam32[0] * lam32[1])) - jnp.exp(jnp.sum(lam32[2] * lam32[3])) + lambda_init

    def attend(q, k, v):
        s = jnp.einsum('bhiqd,bhikd->bhiqk', q, k).astype(jnp.float32) * (DA_DIM ** -0.5)
        p = jax.nn.softmax(s, axis=-1)
        a = p[:, :, 0] - lam_full * p[:, :, 1]
        return jnp.einsum('bhqk,bhke->bhqe', a.astype(v.dtype), v)

    def finish(o):
        o = rmsnorm(o, subln) * (1.0 - lambda_init)
        return o.transpose(0, 2, 1, 3).reshape(bsz, o.shape[2], DA_V_WIDTH) @ w_out

    k_all = jnp.concatenate([k_x, k_c], axis=3)
    v_all = jnp.concatenate([v_x, v_c], axis=2)
    n_blocks = seq // Q_BLOCK
    q_blocks = jnp.moveaxis(q_x.reshape(bsz, DA_HEADS, 2, n_blocks, Q_BLOCK, DA_DIM), 3, 0)
    o_x = lax.map(lambda qb: attend(qb, k_all, v_all), q_blocks)
    o_x = jnp.moveaxis(o_x, 0, 2).reshape(bsz, DA_HEADS, seq, DA_VDIM)
    out_x = finish(o_x)
    out_c = finish(attend(q_c, k_c, v_c)) if ctx_queries else None
    return out_x, out_c


def moe(h, router_w, router_b, exp_gate, exp_up, exp_down, sh_gate, sh_up, sh_down):
    shape = h.shape
    tok = h.reshape(-1, shape[-1])
    scores = jax.nn.sigmoid((tok @ router_w).astype(jnp.float32))
    sel = scores + router_b.astype(jnp.float32)
    per_group = N_EXPERTS // N_GROUPS
    grp_score = jnp.sum(lax.top_k(sel.reshape(-1, N_GROUPS, per_group), 2)[0], axis=-1)
    _, grp_idx = lax.top_k(grp_score, TOPK_GROUPS)
    grp_keep = jnp.sum(jax.nn.one_hot(grp_idx, N_GROUPS, dtype=jnp.float32), axis=-2) > 0
    sel = jnp.where(jnp.repeat(grp_keep, per_group, axis=-1), sel, NEG_INF)
    _, idx = lax.top_k(sel, TOP_K)
    w = jnp.take_along_axis(scores, idx, axis=-1)
    w = w / jnp.sum(w, axis=-1, keepdims=True) * ROUTED_SCALE
    gates = jnp.sum(jax.nn.one_hot(idx, N_EXPERTS, dtype=jnp.float32) * w[..., None], axis=-2)

    def add_expert(acc, e):
        wg, wu, wd, g = e
        y = (jax.nn.silu(tok @ wg) * (tok @ wu)) @ wd
        return acc + g[:, None].astype(y.dtype) * y, None

    routed, _ = lax.scan(add_expert, jnp.zeros_like(tok), (exp_gate, exp_up, exp_down, gates.T))
    shared = (jax.nn.silu(tok @ sh_gate) * (tok @ sh_up)) @ sh_down
    return (routed + shared).reshape(shape)


def diff_lambda_init(layer):
    return 0.8 - 0.6 * math.exp(-0.3 * layer)


def setup_inputs(seed: int = 0) -> dict:
    key = jax.random.key(seed)
    keys = iter(jax.random.split(key, 128))

    def normal(shape, scale):
        return scale * jax.random.normal(next(keys), shape, jnp.float32)

    def gain(shape):
        return 1.0 + 0.05 * jax.random.normal(next(keys), shape, jnp.float32)

    d = D_MODEL
    inp = {
        'x': normal((BATCH, SEQ, d), 1.0),
        'c': normal((BATCH, d), 1.0),
        'ctx': normal((BATCH, CTX_LEN, d), 1.0),
        'c_ctx': normal((d,), 1.0),
    }
    for layer in range(DEPTH):
        p = 'l%d_' % layer
        inp[p + 'ada_w'] = normal((d, 6 * d), 0.5 * d ** -0.5)
        inp[p + 'ada_b'] = normal((6 * d,), 0.02)
        inp[p + 'norm1'] = gain((d,))
        inp[p + 'norm2'] = gain((d,))
        if layer % 2 == 0:
            inp[p + 'w_in'] = normal((d, EVEN_IN_WIDTH), d ** -0.5)
            inp[p + 'na_qnorm'] = gain((NA_HEAD_DIM,))
            inp[p + 'na_knorm'] = gain((NA_HEAD_DIM,))
            inp[p + 'na_rpb'] = normal((NA_HEADS, 2 * NA_WIN_H - 1, 2 * NA_WIN_W - 1), 0.1)
            inp[p + 'ml_conv_w'] = normal((ML_CONV, 2 * ML_HEADS * ML_DK), ML_CONV ** -0.5)
            inp[p + 'ml_conv_b'] = normal((2 * ML_HEADS * ML_DK,), 0.02)
            f_bias = jnp.linspace(3.0, 6.0, ML_HEADS, dtype=jnp.float32)
            inp[p + 'ml_gate_b'] = normal((2, 2, ML_HEADS), 0.1).at[:, 1].add(f_bias)
            inp[p + 'ml_hnorm'] = gain((ML_WIDTH,))
            inp[p + 'w_out'] = normal((NA_WIDTH + ML_WIDTH, d), (NA_WIDTH + ML_WIDTH) ** -0.5)
        else:
            inp[p + 'w_in'] = normal((d, 2 * DA_QK_WIDTH + DA_V_WIDTH), d ** -0.5)
            inp[p + 'qnorm'] = gain((DA_DIM,))
            inp[p + 'knorm'] = gain((DA_DIM,))
            inp[p + 'lambda'] = normal((4, DA_DIM), 0.1)
            inp[p + 'subln'] = gain((DA_VDIM,))
            inp[p + 'w_out'] = normal((DA_V_WIDTH, d), DA_V_WIDTH ** -0.5)
        inp[p + 'router_w'] = normal((d, N_EXPERTS), d ** -0.5)
        inp[p + 'router_b'] = normal((N_EXPERTS,), 0.01)
        inp[p + 'exp_gate'] = normal((N_EXPERTS, d, D_EXPERT), d ** -0.5)
        inp[p + 'exp_up'] = normal((N_EXPERTS, d, D_EXPERT), d ** -0.5)
        inp[p + 'exp_down'] = normal((N_EXPERTS, D_EXPERT, d), D_EXPERT ** -0.5)
        inp[p + 'sh_gate'] = normal((d, D_EXPERT), d ** -0.5)
        inp[p + 'sh_up'] = normal((d, D_EXPERT), d ** -0.5)
        inp[p + 'sh_down'] = normal((D_EXPERT, d), D_EXPERT ** -0.5)
    return inp


def reference(x, c, ctx, c_ctx,
              l0_ada_w, l0_ada_b, l0_norm1, l0_norm2, l0_w_in, l0_na_qnorm, l0_na_knorm, l0_na_rpb,
              l0_ml_conv_w, l0_ml_conv_b, l0_ml_gate_b, l0_ml_hnorm, l0_w_out,
              l0_router_w, l0_router_b, l0_exp_gate, l0_exp_up, l0_exp_down, l0_sh_gate, l0_sh_up, l0_sh_down,
              l1_ada_w, l1_ada_b, l1_norm1, l1_norm2, l1_w_in, l1_qnorm, l1_knorm, l1_lambda, l1_subln, l1_w_out,
              l1_router_w, l1_router_b, l1_exp_gate, l1_exp_up, l1_exp_down, l1_sh_gate, l1_sh_up, l1_sh_down):
    seq = x.shape[1]
    n_ctx = ctx.shape[1]
    cos, sin = axial_rope_tables(seq, DA_DIM)
    adaln = [(l0_ada_w, l0_ada_b, l0_norm1, l0_norm2), (l1_ada_w, l1_ada_b, l1_norm1, l1_norm2)]
    mixers = [(l0_w_in, l0_na_qnorm, l0_na_knorm, l0_na_rpb, l0_ml_conv_w, l0_ml_conv_b, l0_ml_gate_b, l0_ml_hnorm, l0_w_out),
              (l1_w_in, l1_qnorm, l1_knorm, l1_lambda, l1_subln, l1_w_out)]
    moes = [(l0_router_w, l0_router_b, l0_exp_gate, l0_exp_up, l0_exp_down, l0_sh_gate, l0_sh_up, l0_sh_down),
            (l1_router_w, l1_router_b, l1_exp_gate, l1_exp_up, l1_exp_down, l1_sh_gate, l1_sh_up, l1_sh_down)]
    xc = ctx
    for layer in range(DEPTH):
        ada_w, ada_b, norm1, norm2 = adaln[layer]
        last = layer == DEPTH - 1
        mx = jnp.split(jax.nn.silu(c) @ ada_w + ada_b, 6, axis=-1)
        mc = jnp.split(jax.nn.silu(c_ctx) @ ada_w + ada_b, 6, axis=-1)
        hx = modulate(rmsnorm(x, norm1), mx[0][:, None], mx[1][:, None])
        hc = modulate(rmsnorm(xc, norm1), mc[0], mc[1])
        if layer % 2 == 0:
            ox, oc = even_mixer(hx, hc, *mixers[layer])
        else:
            ox, oc = odd_mixer(hx, hc, *mixers[layer], diff_lambda_init(layer), cos, sin, not last)
        x = x + mx[2][:, None] * ox
        hx = modulate(rmsnorm(x, norm2), mx[3][:, None], mx[4][:, None])
        if last:
            x = x + mx[5][:, None] * moe(hx, *moes[layer])
        else:
            xc = xc + mc[2] * oc
            hc = modulate(rmsnorm(xc, norm2), mc[3], mc[4])
            y = moe(jnp.concatenate([hc, hx], axis=1), *moes[layer])
            xc = xc + mc[5] * y[:, :n_ctx]
            x = x + mx[5][:, None] * y[:, n_ctx:]
    return x
```

```cpp
#include <hip/hip_runtime.h>
#include <cstdio>
#include <cstdint>
namespace pg8 {
#define PG8_LAS __attribute__((address_space(3)))
typedef unsigned short bf16_t;
typedef short bf16x8 __attribute__((ext_vector_type(8)));
typedef float f32x4 __attribute__((ext_vector_type(4)));
typedef unsigned u32x4 __attribute__((ext_vector_type(4)));
constexpr int BM = 256, BK = 64, HALF = 128, HTB = HALF * BK * 2  , STAGE_BYTES = 8 * HTB, NXCD = 8, WGM = 8;

__host__ __device__ __forceinline__ int lds_byte(int r, int c) { const int st = (r >> 4) * 2 + (c >> 5), rr = r & 15, cc = c & 31, ob = rr * 64 + cc * 2; return st * 1024 + (ob ^ (((ob >> 9) & 1) << 5)); }
__host__ __device__ __forceinline__ void stage_rc(int b, int& R, int& C) { const int st = b / 1024, sb = b % 1024, swz = sb ^ (((sb >> 9) & 1) << 5); R = (st >> 1) * 16 + swz / 64; C = (st & 1) * 32 + (swz % 64) / 2; }
__host__ __device__ __forceinline__ int perm32(int rho) { const int n = rho >> 4, i = rho & 15; return 8 * (i >> 2) + 4 * n + (i & 3); }

struct Unit { int pm, pn; };
struct Gemm { const bf16_t* A; const bf16_t* Bt; int M, N, K; };

struct StaticOrder {
    int nM, nN, nwg, G, c;
    __host__ __device__ void init(int M, int N, int G_, int c_) { nM = M / BM; nN = N / BM; nwg = nM * nN; G = G_; c = c_; }
    __host__ __device__ bool next(int i, Unit& u) const {
        const long L = (long)i * G + c; if (L >= nwg) return false;
        int wgid = (int)L; { const int q = nwg / NXCD, r = nwg % NXCD, xcd = wgid % NXCD, off = wgid / NXCD; wgid = (xcd < r ? xcd * (q + 1) : r * (q + 1) + (xcd - r) * q) + off; }
        const int nig = WGM * nN, gid = wgid / nig, fm = gid * WGM, gsz = (nM - fm) < WGM ? (nM - fm) : WGM;
        u.pm = fm + ((wgid % nig) % gsz); u.pn = (wgid % nig) / gsz; return true;
    }
    __device__ __forceinline__ void a_ready(const Unit&) const {}
    __device__ __forceinline__ void done(const Unit&) const {}
};
struct CountedOrder : StaticOrder {
    const unsigned* ready; unsigned need; unsigned* tmo;
    __device__ __forceinline__ void a_ready(const Unit& u) const {
        if (threadIdx.x < 64) {
            const unsigned long long t0 = __builtin_amdgcn_s_memrealtime(); unsigned polls = 0;
            while ((unsigned)__builtin_amdgcn_readfirstlane(__hip_atomic_load(ready + 64 * u.pm, __ATOMIC_RELAXED, __HIP_MEMORY_SCOPE_AGENT)) < need) {
                if ((++polls & 255u) == 0u && __builtin_amdgcn_readfirstlane(__hip_atomic_load(tmo, __ATOMIC_RELAXED, __HIP_MEMORY_SCOPE_AGENT)) != 0u) break;
                if (__builtin_amdgcn_s_memrealtime() - t0 > 2000000ull) {
                    if (threadIdx.x == 0) { unsigned expect = 0u; __hip_atomic_compare_exchange_strong(tmo + 1, &expect, 0x600u | (unsigned)(u.pm & 0xff), __ATOMIC_RELAXED, __ATOMIC_RELAXED, __HIP_MEMORY_SCOPE_AGENT); __hip_atomic_store(tmo, 1u, __ATOMIC_RELAXED, __HIP_MEMORY_SCOPE_AGENT); }
                    break; }
                __builtin_amdgcn_s_sleep(2); }
            __builtin_amdgcn_fence(__ATOMIC_ACQUIRE, "agent");
            asm volatile("s_waitcnt vmcnt(0)" ::: "memory");
        }
#if !defined(BROKEN_HOOK_NO_BARRIER)
        asm volatile("" ::: "memory"); __builtin_amdgcn_s_barrier(); asm volatile("" ::: "memory");
#endif
    }
};

__device__ __forceinline__ unsigned cvt_pk_bf16(float lo, float hi) { unsigned r; asm volatile("v_cvt_pk_bf16_f32 %0, %1, %2" : "=v"(r) : "v"(lo), "v"(hi)); return r; }
typedef float f32x2 __attribute__((ext_vector_type(2)));
__device__ __forceinline__ f32x2 gelu_pk(f32x2 v) {
    const f32x2 av = __builtin_elementwise_abs(v), d = av * 0.2316418882f + 1.0f;
    f32x2 t; t.x = __builtin_amdgcn_rcpf(d.x); t.y = __builtin_amdgcn_rcpf(d.y);
    f32x2 q = t * 0.5307027145f + (-0.7265760135f); q = q * t + 0.7107068705f; q = q * t + (-0.142248368f); q = q * t + 0.127414796f; q = q * t;
    const f32x2 s = (v * v) * (-0.72134752044f);
    f32x2 e; e.x = __builtin_amdgcn_exp2f(s.x); e.y = __builtin_amdgcn_exp2f(s.y);
    const f32x2 m = v * (q * e), r = v - m;
    f32x2 o; o.x = v.x < 0.f ? m.x : r.x; o.y = v.y < 0.f ? m.y : r.y; return o;
}

struct EpiF32 {
    static constexpr bool PERM = false, AFTER_DRAIN = false;
    float* C; int ldc; const float* bias;
    __device__ __forceinline__ void operator()(const f32x4 (&acc)[2][2][4][2], const Unit& u, int wr, int wc, int fr, int fq) const {
        const int row0 = u.pm * BM + wr * 64 + fr, col0 = u.pn * BM + wc * 32 + 4 * fq;
        f32x4 bv[2][2];
#pragma unroll
        for (int bj = 0; bj < 2; ++bj)
#pragma unroll
            for (int n = 0; n < 2; ++n) bv[bj][n] = bias ? *(const f32x4*)(bias + col0 + bj * HALF + n * 16) : (f32x4){0.f, 0.f, 0.f, 0.f};
#pragma unroll
        for (int ai = 0; ai < 2; ++ai)
#pragma unroll
            for (int m = 0; m < 4; ++m) { float* rowp = C + (size_t)(row0 + ai * HALF + m * 16) * ldc + col0;
#pragma unroll
                for (int bj = 0; bj < 2; ++bj)
#pragma unroll
                    for (int n = 0; n < 2; ++n) *(f32x4*)(rowp + bj * HALF + n * 16) = acc[ai][bj][m][n] + bv[bj][n]; }
    }
};
template <int ACT  > struct EpiBf16 {
    static constexpr bool PERM = true, AFTER_DRAIN = false;
    bf16_t* O; int ldc; const float* bias; int split_cols; size_t split_stride;
    __device__ __forceinline__ void operator()(const f32x4 (&acc)[2][2][4][2], const Unit& u, int wr, int wc, int fr, int fq) const {
        const int row0 = u.pm * BM + wr * 64 + fr; int colt = u.pn * BM; bf16_t* base = O;
        if (split_cols) { const int t = colt / split_cols; base += (size_t)t * split_stride; colt -= t * split_cols; }
        const int col0 = colt + wc * 32 + 8 * fq, bcol0 = u.pn * BM + wc * 32 + 8 * fq;
        f32x4 bv[2][2];
#pragma unroll
        for (int bj = 0; bj < 2; ++bj)
#pragma unroll
            for (int n = 0; n < 2; ++n) bv[bj][n] = bias ? *(const f32x4*)(bias + bcol0 + bj * HALF + 4 * n) : (f32x4){0.f, 0.f, 0.f, 0.f};
#pragma unroll
        for (int ai = 0; ai < 2; ++ai)
#pragma unroll
            for (int m = 0; m < 4; ++m) { bf16_t* rowp = base + (size_t)(row0 + ai * HALF + m * 16) * ldc + col0;
#pragma unroll
                for (int bj = 0; bj < 2; ++bj) { f32x4 v0 = acc[ai][bj][m][0] + bv[bj][0], v1 = acc[ai][bj][m][1] + bv[bj][1];
                    if (ACT == 1) { f32x2 a = gelu_pk((f32x2){v0[0], v0[1]}), b = gelu_pk((f32x2){v0[2], v0[3]}), c = gelu_pk((f32x2){v1[0], v1[1]}), d = gelu_pk((f32x2){v1[2], v1[3]});
                        v0 = (f32x4){a.x, a.y, b.x, b.y}; v1 = (f32x4){c.x, c.y, d.x, d.y}; }
                    if (ACT == 2) {
#pragma unroll
                        for (int j = 0; j < 4; ++j) { v0[j] = 0.5f * v0[j] * (1.0f + erff(v0[j] * 0.70710678f)); v1[j] = 0.5f * v1[j] * (1.0f + erff(v1[j] * 0.70710678f)); } }
                    u32x4 w; w.x = cvt_pk_bf16(v0[0], v0[1]); w.y = cvt_pk_bf16(v0[2], v0[3]); w.z = cvt_pk_bf16(v1[0], v1[1]); w.w = cvt_pk_bf16(v1[2], v1[3]);
                    *(u32x4*)(rowp + bj * HALF) = w; } }
    }
};
template <class Epi, class Sched, bool STAMP = false>
__device__ __forceinline__ void gemm_phase(PG8_LAS unsigned char* lds, const Gemm g, const Sched& S, const Epi& E, unsigned long long* stamps) {
    const int tid = threadIdx.x, wid = __builtin_amdgcn_readfirstlane(tid >> 6), lane = tid & 63, wr = wid >> 2, wc = wid & 3, fr = lane & 15, fq = lane >> 4;
    const int K = g.K, nt = K / BK;
    int ts_lo = 0, ts_hi = 0, nts = 0; const unsigned long long rt_entry = STAMP ? (unsigned long long)wall_clock64() : 0ull;
#define PG8_STAMP() do { if (STAMP && wid == 0 && nts < 64) { const unsigned long long _c = (unsigned long long)clock64(); \
        ts_lo = (lane == nts) ? (int)(unsigned)_c : ts_lo; ts_hi = (lane == nts) ? (int)(unsigned)(_c >> 32) : ts_hi; ++nts; } } while (0)
    PG8_STAMP();
    unsigned voffA[2], voffB[2];
#pragma unroll
    for (int i = 0; i < 2; ++i) { int R, C; stage_rc(tid * 16 + i * 8192, R, C); const int Rb = Epi::PERM ? ((R & ~31) + perm32(R & 31)) : R;
        voffA[i] = (unsigned)(R * K + C) * 2u; voffB[i] = (unsigned)(Rb * K + C) * 2u; }
    const size_t kstep = (size_t)(BK * 2);
    const size_t hstep = (size_t)HALF * K * 2;
    const size_t tstep = 2 * hstep;
    const unsigned ldsw = (unsigned)wid * 1024u;
    const int aoff = lds_byte(wr * 64 + fr, fq * 8), boff = lds_byte(wc * 32 + fr, fq * 8);
#define PG8_SA(b, h) (((b) * 2 + (h)) * HTB)
#define PG8_SB(b, h) ((4 + (b) * 2 + (h)) * HTB)
#define PG8_STAGE(bufoff, gbase, voff) do { _Pragma("unroll") for (int _i = 0; _i < 2; ++_i) \
        __builtin_amdgcn_global_load_lds((const unsigned*)((const char*)(gbase) + (voff)[_i]), (PG8_LAS unsigned*)(lds + (bufoff) + ldsw + _i * 8192), 16, 0, 0); } while (0)
#define PG8_LDA(dst, b, h) do { _Pragma("unroll") for (int m = 0; m < 4; ++m) _Pragma("unroll") for (int k = 0; k < 2; ++k) dst[m][k] = *(const PG8_LAS bf16x8*)(lds + PG8_SA(b, h) + aoff + m * 2048 + k * 1024); } while (0)
#define PG8_LDB(dst, b, h) do { _Pragma("unroll") for (int n = 0; n < 2; ++n) _Pragma("unroll") for (int k = 0; k < 2; ++k) dst[n][k] = *(const PG8_LAS bf16x8*)(lds + PG8_SB(b, h) + boff + n * 2048 + k * 1024); } while (0)
#define PG8_MMA(ai, bj, At, Bt) do { __builtin_amdgcn_s_setprio(1); _Pragma("unroll") for (int m = 0; m < 4; ++m) _Pragma("unroll") for (int n = 0; n < 2; ++n) _Pragma("unroll") for (int k = 0; k < 2; ++k) \
        acc[ai][bj][m][n] = __builtin_amdgcn_mfma_f32_16x16x32_bf16(Bt[n][k], At[m][k], acc[ai][bj][m][n], 0, 0, 0); __builtin_amdgcn_s_setprio(0); } while (0)
#define PG8_WAIT_V(n) asm volatile("s_waitcnt vmcnt(" #n ")" ::: "memory")
#define PG8_WAIT_L(n) asm volatile("s_waitcnt lgkmcnt(" #n ")" ::: "memory")
#define PG8_BAR __builtin_amdgcn_s_barrier()
#define PG8_SCHED __builtin_amdgcn_sched_barrier(0)
    Unit cur, nxt; int ui = 0;
    if (!S.next(0, cur)) return;
    f32x4 acc[2][2][4][2];
#pragma unroll
    for (int a = 0; a < 2; ++a)
#pragma unroll
        for (int b = 0; b < 2; ++b)
#pragma unroll
            for (int m = 0; m < 4; ++m)
#pragma unroll
                for (int n = 0; n < 2; ++n) acc[a][b][m][n] = (f32x4){0.f, 0.f, 0.f, 0.f};
    bf16x8 At[4][2], B0[2][2], B1[2][2];
    const char* cA = (const char*)g.A + (size_t)cur.pm * tstep; const char* cB = (const char*)g.Bt + (size_t)cur.pn * tstep;
    S.a_ready(cur);
    PG8_STAGE(PG8_SB(0, 0), cB, voffB); PG8_STAGE(PG8_SA(0, 0), cA, voffA); PG8_STAGE(PG8_SB(0, 1), cB + hstep, voffB); PG8_STAGE(PG8_SA(0, 1), cA + hstep, voffA);
    if (wr == 1) PG8_BAR;
    PG8_WAIT_V(4); PG8_BAR;
    PG8_STAGE(PG8_SB(1, 0), cB + kstep, voffB); PG8_STAGE(PG8_SA(1, 0), cA + kstep, voffA); PG8_STAGE(PG8_SB(1, 1), cB + hstep + kstep, voffB);
    PG8_WAIT_V(6); PG8_BAR;
    PG8_STAMP();
    for (;;) {
        const bool has_next = S.next(ui + 1, nxt);
        const char* nA = has_next ? (const char*)g.A + (size_t)nxt.pm * tstep : cA; const char* nB = has_next ? (const char*)g.Bt + (size_t)nxt.pn * tstep : cB;
        for (int t = 0; t < nt; t += 2) {
            const bool last = (t == nt - 2);
            const char* a1 = cA + (size_t)(t + 1) * kstep;
            const char* a2 = last ? nA : cA + (size_t)(t + 2) * kstep; const char* b2 = last ? nB : cB + (size_t)(t + 2) * kstep;
            const char* a3 = a2 + kstep; const char* b3 = b2 + kstep;
            if (last && has_next) S.a_ready(nxt);
            PG8_LDB(B0, 0, 0); PG8_SCHED; PG8_LDA(At, 0, 0); PG8_STAGE(PG8_SA(1, 1), a1 + hstep, voffA);
            PG8_WAIT_L(8); PG8_BAR; PG8_WAIT_L(0); PG8_MMA(0, 0, At, B0); PG8_BAR; PG8_SCHED;
            PG8_LDB(B1, 0, 1); PG8_STAGE(PG8_SB(0, 0), b2, voffB);
            PG8_BAR; PG8_WAIT_L(0); PG8_MMA(0, 1, At, B1); PG8_BAR;
            PG8_LDA(At, 0, 1); PG8_STAGE(PG8_SA(0, 0), a2, voffA);
            PG8_BAR; PG8_WAIT_L(0); PG8_MMA(1, 0, At, B0); PG8_BAR; PG8_SCHED;
            PG8_STAGE(PG8_SB(0, 1), b2 + hstep, voffB);
            PG8_WAIT_V(6); PG8_BAR; PG8_MMA(1, 1, At, B1); PG8_BAR;
            PG8_LDB(B0, 1, 0); PG8_SCHED; PG8_LDA(At, 1, 0); PG8_STAGE(PG8_SA(0, 1), a2 + hstep, voffA);
            PG8_WAIT_L(8); PG8_BAR; PG8_WAIT_L(0); PG8_MMA(0, 0, At, B0); PG8_BAR; PG8_SCHED;
            PG8_LDB(B1, 1, 1); PG8_STAGE(PG8_SB(1, 0), b3, voffB);
            PG8_BAR; PG8_WAIT_L(0); PG8_MMA(0, 1, At, B1); PG8_BAR;
            PG8_LDA(At, 1, 1); PG8_STAGE(PG8_SA(1, 0), a3, voffA);
            PG8_BAR; PG8_WAIT_L(0); PG8_MMA(1, 0, At, B0); PG8_BAR; PG8_SCHED;
            PG8_STAGE(PG8_SB(1, 1), b3 + hstep, voffB);
            PG8_WAIT_V(6); PG8_BAR; PG8_MMA(1, 1, At, B1); PG8_BAR;
        }
        PG8_STAMP();
        if constexpr (!Epi::AFTER_DRAIN) { E(acc, cur, wr, wc, fr, fq); S.done(cur); }
        PG8_STAMP();
        if (!has_next) break;
#pragma unroll
        for (int a = 0; a < 2; ++a)
#pragma unroll
            for (int b = 0; b < 2; ++b)
#pragma unroll
                for (int m = 0; m < 4; ++m)
#pragma unroll
                    for (int n = 0; n < 2; ++n) acc[a][b][m][n] = (f32x4){0.f, 0.f, 0.f, 0.f};
        cur = nxt; cA = nA; cB = nB; ++ui;
    }
    PG8_WAIT_V(0);
    if (wr == 0) PG8_BAR;
    PG8_BAR;
    if constexpr (Epi::AFTER_DRAIN) { E.fused(acc, cur, wr, wc, fr, fq, lds, wid, lane); S.done(cur); }
    PG8_STAMP();
    if (STAMP && wid == 0) { stamps[lane] = lane < nts ? (((unsigned long long)(unsigned)ts_hi << 32) | (unsigned)ts_lo) : 0ull;
        if (lane == 62) stamps[62] = rt_entry; if (lane == 63) stamps[63] = (unsigned long long)wall_clock64(); }
#undef PG8_STAMP
#undef PG8_SA
#undef PG8_SB
#undef PG8_STAGE
#undef PG8_LDA
#undef PG8_LDB
#undef PG8_MMA
#undef PG8_WAIT_V
#undef PG8_WAIT_L
#undef PG8_BAR
#undef PG8_SCHED
}
}
#define GAS __attribute__((address_space(1)))
#define LAS __attribute__((address_space(3)))
typedef unsigned short bf16;
typedef unsigned v4u __attribute__((ext_vector_type(4)));
typedef unsigned v2u __attribute__((ext_vector_type(2)));
typedef float f32x4 __attribute__((ext_vector_type(4)));
typedef short bf16x8 __attribute__((ext_vector_type(8)));
#define LDS_WAIT() asm volatile("s_waitcnt lgkmcnt(0)" ::: "memory")
constexpr int NWAVES = 8, NTHR = 512;
constexpr int D = 2048, NB = 2, SEQ = 4096, LCTX = 256, TT = SEQ + LCTX  , M0 = NB * TT  , M1 = NB * SEQ  ;
constexpr int NIN0 = 7200, NIN0P = 7424, NIN1 = 6144, NE = 64, DE = 512, TOPK = 6, GW = 64, GROWS = 64;
constexpr int C_NAQ = 0, C_NAK = 1024, C_NAV = 2048, C_MLQK = 3072, C_MLV = 5120, C_MLO = 6144, C_MLG = 7168;
constexpr int RMAX = 68608;
constexpr float EPS = 1e-6f;
constexpr size_t MiB = 1u << 20;
constexpr size_t WS_CTL = 0, CTL_BYTES = 1 * MiB;
constexpr size_t WS_MOD = 1 * MiB;
constexpr size_t WS_ROPE = WS_MOD + 512 * 1024;
constexpr size_t WS_GATE = 4 * MiB;
constexpr size_t WS_ROUTE = 6 * MiB;
constexpr size_t WS_WIN0 = 8 * MiB, WS_WOUT0 = 37 * MiB, WS_WIN1 = 45 * MiB, WS_WOUT1 = 69 * MiB;
constexpr size_t WS_W1T = 77 * MiB;
constexpr size_t WS_W2T = WS_W1T + 520 * MiB;
constexpr size_t WS_X = WS_W2T + 260 * MiB;
constexpr size_t WS_HB = WS_X + 68 * MiB;
constexpr size_t WS_H2 = WS_HB + 34 * MiB;
constexpr size_t WS_MIX = WS_H2 + 34 * MiB;
constexpr size_t WS_PROJ = WS_MIX, WS_QK = WS_PROJ + 124 * MiB, WS_HM = WS_QK + 68 * MiB, WS_AO = WS_HM + 68 * MiB, WS_SA = WS_MIX;
constexpr size_t WS_ACT = WS_MIX + 294 * MiB;
constexpr size_t WS_ACTS = WS_ACT + 67 * MiB;
constexpr size_t WS_Y = WS_ACTS + 9 * MiB;
constexpr size_t WS_YS = WS_Y + 268 * MiB;
constexpr size_t WS_END = WS_YS + 34 * MiB;
static_assert(WS_END <= 1900 * MiB, "d_ws map must stay under the guaranteed workspace (sum of inputs = 1957 MiB)");
static_assert((size_t)RMAX * D * 2 <= 294 * MiB && (size_t)M0 * NIN0P * 2 <= 124 * MiB, "overlay sizes");
constexpr int CW_CNT0 = 64, CW_CNT1 = 192, CW_BAR = 4096;
constexpr int RING_BYTES = 131072, MISC_OFF = RING_BYTES, LDS_BYTES = 147456;
__device__ __forceinline__ float bf2f(unsigned v) { return __uint_as_float(v << 16); }
__device__ __forceinline__ unsigned f2bf(float f) { unsigned u = __float_as_uint(f); return (u + 0x7fffu + ((u >> 16) & 1u)) >> 16; }
__device__ __forceinline__ unsigned pk2(float lo, float hi) { return f2bf(lo) | (f2bf(hi) << 16); }
__device__ __forceinline__ float wave_sum(float v) {
#pragma unroll
    for (int o = 1; o < 64; o <<= 1) v += __shfl_xor(v, o);
    return v; }
__device__ __forceinline__ float siluf(float x) { return x / (1.f + __expf(-x)); }
__device__ __forceinline__ float sigmf(float x) { return 1.f / (1.f + __expf(-x)); }
#define XB_TMO      128
#define XB_XCNT(j)  (256  + 64 * (j))
#define XB_XSUB(j)  (1280 + 64 * (j))
#define XB_XGEN(j)  (2304 + 64 * (j))
#define XB_TOP      3328
#define XB_TOPGEN   3392
#define XCD_BAR_WORDS 3456
#define XB_SPIN_CAP (1u << 18)
#define LAS __attribute__((address_space(3)))

__device__ __forceinline__ unsigned xb_ld(unsigned* p)              { return __hip_atomic_load(p, __ATOMIC_RELAXED, __HIP_MEMORY_SCOPE_AGENT); }
__device__ __forceinline__ unsigned xb_add(unsigned* p, unsigned v) { return __hip_atomic_fetch_add(p, v, __ATOMIC_RELAXED, __HIP_MEMORY_SCOPE_AGENT); }
__device__ __forceinline__ unsigned xb_xcc_id() { return (unsigned)__builtin_amdgcn_s_getreg((3 << 11) | 20) & 0xFu; }
#define XB_SPIN(cond, bar) do { unsigned _sp = 0; while (cond) { __builtin_amdgcn_s_sleep(1); \
    if ((++_sp & 255u) == 0u) { if (xb_ld(&(bar)[XB_TMO])) break; if (_sp > XB_SPIN_CAP) { atomicAdd(&(bar)[XB_TMO], 1u); break; } } } } while (0)

struct XcdBarrier {
    unsigned* bar; unsigned x;
    volatile LAS unsigned* st;
};

__device__ __forceinline__ XcdBarrier xcd_barrier_post(unsigned* bar, volatile LAS unsigned* st) {
    XcdBarrier b; b.bar = bar; b.x = xb_xcc_id(); b.st = st;
    if (threadIdx.x == 0) (void)xb_add(&bar[XB_XCNT(b.x)], 1u);
    return b;
}
__device__ __forceinline__ void xcd_barrier_complete(unsigned* bar, unsigned x, unsigned& nloc, unsigned& nx) {
    const unsigned G = gridDim.x * gridDim.y * gridDim.z;
    unsigned sum, cnt, mine, sp = 0u;
    for (;;) {
        sum = 0u; cnt = 0u; mine = 0u;
#pragma unroll
        for (unsigned j = 0; j < 16; ++j) { const unsigned c = xb_ld(&bar[XB_XCNT(j)]); sum += c; cnt += (c > 0u) ? 1u : 0u; mine = (j == x) ? c : mine; }
        if (sum == G) break;
        __builtin_amdgcn_s_sleep(1);
        if ((++sp & 255u) == 0u) { if (xb_ld(&bar[XB_TMO])) break; if (sp > XB_SPIN_CAP) { atomicAdd(&bar[XB_TMO], 1u); break; } }
    }
    nloc = mine > 0u ? mine : 1u; nx = cnt > 0u ? cnt : 1u;
}

__device__ __forceinline__ void xcd_barrier(const XcdBarrier& b) {
    asm volatile("s_waitcnt vmcnt(0)" ::: "memory");
    __syncthreads();
    if (threadIdx.x == 0) {
        unsigned* bar = b.bar;
        __builtin_amdgcn_s_waitcnt(0);
        unsigned nloc = b.st[0], nx = b.st[1];
        if (nloc == 0u) { xcd_barrier_complete(bar, b.x, nloc, nx); b.st[0] = nloc; b.st[1] = nx; }
        const unsigned old = xb_add(&bar[XB_XSUB(b.x)], 1u);
        const unsigned gen = old / nloc;
        if (old + 1u == (gen + 1u) * nloc) {
            __builtin_amdgcn_fence(__ATOMIC_RELEASE, "agent");
            asm volatile("s_waitcnt vmcnt(0)" ::: "memory");
            const unsigned og = xb_add(&bar[XB_TOP], 1u);
            const unsigned tg = og / nx;
            if (og + 1u == (tg + 1u) * nx) xb_add(&bar[XB_TOPGEN], 1u);
            else XB_SPIN(xb_ld(&bar[XB_TOPGEN]) == tg, bar);
            __builtin_amdgcn_fence(__ATOMIC_ACQUIRE, "agent");
            xb_add(&bar[XB_XGEN(b.x)], 1u);
            asm volatile("s_waitcnt vmcnt(0)" ::: "memory");
        } else {
            XB_SPIN(xb_ld(&bar[XB_XGEN(b.x)]) == gen, bar);
            __builtin_amdgcn_fence(__ATOMIC_ACQUIRE, "agent");
            asm volatile("s_waitcnt vmcnt(0)" ::: "memory");
        }
    }
    __syncthreads();
}

struct Ctx {
    LAS unsigned char* lds; const float* const* in; float* out; unsigned char* ws;
    int tid, lane, wave, G, bid;
};
#define WSP(T, off) ((T*)(C.ws + (off)))
enum { I_X = 0, I_C = 1, I_CTX = 2, I_CCTX = 3, I_L0 = 4, I_L1 = 25 };
enum { A_W = 0, A_B = 1, N1 = 2, N2 = 3, W_IN = 4 };
enum { E_QN = 5, E_KN = 6, E_RPB = 7, E_CW = 8, E_CB = 9, E_GB = 10, E_HN = 11, E_WOUT = 12, E_RW = 13 };
enum { O_QN = 5, O_KN = 6, O_LAM = 7, O_SUB = 8, O_WOUT = 9, O_RW = 10 };
__device__ __forceinline__ const float* in_row(const Ctx& C, int r) { const int b = r / TT, t = r - b * TT;
    return t < LCTX ? C.in[I_CTX] + ((size_t)b * LCTX + t) * D : C.in[I_X] + ((size_t)b * SEQ + (t - LCTX)) * D; }
__device__ __forceinline__ const float* mod_row(const Ctx& C, int layer, int r) { const int b = r / TT, t = r - b * TT;
    return WSP(const float, WS_MOD) + ((size_t)layer * 3 + (t < LCTX ? 2 : b)) * (6 * D); }

__device__ __forceinline__ void transpose_item(const float* W, int K, int N, bf16* WT, int k0, int n0, int dst_row0, LAS float* scr, int lane) {
#pragma unroll 8
    for (int i = 0; i < 32; ++i) { const int kk = 2 * i + (lane >> 5); scr[kk * 33 + (lane & 31)] = W[(size_t)(k0 + kk) * N + n0 + (lane & 31)]; }
    LDS_WAIT(); asm volatile("" ::: "memory");
    const int c = lane & 7;
#pragma unroll
    for (int j = 0; j < 4; ++j) { const int n = (lane >> 3) + 8 * j; const LAS float* s = scr + (8 * c) * 33 + n;
        v4u o; o.x = pk2(s[0 * 33], s[1 * 33]); o.y = pk2(s[2 * 33], s[3 * 33]); o.z = pk2(s[4 * 33], s[5 * 33]); o.w = pk2(s[6 * 33], s[7 * 33]);
        *(v4u*)(WT + (size_t)(dst_row0 + n) * K + k0 + 8 * c) = o; }
    LDS_WAIT(); asm volatile("" ::: "memory");
}
__device__ __forceinline__ void p0_prologue(const Ctx& C) {
    LAS float* sv = (LAS float*)C.lds;
    LAS float* red = sv + 3 * D;
    for (int i = C.tid; i < 3 * D; i += NTHR) { const int r = i / D, k = i - r * D; const float v = r < 2 ? C.in[I_C][r * D + k] : C.in[I_CCTX][k]; sv[i] = v / (1.f + expf(-v)); }
    __syncthreads();
    for (int item = C.bid; item < 2 * 192; item += C.G) {
        const int layer = item / 192, c0 = (item % 192) * 64; const float* W = C.in[(layer ? I_L1 : I_L0) + A_W]; const float* bia = C.in[(layer ? I_L1 : I_L0) + A_B];
        const int cg = C.tid & 15, ks = C.tid >> 4; float acc[3][4] = {};
        for (int k = ks * 64; k < ks * 64 + 64; ++k) { const f32x4 w = *(const f32x4*)(W + (size_t)k * (6 * D) + c0 + cg * 4);
#pragma unroll
            for (int r = 0; r < 3; ++r) { const float s = sv[r * D + k]; acc[r][0] += s * w.x; acc[r][1] += s * w.y; acc[r][2] += s * w.z; acc[r][3] += s * w.w; } }
#pragma unroll
        for (int r = 0; r < 3; ++r)
#pragma unroll
            for (int j = 0; j < 4; ++j) red[(ks * 3 + r) * 64 + cg * 4 + j] = acc[r][j];
        __syncthreads();
        if (C.tid < 192) { const int r = C.tid / 64, cc = C.tid % 64; float s = 0.f; for (int q = 0; q < 32; ++q) s += red[(q * 3 + r) * 64 + cc];
            WSP(float, WS_MOD)[((size_t)layer * 3 + r) * (6 * D) + c0 + cc] = s + bia[c0 + cc]; }
        __syncthreads();
    }
    for (int i = C.bid * NTHR + C.tid; i < SEQ * 64; i += C.G * NTHR) { const int t = i >> 6, f = i & 63; const float inv = powf(10000.f, -(float)(f & 31) / 32.f);
        const float ang = (float)(f < 32 ? t / GW : t % GW) * inv; WSP(float, WS_ROPE)[i] = cosf(ang); WSP(float, WS_ROPE)[SEQ * 64 + i] = sinf(ang); }
    LAS float* scr = (LAS float*)(C.lds + C.wave * 16384);
    const int gw = C.bid * NWAVES + C.wave, NGW = C.G * NWAVES;
    constexpr int I_IN0 = 32 * (NIN0 / 32), I_OUT = 32 * 64, I_IN1 = 32 * (NIN1 / 32), I_GU = 32 * 16  , I_DN = 8 * 64;
    constexpr int PER_L = 65 * (2 * I_GU + I_DN), NITEMS = I_IN0 + I_OUT + I_IN1 + I_OUT + 2 * PER_L;
    __syncthreads();
    for (int it = gw; it < NITEMS; it += NGW) {
        int r = it;
        if (r < I_IN0) { const int nb = NIN0 / 32, kb = r / nb, n0 = (r % nb) * 32; transpose_item(C.in[I_L0 + W_IN], D, NIN0, WSP(bf16, WS_WIN0), kb * 64, n0, n0, scr, C.lane); continue; } r -= I_IN0;
        if (r < I_OUT) { const int kb = r / 64, n0 = (r % 64) * 32; transpose_item(C.in[I_L0 + E_WOUT], D, D, WSP(bf16, WS_WOUT0), kb * 64, n0, n0, scr, C.lane); continue; } r -= I_OUT;
        if (r < I_IN1) { const int nb = NIN1 / 32, kb = r / nb, n0 = (r % nb) * 32; transpose_item(C.in[I_L1 + W_IN], D, NIN1, WSP(bf16, WS_WIN1), kb * 64, n0, n0, scr, C.lane); continue; } r -= I_IN1;
        if (r < I_OUT) { const int kb = r / 64, n0 = (r % 64) * 32; transpose_item(C.in[I_L1 + O_WOUT], D, D, WSP(bf16, WS_WOUT1), kb * 64, n0, n0, scr, C.lane); continue; } r -= I_OUT;
        const int layer = r / PER_L; r -= layer * PER_L; const int rb = (layer ? I_L1 + O_RW : I_L0 + E_RW);
        const int e = r / (2 * I_GU + I_DN); r -= e * (2 * I_GU + I_DN);
        if (r < 2 * I_GU) { const int s = r / I_GU, q = r % I_GU, kb = q / 16, n0 = (q % 16) * 32;
            const float* W = e < NE ? C.in[rb + 2 + s] + (size_t)e * D * DE : C.in[rb + 5 + s];
            bf16* WT = WSP(bf16, WS_W1T) + ((size_t)layer * 65 + e) * (1024 * (size_t)D);
            transpose_item(W, D, DE, WT, kb * 64, n0, 256 * (n0 / 128) + 128 * s + (n0 % 128), scr, C.lane); continue; }
        r -= 2 * I_GU;
        { const int kb = r / 64, n0 = (r % 64) * 32; const float* W = e < NE ? C.in[rb + 4] + (size_t)e * DE * D : C.in[rb + 7];
          bf16* WT = WSP(bf16, WS_W2T) + ((size_t)layer * 65 + e) * ((size_t)D * DE);
          transpose_item(W, DE, D, WT, kb * 64, n0, n0, scr, C.lane); }
    }
}

__device__ __forceinline__ void norm_mod_row(f32x4 (&v)[8], const float* gain, const float* shift, const float* scale, int lane) {
    float s = 0.f;
#pragma unroll
    for (int j = 0; j < 8; ++j) s += (v[j].x * v[j].x + v[j].y * v[j].y) + (v[j].z * v[j].z + v[j].w * v[j].w);
    const float r = 1.f / sqrtf(wave_sum(s) * (1.f / D) + EPS);
#pragma unroll
    for (int j = 0; j < 8; ++j) { const int c = 4 * lane + 256 * j; const f32x4 g = *(const f32x4*)(gain + c), sh = *(const f32x4*)(shift + c), sc = *(const f32x4*)(scale + c);
        v[j] = v[j] * r * g * (sc + 1.f) + sh; }
}
__device__ __forceinline__ void store_row_bf16(bf16* o, const f32x4 (&v)[8], int lane) {
#pragma unroll
    for (int j = 0; j < 8; ++j) { v2u w; w.x = pk2(v[j].x, v[j].y); w.y = pk2(v[j].z, v[j].w); *(v2u*)(o + 4 * lane + 256 * j) = w; }
}
__device__ __forceinline__ void p_norm1_l0(const Ctx& C) {
    const int gw = C.bid * NWAVES + C.wave, NGW = C.G * NWAVES;
    for (int r = gw; r < M0; r += NGW) { const float* x = in_row(C, r); f32x4 v[8];
#pragma unroll
        for (int j = 0; j < 8; ++j) v[j] = *(const f32x4*)(x + 4 * C.lane + 256 * j);
        const float* md = mod_row(C, 0, r); norm_mod_row(v, C.in[I_L0 + N1], md + 0 * D, md + 1 * D, C.lane);
        store_row_bf16(WSP(bf16, WS_HB) + (size_t)r * D, v, C.lane); }
}
__device__ __forceinline__ void p_prep_l0(const Ctx& C) {
    const int gw = C.bid * NWAVES + C.wave, NGW = C.G * NWAVES, lane = C.lane;
    const bf16* PB = WSP(const bf16, WS_PROJ); bf16* QN = WSP(bf16, WS_QK); bf16* KN = QN + (size_t)M0 * 1024; bf16* MQ = KN + (size_t)M0 * 1024; bf16* MK = MQ + (size_t)M0 * 1024;
    float* LI = WSP(float, WS_GATE); float* LF = LI + 2 * NB * 8 * TT;
    for (int r = gw; r < M0; r += NGW) { const int b = r / TT, t = r - b * TT; const bf16* pr = PB + (size_t)r * NIN0P;
#pragma unroll
        for (int qk = 0; qk < 2; ++qk) { const v4u a = *(const v4u*)(pr + (qk ? C_NAK : C_NAQ) + 16 * lane), bq = *(const v4u*)(pr + (qk ? C_NAK : C_NAQ) + 16 * lane + 8);
            float f[16]; const unsigned w[8] = {a.x, a.y, a.z, a.w, bq.x, bq.y, bq.z, bq.w}; float s = 0.f;
#pragma unroll
            for (int i = 0; i < 8; ++i) { f[2 * i] = bf2f(w[i] & 0xffffu); f[2 * i + 1] = bf2f(w[i] >> 16); s += f[2 * i] * f[2 * i] + f[2 * i + 1] * f[2 * i + 1]; }
            s += __shfl_xor(s, 1); s += __shfl_xor(s, 2); s += __shfl_xor(s, 4);
            const float rr = 1.f / sqrtf(s * (1.f / 128.f) + EPS); const float* g = C.in[I_L0 + (qk ? E_KN : E_QN)] + (16 * lane) % 128; unsigned o[8];
#pragma unroll
            for (int i = 0; i < 8; ++i) o[i] = pk2(f[2 * i] * rr * g[2 * i], f[2 * i + 1] * rr * g[2 * i + 1]);
            bf16* dst = (qk ? KN : QN) + (size_t)r * 1024 + 16 * lane; *(v4u*)dst = (v4u){o[0], o[1], o[2], o[3]}; *(v4u*)(dst + 8) = (v4u){o[4], o[5], o[6], o[7]}; }
        { const int seg_lo = t < LCTX ? 0 : LCTX, seg_hi = t < LCTX ? LCTX : TT; const float* cw = C.in[I_L0 + E_CW]; const float* cb = C.in[I_L0 + E_CB]; const int c0 = 32 * lane;
          float acc[32];
#pragma unroll
          for (int i = 0; i < 32; ++i) acc[i] = cb[c0 + i];
#pragma unroll
          for (int j = 0; j < 5; ++j) { const int tt = t + j - 2; if (tt < seg_lo || tt >= seg_hi) continue; const bf16* src = PB + ((size_t)b * TT + tt) * NIN0P + C_MLQK + c0;
#pragma unroll
              for (int q = 0; q < 4; ++q) { const v4u a = *(const v4u*)(src + 8 * q); const unsigned w[4] = {a.x, a.y, a.z, a.w};
#pragma unroll
                  for (int i = 0; i < 4; ++i) { acc[8 * q + 2 * i] += cw[j * 2048 + c0 + 8 * q + 2 * i] * bf2f(w[i] & 0xffffu); acc[8 * q + 2 * i + 1] += cw[j * 2048 + c0 + 8 * q + 2 * i + 1] * bf2f(w[i] >> 16); } } }
          const float ksc = lane >= 32 ? 0.08838834764831845f : 1.f;
          bf16* dst = (lane >= 32 ? MK + (size_t)r * 1024 + (c0 - 1024) : MQ + (size_t)r * 1024 + c0);
#pragma unroll
          for (int q = 0; q < 4; ++q) { v4u o; unsigned ow[4];
#pragma unroll
              for (int i = 0; i < 4; ++i) ow[i] = pk2(siluf(acc[8 * q + 2 * i]) * ksc, siluf(acc[8 * q + 2 * i + 1]) * ksc);
              o = (v4u){ow[0], ow[1], ow[2], ow[3]}; *(v4u*)(dst + 8 * q) = o; } }
        if (lane < 32) { const float g = bf2f(pr[C_MLG + lane]) + C.in[I_L0 + E_GB][lane]; const int dir = lane >> 4, isf = (lane >> 3) & 1, h = lane & 7;
            const size_t idx = (((size_t)dir * NB + b) * 8 + h) * TT + t;
            if (isf) LF[idx] = fminf(g, 0.f) - log1pf(expf(-fabsf(g))); else LI[idx] = g; }
    }
}
__device__ __forceinline__ void p_mlfin_l0(const Ctx& C) {
    const int gw = C.bid * NWAVES + C.wave, NGW = C.G * NWAVES, lane = C.lane;
    const float* HM = WSP(const float, WS_HM); const bf16* PB = WSP(const bf16, WS_PROJ); bf16* AO = WSP(bf16, WS_AO);
    for (int r = gw; r < M0; r += NGW) { float f[16]; float s = 0.f;
#pragma unroll
        for (int q = 0; q < 4; ++q) { const f32x4 a = *(const f32x4*)(HM + (size_t)r * 1024 + 16 * lane + 4 * q), bq = *(const f32x4*)(HM + (size_t)(M0 + r) * 1024 + 16 * lane + 4 * q);
            f[4 * q] = a.x + bq.x; f[4 * q + 1] = a.y + bq.y; f[4 * q + 2] = a.z + bq.z; f[4 * q + 3] = a.w + bq.w; }
#pragma unroll
        for (int i = 0; i < 16; ++i) s += f[i] * f[i];
        s += __shfl_xor(s, 1); s += __shfl_xor(s, 2); s += __shfl_xor(s, 4);
        const float rr = 1.f / sqrtf(s * (1.f / 128.f) + EPS); const float* g = C.in[I_L0 + E_HN] + 16 * lane; const bf16* mo = PB + (size_t)r * NIN0P + C_MLO + 16 * lane; unsigned o[8];
#pragma unroll
        for (int i = 0; i < 8; ++i) o[i] = pk2(f[2 * i] * rr * g[2 * i] * sigmf(bf2f(mo[2 * i])), f[2 * i + 1] * rr * g[2 * i + 1] * sigmf(bf2f(mo[2 * i + 1])));
        bf16* dst = AO + (size_t)r * D + 1024 + 16 * lane; *(v4u*)dst = (v4u){o[0], o[1], o[2], o[3]}; *(v4u*)(dst + 8) = (v4u){o[4], o[5], o[6], o[7]}; }
}
__device__ __forceinline__ void p_prep_l1(const Ctx& C) {
    const int gw = C.bid * NWAVES + C.wave, NGW = C.G * NWAVES, lane = C.lane;
    const bf16* PB = WSP(const bf16, WS_PROJ); bf16* Q1 = WSP(bf16, WS_QK); bf16* K1 = Q1 + (size_t)32 * SEQ * 128;
    const float* rc = WSP(const float, WS_ROPE); const float* rs = rc + SEQ * 64;
    for (int r = gw; r < M0; r += NGW) { const int b = r / TT, t = r - b * TT; const bool lat = t >= LCTX; const int s = t - LCTX;
#pragma unroll
        for (int qk = 0; qk < 2; ++qk) { if (qk == 0 && !lat) continue;
            const bf16* src = PB + (size_t)r * NIN1 + qk * 2048 + 32 * lane; float f[32]; float ss = 0.f;
#pragma unroll
            for (int q = 0; q < 4; ++q) { const v4u a = *(const v4u*)(src + 8 * q); const unsigned w[4] = {a.x, a.y, a.z, a.w};
#pragma unroll
                for (int i = 0; i < 4; ++i) { f[8 * q + 2 * i] = bf2f(w[i] & 0xffffu); f[8 * q + 2 * i + 1] = bf2f(w[i] >> 16); } }
#pragma unroll
            for (int i = 0; i < 32; ++i) ss += f[i] * f[i];
            ss += __shfl_xor(ss, 1); ss += __shfl_xor(ss, 2);
            const float rr = 1.f / sqrtf(ss * (1.f / 128.f) + EPS); const int d0 = 32 * (lane & 3); const float* g = C.in[I_L1 + (qk ? O_KN : O_QN)] + d0;
#pragma unroll
            for (int i = 0; i < 32; ++i) f[i] = f[i] * rr * g[i];
            if (lat) {
                const float sgn = (lane & 2) ? 1.f : -1.f; const float* cr = rc + (size_t)s * 64 + (d0 & 63); const float* sr = rs + (size_t)s * 64 + (d0 & 63);
#pragma unroll
                for (int i = 0; i < 32; ++i) { const float p = __shfl_xor(f[i], 2); f[i] = f[i] * cr[i] + sgn * p * sr[i]; } }
            const int hi = lane >> 2; bf16* dst = qk ? K1 + (((size_t)b * 16 + hi) * TT + t) * 128 + d0 : Q1 + (((size_t)b * 16 + hi) * SEQ + s) * 128 + d0;
#pragma unroll
            for (int q = 0; q < 4; ++q) { unsigned ow[4];
#pragma unroll
                for (int i = 0; i < 4; ++i) ow[i] = pk2(f[8 * q + 2 * i], f[8 * q + 2 * i + 1]);
                *(v4u*)(dst + 8 * q) = (v4u){ow[0], ow[1], ow[2], ow[3]}; } }
    }
}
__device__ __forceinline__ bf16x8 ld_frag(const LAS bf16* base, int ld, int x0, int k0, int lane) { return *(const LAS bf16x8*)(base + (x0 + (lane & 15)) * ld + k0 + 8 * (lane >> 4)); }
#define MFMA16(a, b, c) __builtin_amdgcn_mfma_f32_16x16x32_bf16((a), (b), (c), 0, 0, 0)
__device__ __forceinline__ float grp16_max(float v) { v = fmaxf(v, __shfl_xor(v, 1)); v = fmaxf(v, __shfl_xor(v, 2)); v = fmaxf(v, __shfl_xor(v, 4)); v = fmaxf(v, __shfl_xor(v, 8)); return v; }
__device__ __forceinline__ float grp16_sum(float v) { v += __shfl_xor(v, 1); v += __shfl_xor(v, 2); v += __shfl_xor(v, 4); v += __shfl_xor(v, 8); return v; }
constexpr int LDK = 136, LDT = 72;
constexpr float NEG_BIG = -1e30f;

template <int DV> struct AttnState { f32x4 o[DV / 16]; float m[4], l[4];
    __device__ __forceinline__ void init() {
#pragma unroll
        for (int n = 0; n < DV / 16; ++n) o[n] = (f32x4){0.f, 0.f, 0.f, 0.f};
#pragma unroll
        for (int i = 0; i < 4; ++i) { m[i] = NEG_BIG; l[i] = 0.f; } } };
template <int DV, class Bias> __device__ __forceinline__ void attn_tile(AttnState<DV>& st, const bf16x8 (&qf)[4], const LAS bf16* sK, const LAS bf16* sVt, LAS bf16* sP, float scale, const Bias& bias, int lane) {
    f32x4 s[4];
#pragma unroll
    for (int j = 0; j < 4; ++j) { s[j] = (f32x4){0.f, 0.f, 0.f, 0.f};
#pragma unroll
        for (int ks = 0; ks < 4; ++ks) s[j] = MFMA16(qf[ks], ld_frag(sK, LDK, 16 * j, 32 * ks, lane), s[j]); }
    float alpha[4];
#pragma unroll
    for (int i = 0; i < 4; ++i) { float v[4]; bool ok[4]; float mx = NEG_BIG;
#pragma unroll
        for (int j = 0; j < 4; ++j) { const float bb = bias(i, j); ok[j] = bb > -1e29f; v[j] = s[j][i] * scale + bb; mx = ok[j] ? fmaxf(mx, v[j]) : mx; }
        mx = grp16_max(mx); const float mn = fmaxf(st.m[i], mx); alpha[i] = __expf(st.m[i] - mn); st.m[i] = mn; float ps = 0.f;
#pragma unroll
        for (int j = 0; j < 4; ++j) { const float p = ok[j] ? __expf(v[j] - mn) : 0.f; ps += p; sP[(4 * (lane >> 4) + i) * LDT + 16 * j + (lane & 15)] = (bf16)f2bf(p); }
        st.l[i] = st.l[i] * alpha[i] + ps; }
#pragma unroll
    for (int n = 0; n < DV / 16; ++n) { st.o[n][0] *= alpha[0]; st.o[n][1] *= alpha[1]; st.o[n][2] *= alpha[2]; st.o[n][3] *= alpha[3]; }
    LDS_WAIT(); __builtin_amdgcn_wave_barrier();
#pragma unroll
    for (int ks = 0; ks < 2; ++ks) { const bf16x8 pa = ld_frag(sP, LDT, 0, 32 * ks, lane);
#pragma unroll
        for (int n = 0; n < DV / 16; ++n) st.o[n] = MFMA16(pa, ld_frag(sVt, LDT, 16 * n, 32 * ks, lane), st.o[n]); }
    LDS_WAIT(); __builtin_amdgcn_wave_barrier();
}
template <int DV> __device__ __forceinline__ void stage_kv(LAS bf16* sK, LAS bf16* sVt, const bf16* kp, size_t kld, const bf16* vp, size_t vld, int tid) {
    for (int c = tid; c < 64 * 16; c += NTHR) { const int key = c >> 4, ch = c & 15; *(LAS v4u*)(sK + key * LDK + 8 * ch) = *(const v4u*)(kp + (size_t)key * kld + 8 * ch); }
    for (int c = tid; c < 64 * (DV / 8); c += NTHR) { const int key = c / (DV / 8), ch = c % (DV / 8); const v4u a = *(const v4u*)(vp + (size_t)key * vld + 8 * ch); const unsigned w[4] = {a.x, a.y, a.z, a.w};
#pragma unroll
        for (int i = 0; i < 4; ++i) { sVt[(8 * ch + 2 * i) * LDT + key] = (bf16)(w[i] & 0xffffu); sVt[(8 * ch + 2 * i + 1) * LDT + key] = (bf16)(w[i] >> 16); } }
}
__device__ __forceinline__ void load_qfrag(bf16x8 (&qf)[4], const bf16* qrow0, size_t qld, int lane) {
#pragma unroll
    for (int ks = 0; ks < 4; ++ks) qf[ks] = *(const bf16x8*)(qrow0 + (size_t)(lane & 15) * qld + 32 * ks + 8 * (lane >> 4));
}
struct NoBias { __device__ __forceinline__ float operator()(int, int) const { return 0.f; } };

struct NaBias { const LAS float* rpb; int dr  , w0  ; int lane;
    __device__ __forceinline__ float operator()(int i, int j) const { const int w = w0 + i, col = 16 * j + (lane & 15); int c0 = w - 8; c0 = c0 < 0 ? 0 : (c0 > 48 ? 48 : c0);
        return (col >= c0 && col < c0 + 16) ? rpb[dr * 31 + (col - w + 15)] : NEG_BIG; } };
__device__ __forceinline__ void p_na_l0(const Ctx& C) {
    LAS bf16* sK = (LAS bf16*)C.lds; LAS bf16* sVt = sK + 64 * LDK; LAS bf16* sP = sVt + 128 * LDT + C.wave * (16 * LDT); LAS float* sRpb = (LAS float*)(C.lds + 65536);
    const bf16* PB = WSP(const bf16, WS_PROJ); const bf16* QN = WSP(const bf16, WS_QK); const bf16* KN = QN + (size_t)M0 * 1024; bf16* AO = WSP(bf16, WS_AO);
    const float scale = 0.08838834764831845f; const int lane = C.lane, wave = C.wave;
    for (int u = C.bid; u < 512 + 32; u += C.G) {
        const bool ctxq = u >= 512; const int v = ctxq ? u - 512 : u; const int b = ctxq ? v / 16 : v / 256, h = ctxq ? (v / 2) % 8 : (v / 32) % 8, rp = v % 32;
        const size_t rowb = (size_t)b * TT;
        int r = 0, q0; if (ctxq) q0 = 128 * (v & 1) + 16 * wave; else { r = 2 * rp + (wave >> 2); q0 = LCTX + r * 64 + 16 * (wave & 3); }
        bf16x8 qf[4]; load_qfrag(qf, QN + (rowb + q0) * 1024 + h * 128, 1024, lane);
        AttnState<128> st; st.init();
        int kr0 = r - 4; kr0 = kr0 < 0 ? 0 : (kr0 > 56 ? 56 : kr0);
        int lo = 2 * rp - 4; lo = lo < 0 ? 0 : (lo > 56 ? 56 : lo); int hi = 2 * rp + 1 - 4; hi = (hi < 0 ? 0 : (hi > 56 ? 56 : hi)) + 7;
        const int nloc = ctxq ? 0 : hi - lo + 1;
        __syncthreads();
        if (!ctxq) for (int i = C.tid; i < 15 * 31; i += NTHR) sRpb[i] = C.in[I_L0 + E_RPB][h * 465 + i];
        for (int tl = 0; tl < nloc + 4; ++tl) {
            const bool loc = tl < nloc; const int kr = lo + tl; const size_t krow = rowb + (loc ? LCTX + kr * 64 : (tl - nloc) * 64);
            __syncthreads();
            stage_kv<128>(sK, sVt, KN + krow * 1024 + h * 128, 1024, PB + krow * NIN0P + C_NAV + h * 128, NIN0P, C.tid);
            __syncthreads();
            if (loc) { if (kr >= kr0 && kr < kr0 + 8) { NaBias nb{sRpb, kr - r + 7, 16 * (wave & 3) + 4 * (lane >> 4), lane}; attn_tile<128>(st, qf, sK, sVt, sP, scale, nb, lane); } }
            else attn_tile<128>(st, qf, sK, sVt, sP, scale, NoBias(), lane);
        }
#pragma unroll
        for (int i = 0; i < 4; ++i) { const float inv = 1.f / grp16_sum(st.l[i]); bf16* dst = AO + (rowb + q0 + 4 * (lane >> 4) + i) * D + h * 128 + (lane & 15);
#pragma unroll
            for (int n = 0; n < 8; ++n) dst[16 * n] = (bf16)f2bf(st.o[n][i] * inv); }
    }
}
__device__ __forceinline__ void p_da_l1(const Ctx& C) {
    LAS bf16* sK = (LAS bf16*)C.lds; LAS bf16* sVt = sK + 64 * LDK; LAS bf16* sP = sVt + 256 * LDT + C.wave * (16 * LDT);
    const bf16* PB = WSP(const bf16, WS_PROJ); const bf16* Q1 = WSP(const bf16, WS_QK); const bf16* K1 = Q1 + (size_t)32 * SEQ * 128; bf16* AO = WSP(bf16, WS_AO);
    const float scale = 0.08838834764831845f, linit = 0.35550906759096926f; const int lane = C.lane, wave = C.wave;
    float lamf; { const float* lm = C.in[I_L1 + O_LAM]; float a = 0.f, bq = 0.f; for (int i = 0; i < 128; ++i) { a += lm[i] * lm[128 + i]; bq += lm[256 + i] * lm[384 + i]; } lamf = expf(a) - expf(bq) + linit; }
    for (int u = C.bid; u < 512; u += C.G) { const int b = u / 256, h = (u / 32) % 8, qb = u % 32; const int s0 = 128 * qb + 16 * wave;
        f32x4 keep[16];
#pragma unroll
        for (int pass = 0; pass < 2; ++pass) { const size_t hi = (size_t)b * 16 + h * 2 + pass;
            bf16x8 qf[4]; load_qfrag(qf, Q1 + (hi * SEQ + s0) * 128, 128, lane);
            AttnState<256> st; st.init();
            for (int kt = 0; kt < TT / 64; ++kt) { __syncthreads();
                stage_kv<256>(sK, sVt, K1 + (hi * TT + kt * 64) * 128, 128, PB + ((size_t)b * TT + kt * 64) * NIN1 + 4096 + h * 256, NIN1, C.tid);
                __syncthreads();
                attn_tile<256>(st, qf, sK, sVt, sP, scale, NoBias(), lane); }
            float inv[4];
#pragma unroll
            for (int i = 0; i < 4; ++i) inv[i] = 1.f / grp16_sum(st.l[i]);
#pragma unroll
            for (int n = 0; n < 16; ++n)
#pragma unroll
                for (int i = 0; i < 4; ++i) { const float val = st.o[n][i] * inv[i]; keep[n][i] = pass == 0 ? val : keep[n][i] - lamf * val; }
        }
        const float* sg = C.in[I_L1 + O_SUB];
#pragma unroll
        for (int i = 0; i < 4; ++i) { float ss = 0.f;
#pragma unroll
            for (int n = 0; n < 16; ++n) ss += keep[n][i] * keep[n][i];
            ss = grp16_sum(ss); const float rr = (1.f - linit) / sqrtf(ss * (1.f / 256.f) + EPS);
            bf16* dst = AO + ((size_t)b * SEQ + s0 + 4 * (lane >> 4) + i) * D + h * 256 + (lane & 15);
#pragma unroll
            for (int n = 0; n < 16; ++n) dst[16 * n] = (bf16)f2bf(keep[n][i] * rr * sg[16 * n + (lane & 15)]); }
    }
}
__device__ __forceinline__ void p_mlstm_l0(const Ctx& C) {
    LAS bf16* sQ = (LAS bf16*)C.lds; LAS bf16* sK = sQ + 64 * LDK; LAS bf16* sKw = sK + 64 * LDK; LAS bf16* sVt = sKw + 128 * LDT; LAS bf16* sP = sVt + 48 * LDT; LAS bf16* sCt = sP + 64 * LDT;
    LAS float* sNum = (LAS float*)(sCt + 48 * LDK); LAS float* sA = sNum + 64 * 49; LAS float* sM = sA + 64; LAS float* sWI = sM + 64; LAS float* sFl = sWI + 64; LAS float* sWG = sFl + 64; LAS float* sDec = sWG + 64;
    const bf16* PB = WSP(const bf16, WS_PROJ); const bf16* MQ = WSP(const bf16, WS_QK) + (size_t)2 * M0 * 1024; const bf16* MK = MQ + (size_t)M0 * 1024;
    const float* LI = WSP(const float, WS_GATE); const float* LF = LI + 2 * NB * 8 * TT; float* HM = WSP(float, WS_HM);
    const int lane = C.lane, wave = C.wave, tid = C.tid;
    for (int u = C.bid; u < 128; u += C.G) { const int sl = u & 3, dir = (u >> 2) & 1, h = (u >> 3) & 7, b = u >> 6; const size_t rowb = (size_t)b * TT;
        const float* li = LI + (((size_t)dir * NB + b) * 8 + h) * TT; const float* lf = LF + (((size_t)dir * NB + b) * 8 + h) * TT;
        f32x4 cT[3] = {(f32x4){0.f, 0.f, 0.f, 0.f}, (f32x4){0.f, 0.f, 0.f, 0.f}, (f32x4){0.f, 0.f, 0.f, 0.f}}; float m = 0.f;
        __syncthreads();
        for (int i = tid; i < 48 * LDK; i += NTHR) sCt[i] = 0;
        for (int i = tid; i < 16 * LDT; i += NTHR) sVt[32 * LDT + i] = (i < 64) ? (bf16)0x3F80 : (bf16)0;
        for (int ch = 0; ch < TT / 64; ++ch) {
            const int p0 = 64 * ch; auto tok = [&](int j) { const int p = p0 + j; return dir == 0 ? p : (p < LCTX ? LCTX - 1 - p : TT - 1 - (p - LCTX)); };
            __syncthreads();
            if (wave == 0) { const int t = tok(lane); const float fi = li[t], ff = lf[t]; float bc = ff;
#pragma unroll
                for (int o = 1; o < 64; o <<= 1) { const float x = __shfl_up(bc, o); if (lane >= o) bc += x; }
                const float a = fi - bc; float pm = a;
#pragma unroll
                for (int o = 1; o < 64; o <<= 1) { const float x = __shfl_up(pm, o); if (lane >= o) pm = fmaxf(pm, x); }
                const float Mt = fmaxf(m, pm), M63 = __shfl(Mt, 63), bl = __shfl(bc, 63);
                sA[lane] = a; sM[lane] = Mt; sWI[lane] = __expf(m - Mt); sFl[lane] = __expf(-bc - Mt); sWG[lane] = __expf(a - M63); if (lane == 0) sDec[0] = __expf(m - M63);
                m = bl + M63; }
            for (int c = tid; c < 64 * 16; c += NTHR) { const int j = c >> 4, cq = c & 15; const size_t row = rowb + tok(j);
                *(LAS v4u*)(sQ + j * LDK + 8 * cq) = *(const v4u*)(MQ + row * 1024 + h * 128 + 8 * cq); *(LAS v4u*)(sK + j * LDK + 8 * cq) = *(const v4u*)(MK + row * 1024 + h * 128 + 8 * cq); }
            if (tid < 256) { const int j = tid >> 2, cq = tid & 3; const v4u a = *(const v4u*)(PB + (rowb + tok(j)) * NIN0P + C_MLV + h * 128 + 32 * sl + 8 * cq); const unsigned w[4] = {a.x, a.y, a.z, a.w};
#pragma unroll
                for (int i = 0; i < 4; ++i) { sVt[(8 * cq + 2 * i) * LDT + j] = (bf16)(w[i] & 0xffffu); sVt[(8 * cq + 2 * i + 1) * LDT + j] = (bf16)(w[i] >> 16); } }
            __syncthreads();
            for (int e = tid; e < 64 * 128; e += NTHR) { const int j = e >> 7, dk = e & 127; sKw[dk * LDT + j] = (bf16)f2bf(bf2f(sK[j * LDK + dk]) * sWG[j]); }
#pragma unroll
            for (int q = 0; q < 2; ++q) { const int tt = wave >> 1, stl = 2 * (wave & 1) + q; f32x4 s = (f32x4){0.f, 0.f, 0.f, 0.f};
                if (stl <= tt) {
#pragma unroll
                    for (int ks = 0; ks < 4; ++ks) s = MFMA16(ld_frag(sQ, LDK, 16 * tt, 32 * ks, lane), ld_frag(sK, LDK, 16 * stl, 32 * ks, lane), s); }
                const int sc = 16 * stl + (lane & 15); const float as = sA[sc];
#pragma unroll
                for (int i = 0; i < 4; ++i) { const int tr = 16 * tt + 4 * (lane >> 4) + i; const float p = (sc <= tr) ? s[i] * __expf(as - sM[tr]) : 0.f; sP[tr * LDT + sc] = (bf16)f2bf(p); } }
            __syncthreads();
#pragma unroll
            for (int q = 0; q < 2; ++q) { const int tile = wave + 8 * q; if (tile < 12) { const int tt = tile / 3, nt = tile % 3; f32x4 aq = (f32x4){0.f, 0.f, 0.f, 0.f}, ap = (f32x4){0.f, 0.f, 0.f, 0.f};
#pragma unroll
                for (int ks = 0; ks < 4; ++ks) aq = MFMA16(ld_frag(sQ, LDK, 16 * tt, 32 * ks, lane), ld_frag(sCt, LDK, 16 * nt, 32 * ks, lane), aq);
#pragma unroll
                for (int ks = 0; ks < 2; ++ks) ap = MFMA16(ld_frag(sP, LDT, 16 * tt, 32 * ks, lane), ld_frag(sVt, LDT, 16 * nt, 32 * ks, lane), ap);
#pragma unroll
                for (int i = 0; i < 4; ++i) { const int tr = 16 * tt + 4 * (lane >> 4) + i; sNum[tr * 49 + 16 * nt + (lane & 15)] = sWI[tr] * aq[i] + ap[i]; } } }
            { const float dec = sDec[0];
#pragma unroll
              for (int nt = 0; nt < 3; ++nt) { cT[nt] = cT[nt] * dec;
#pragma unroll
                  for (int ks = 0; ks < 2; ++ks) cT[nt] = MFMA16(ld_frag(sVt, LDT, 16 * nt, 32 * ks, lane), ld_frag(sKw, LDT, 16 * wave, 32 * ks, lane), cT[nt]); } }
            __syncthreads();
            for (int e = tid; e < 64 * 32; e += NTHR) { const int j = e >> 5, dv = e & 31; const float den = sNum[j * 49 + 32];
                HM[((size_t)dir * M0 + rowb + tok(j)) * 1024 + h * 128 + 32 * sl + dv] = sNum[j * 49 + dv] / fmaxf(fabsf(den), sFl[j]); }
#pragma unroll
            for (int nt = 0; nt < 3; ++nt)
#pragma unroll
                for (int i = 0; i < 4; ++i) sCt[(16 * nt + 4 * (lane >> 4) + i) * LDK + 16 * wave + (lane & 15)] = (bf16)f2bf(cT[nt][i]);
        }
    }
}
template <int MODE> struct EpiResid { static constexpr bool PERM = false, AFTER_DRAIN = false; Ctx C;
    __device__ __forceinline__ void operator()(const pg8::f32x4 (&acc)[2][2][4][2], const pg8::Unit& u, int wr, int wc, int fr, int fq) const {
        const int row0 = u.pm * 256 + wr * 64 + fr, col0 = u.pn * 256 + wc * 32 + 4 * fq; float* X = WSP(float, WS_X);
#pragma unroll
        for (int ai = 0; ai < 2; ++ai)
#pragma unroll
            for (int m = 0; m < 4; ++m) { const int r = row0 + ai * 128 + m * 16; int xr; const float* base; const float* gate;
                if (MODE == 0) { xr = r; base = in_row(C, r); gate = mod_row(C, 0, r) + 2 * D; }
                else { const int b = r / SEQ; xr = b * TT + LCTX + (r - b * SEQ); base = X + (size_t)xr * D; gate = WSP(const float, WS_MOD) + ((size_t)3 + b) * (6 * D) + 2 * D; }
#pragma unroll
                for (int bj = 0; bj < 2; ++bj)
#pragma unroll
                    for (int n = 0; n < 2; ++n) { const int c = col0 + bj * 128 + n * 16; const f32x4 bv = *(const f32x4*)(base + c), gv = *(const f32x4*)(gate + c);
                        *(f32x4*)(X + (size_t)xr * D + c) = bv + gv * acc[ai][bj][m][n]; } }
    } };
struct EpiSwiglu { static constexpr bool PERM = false, AFTER_DRAIN = false; bf16* act;
    __device__ __forceinline__ void operator()(const pg8::f32x4 (&acc)[2][2][4][2], const pg8::Unit& u, int wr, int wc, int fr, int fq) const {
        const int row0 = u.pm * 256 + wr * 64 + fr, col0 = (u.pn & 3) * 128 + wc * 32 + 4 * fq;
#pragma unroll
        for (int ai = 0; ai < 2; ++ai)
#pragma unroll
            for (int m = 0; m < 4; ++m) { bf16* rowp = act + (size_t)(row0 + ai * 128 + m * 16) * DE + col0;
#pragma unroll
                for (int n = 0; n < 2; ++n) { const f32x4 g = acc[ai][0][m][n], up = acc[ai][1][m][n]; v2u w; w.x = pk2(siluf(g[0]) * up[0], siluf(g[1]) * up[1]); w.y = pk2(siluf(g[2]) * up[2], siluf(g[3]) * up[3]);
                    *(v2u*)(rowp + n * 16) = w; } }
    } };
struct EpiBf16Mod { static constexpr bool PERM = true, AFTER_DRAIN = false; bf16* O; int ldc; int ntile_mask;
    __device__ __forceinline__ void operator()(const pg8::f32x4 (&acc)[2][2][4][2], const pg8::Unit& u, int wr, int wc, int fr, int fq) const {
        const int row0 = u.pm * 256 + wr * 64 + fr, col0 = (u.pn & ntile_mask) * 256 + wc * 32 + 8 * fq;
#pragma unroll
        for (int ai = 0; ai < 2; ++ai)
#pragma unroll
            for (int m = 0; m < 4; ++m) { bf16* rowp = O + (size_t)(row0 + ai * 128 + m * 16) * ldc + col0;
#pragma unroll
                for (int bj = 0; bj < 2; ++bj) { const f32x4 v0 = acc[ai][bj][m][0], v1 = acc[ai][bj][m][1]; v4u w; w.x = pk2(v0[0], v0[1]); w.y = pk2(v0[2], v0[3]); w.z = pk2(v1[0], v1[1]); w.w = pk2(v1[2], v1[3]);
                    *(v4u*)(rowp + bj * 128) = w; } }
    } };
struct MoeOrder { const int* tile_expert; int nunits, NT, G, c;
    __device__ __forceinline__ bool next(int i, pg8::Unit& u) const { const int L = i * G + c; if (L >= nunits) return false; const int mt = L / NT; u.pm = mt; u.pn = NT * tile_expert[mt] + (L - mt * NT); return true; }
    __device__ __forceinline__ void a_ready(const pg8::Unit&) const {}
    __device__ __forceinline__ void done(const pg8::Unit&) const {} };
struct SharedOrder { int nM, NT, G, c;
    __device__ __forceinline__ bool next(int i, pg8::Unit& u) const { const int L = i * G + c; if (L >= nM * NT) return false; u.pm = L / NT; u.pn = NT * 64 + L % NT; return true; }
    __device__ __forceinline__ void a_ready(const pg8::Unit&) const {}
    __device__ __forceinline__ void done(const pg8::Unit&) const {} };

template <int LAYER> __device__ __forceinline__ void p_norm2_route(const Ctx& C) {
    constexpr int ntok = LAYER ? M1 : M0; constexpr int IL = LAYER ? I_L1 : I_L0, RW = LAYER ? O_RW : E_RW;
    LAS float* sH = (LAS float*)C.lds;
    LAS float* sPart = sH + 8 * D;
    LAS float* sSc = sPart + 8 * 8 * 64;
    const float* X = WSP(const float, WS_X); bf16* H2 = WSP(bf16, WS_H2); unsigned* cnt = WSP(unsigned, WS_CTL) + (LAYER ? CW_CNT1 : CW_CNT0);
    int* TE = WSP(int, WS_ROUTE); int* TP = TE + M0 * TOPK; float* TW = (float*)(TP + M0 * TOPK);
    const float* rw = C.in[IL + RW]; const float* rb = C.in[IL + RW + 1]; const int lane = C.lane, wave = C.wave;
    for (int it = C.bid; it < ntok / 8; it += C.G) { const int i = it * 8 + wave; int xr; if (LAYER) { const int b = i / SEQ; xr = b * TT + LCTX + (i - b * SEQ); } else xr = i;
        __syncthreads();
        { f32x4 v[8]; const float* x = X + (size_t)xr * D;
#pragma unroll
          for (int j = 0; j < 8; ++j) v[j] = *(const f32x4*)(x + 4 * lane + 256 * j);
          const float* md = mod_row(C, LAYER, xr); norm_mod_row(v, C.in[IL + N2], md + 3 * D, md + 4 * D, lane);
          store_row_bf16(H2 + (size_t)i * D, v, lane);
#pragma unroll
          for (int j = 0; j < 8; ++j) *(LAS f32x4*)(sH + wave * D + 4 * lane + 256 * j) = v[j]; }
        __syncthreads();
        { float acc[8] = {}; const int k0 = wave * 256;
          for (int k = 0; k < 256; k += 4) { const float w0 = rw[(size_t)(k0 + k) * NE + lane], w1 = rw[(size_t)(k0 + k + 1) * NE + lane], w2 = rw[(size_t)(k0 + k + 2) * NE + lane], w3 = rw[(size_t)(k0 + k + 3) * NE + lane];
#pragma unroll
              for (int r = 0; r < 8; ++r) { const f32x4 hv = *(const LAS f32x4*)(sH + r * D + k0 + k); acc[r] += hv.x * w0 + hv.y * w1 + hv.z * w2 + hv.w * w3; } }
#pragma unroll
          for (int r = 0; r < 8; ++r) sPart[(wave * 8 + r) * 64 + lane] = acc[r]; }
        __syncthreads();
        { float s = 0.f;
#pragma unroll
          for (int w = 0; w < 8; ++w) s += sPart[(w * 8 + wave) * 64 + lane];
          const float score = 1.f / (1.f + expf(-s)); sSc[wave * 64 + lane] = score; const float sel = score + rb[lane];
          float m1 = sel, m2 = -3e38f;
#pragma unroll
          for (int o = 1; o < 8; o <<= 1) { const float a1 = __shfl_xor(m1, o), a2 = __shfl_xor(m2, o); const float hi = fmaxf(m1, a1), lo = fminf(m1, a1); m2 = fmaxf(lo, fmaxf(m2, a2)); m1 = hi; }
          const float gs = m1 + m2;
          int rank = 0; const int g = lane >> 3;
#pragma unroll
          for (int q = 0; q < 8; ++q) { const float og = __shfl(gs, q * 8); rank += (og > gs || (og == gs && q < g)) ? 1 : 0; }
          float cand = rank < 4 ? sel : -3e38f;
          int myj = -1;
          for (int j = 0; j < TOPK; ++j) { float bv = cand; int bi = lane;
#pragma unroll
              for (int o = 1; o < 64; o <<= 1) { const float ov = __shfl_xor(bv, o); const int oi = __shfl_xor(bi, o); if (ov > bv || (ov == bv && oi < bi)) { bv = ov; bi = oi; } }
              if (lane == bi) { myj = j; cand = -3e38f; } }
          float wsum = wave_sum(myj >= 0 ? score : 0.f);
          if (myj >= 0) { const unsigned pos = atomicAdd(&cnt[lane], 1u); TE[(size_t)i * TOPK + myj] = lane; TP[(size_t)i * TOPK + myj] = (int)pos; TW[(size_t)i * TOPK + myj] = score / wsum * 2.5f; } }
    }
}
template <int LAYER> __device__ __forceinline__ void p_moe_sort(const Ctx& C) {
    constexpr int ntok = LAYER ? M1 : M0;
    LAS int* sOff = (LAS int*)C.lds; const unsigned* cnt = WSP(const unsigned, WS_CTL) + (LAYER ? CW_CNT1 : CW_CNT0);
    __syncthreads();
    if (C.tid == 0) { int o = 0; for (int e = 0; e < NE; ++e) { sOff[e] = o; o += (int)((__hip_atomic_load(cnt + e, __ATOMIC_RELAXED, __HIP_MEMORY_SCOPE_AGENT) + 255u) & ~255u); } sOff[NE] = o; }
    __syncthreads();
    int* TEX = WSP(int, WS_ROUTE) + 4 * M0 * TOPK;
    if (C.bid == 0) { if (C.tid == 0) TEX[0] = sOff[NE] / 256; if (C.tid < NE) for (int mt = sOff[C.tid] / 256; mt < sOff[C.tid + 1] / 256; ++mt) TEX[1 + mt] = C.tid; }
    const int* TE = WSP(const int, WS_ROUTE); const int* TP = TE + M0 * TOPK; int* SR = WSP(int, WS_ROUTE) + 3 * M0 * TOPK;
    const bf16* H2 = WSP(const bf16, WS_H2); bf16* SA = WSP(bf16, WS_SA);
    const int gw = C.bid * NWAVES + C.wave, NGW = C.G * NWAVES;
    for (int i = gw; i < ntok; i += NGW) { v4u v[4];
#pragma unroll
        for (int q = 0; q < 4; ++q) v[q] = *(const v4u*)(H2 + (size_t)i * D + 8 * C.lane + 512 * q);
        for (int j = 0; j < TOPK; ++j) { const int row = sOff[TE[(size_t)i * TOPK + j]] + TP[(size_t)i * TOPK + j]; if (C.lane == 0) SR[(size_t)i * TOPK + j] = row;
#pragma unroll
            for (int q = 0; q < 4; ++q) *(v4u*)(SA + (size_t)row * D + 8 * C.lane + 512 * q) = v[q]; } }
}
template <int LAYER> __device__ __forceinline__ void p_moe_combine(const Ctx& C) {
    constexpr int ntok = LAYER ? M1 : M0;
    const int* SR = WSP(const int, WS_ROUTE) + 3 * M0 * TOPK; const float* TW = (const float*)(WSP(const int, WS_ROUTE) + 2 * M0 * TOPK);
    const bf16* Y = WSP(const bf16, WS_Y); const bf16* YS = WSP(const bf16, WS_YS); float* X = WSP(float, WS_X);
    const int gw = C.bid * NWAVES + C.wave, NGW = C.G * NWAVES, lane = C.lane;
    for (int i = gw; i < ntok; i += NGW) { int xr; if (LAYER) { const int b = i / SEQ; xr = b * TT + LCTX + (i - b * SEQ); } else xr = i;
        f32x4 acc[8];
#pragma unroll
        for (int j = 0; j < 8; ++j) { const v2u a = *(const v2u*)(YS + (size_t)i * D + 4 * lane + 256 * j); acc[j] = (f32x4){bf2f(a.x & 0xffffu), bf2f(a.x >> 16), bf2f(a.y & 0xffffu), bf2f(a.y >> 16)}; }
        for (int s = 0; s < TOPK; ++s) { const float w = TW[(size_t)i * TOPK + s]; const bf16* yr = Y + (size_t)SR[(size_t)i * TOPK + s] * D;
#pragma unroll
            for (int j = 0; j < 8; ++j) { const v2u a = *(const v2u*)(yr + 4 * lane + 256 * j); acc[j] += (f32x4){bf2f(a.x & 0xffffu), bf2f(a.x >> 16), bf2f(a.y & 0xffffu), bf2f(a.y >> 16)} * w; } }
        const float* gate = mod_row(C, LAYER, xr) + 5 * D; f32x4 v[8];
#pragma unroll
        for (int j = 0; j < 8; ++j) { const int c = 4 * lane + 256 * j; v[j] = *(const f32x4*)(X + (size_t)xr * D + c) + *(const f32x4*)(gate + c) * acc[j]; }
        if (LAYER) {
#pragma unroll
            for (int j = 0; j < 8; ++j) *(f32x4*)(C.out + (size_t)i * D + 4 * lane + 256 * j) = v[j]; }
        else {
#pragma unroll
            for (int j = 0; j < 8; ++j) *(f32x4*)(X + (size_t)xr * D + 4 * lane + 256 * j) = v[j];
            const float* md = mod_row(C, 1, xr); norm_mod_row(v, C.in[I_L1 + N1], md + 0 * D, md + 1 * D, lane); store_row_bf16(WSP(bf16, WS_HB) + (size_t)xr * D, v, lane); } }
}

constexpr int NPHASE = 21;
struct Args { const float* in[43]; float* out; unsigned char* ws; int ph_lo, ph_hi; };
__global__ void __launch_bounds__(NTHR, 2) fwd_kernel(Args args) {
    extern __shared__ __attribute__((aligned(16))) unsigned char lds_raw[];
    Ctx C; C.lds = (LAS unsigned char*)lds_raw; C.in = args.in; C.out = args.out; C.ws = args.ws;
    C.tid = threadIdx.x; C.lane = C.tid & 63; C.wave = __builtin_amdgcn_readfirstlane(C.tid >> 6); C.G = gridDim.x; C.bid = blockIdx.x;
    volatile LAS unsigned* MISC = (volatile LAS unsigned*)(C.lds + MISC_OFF);
    if (C.tid < 64) MISC[C.tid] = 0u;
    __syncthreads();
    const int lo = args.ph_lo, hi = args.ph_hi; const bool one = (hi - lo) > 1;
    XcdBarrier bar; bar.bar = WSP(unsigned, WS_CTL) + CW_BAR; bar.x = 0; bar.st = nullptr;
    if (one) bar = xcd_barrier_post(WSP(unsigned, WS_CTL) + CW_BAR, MISC + 8);
#define IN(k) (lo <= (k) && (k) < hi)
#define SEAM(k) do { if (IN(k) && IN((k) + 1)) xcd_barrier(bar); } while (0)
    LAS unsigned char* ring = C.lds;
    if (IN(0)) { p0_prologue(C); } SEAM(0);
    if (IN(1)) { p_norm1_l0(C); } SEAM(1);
    if (IN(2)) { pg8::Gemm g{WSP(const bf16, WS_HB), WSP(const bf16, WS_WIN0), M0, NIN0P, D}; pg8::StaticOrder S; S.init(M0, NIN0P, C.G, C.bid);
        pg8::EpiBf16<0> E{WSP(bf16, WS_PROJ), NIN0P, nullptr, 0, 0}; pg8::gemm_phase<pg8::EpiBf16<0>, pg8::StaticOrder>(ring, g, S, E, nullptr); } SEAM(2);
    if (IN(3)) { p_prep_l0(C); } SEAM(3);
    if (IN(4)) { p_na_l0(C); p_mlstm_l0(C); } SEAM(4);
    if (IN(5)) { p_mlfin_l0(C); } SEAM(5);
    if (IN(6)) { pg8::Gemm g{WSP(const bf16, WS_AO), WSP(const bf16, WS_WOUT0), M0, D, D}; pg8::StaticOrder S; S.init(M0, D, C.G, C.bid);
        EpiResid<0> E{C}; pg8::gemm_phase<EpiResid<0>, pg8::StaticOrder>(ring, g, S, E, nullptr); } SEAM(6);
    if (IN(7)) { p_norm2_route<0>(C); } SEAM(7);
    if (IN(8)) { p_moe_sort<0>(C); } SEAM(8);
    if (IN(9)) { const int* TEX = WSP(const int, WS_ROUTE) + 4 * M0 * TOPK; const bf16* W1 = WSP(const bf16, WS_W1T);
        { pg8::Gemm g{WSP(const bf16, WS_SA), W1, RMAX, 65 * 1024, D}; MoeOrder S{TEX + 1, TEX[0] * 4, 4, C.G, C.bid}; EpiSwiglu E{WSP(bf16, WS_ACT)}; pg8::gemm_phase<EpiSwiglu, MoeOrder>(ring, g, S, E, nullptr); }
        { pg8::Gemm g{WSP(const bf16, WS_H2), W1, M0, 65 * 1024, D}; SharedOrder S{M0 / 256, 4, C.G, C.bid}; EpiSwiglu E{WSP(bf16, WS_ACTS)}; pg8::gemm_phase<EpiSwiglu, SharedOrder>(ring, g, S, E, nullptr); } } SEAM(9);
    if (IN(10)) { const int* TEX = WSP(const int, WS_ROUTE) + 4 * M0 * TOPK; const bf16* W2 = WSP(const bf16, WS_W2T);
        { pg8::Gemm g{WSP(const bf16, WS_ACT), W2, RMAX, 65 * 2048, DE}; MoeOrder S{TEX + 1, TEX[0] * 8, 8, C.G, C.bid}; EpiBf16Mod E{WSP(bf16, WS_Y), D, 7}; pg8::gemm_phase<EpiBf16Mod, MoeOrder>(ring, g, S, E, nullptr); }
        { pg8::Gemm g{WSP(const bf16, WS_ACTS), W2, M0, 65 * 2048, DE}; SharedOrder S{M0 / 256, 8, C.G, C.bid}; EpiBf16Mod E{WSP(bf16, WS_YS), D, 7}; pg8::gemm_phase<EpiBf16Mod, SharedOrder>(ring, g, S, E, nullptr); } } SEAM(10);
    if (IN(11)) { p_moe_combine<0>(C); } SEAM(11);
    if (IN(12)) { pg8::Gemm g{WSP(const bf16, WS_HB), WSP(const bf16, WS_WIN1), M0, NIN1, D}; pg8::StaticOrder S; S.init(M0, NIN1, C.G, C.bid);
        pg8::EpiBf16<0> E{WSP(bf16, WS_PROJ), NIN1, nullptr, 0, 0}; pg8::gemm_phase<pg8::EpiBf16<0>, pg8::StaticOrder>(ring, g, S, E, nullptr); } SEAM(12);
    if (IN(13)) { p_prep_l1(C); } SEAM(13);
    if (IN(14)) { p_da_l1(C); } SEAM(14);
    if (IN(15)) { pg8::Gemm g{WSP(const bf16, WS_AO), WSP(const bf16, WS_WOUT1), M1, D, D}; pg8::StaticOrder S; S.init(M1, D, C.G, C.bid);
        EpiResid<1> E{C}; pg8::gemm_phase<EpiResid<1>, pg8::StaticOrder>(ring, g, S, E, nullptr); } SEAM(15);
    if (IN(16)) { p_norm2_route<1>(C); } SEAM(16);
    if (IN(17)) { p_moe_sort<1>(C); } SEAM(17);
    if (IN(18)) { const int* TEX = WSP(const int, WS_ROUTE) + 4 * M0 * TOPK; const bf16* W1 = WSP(const bf16, WS_W1T) + (size_t)65 * 1024 * D;
        { pg8::Gemm g{WSP(const bf16, WS_SA), W1, RMAX, 65 * 1024, D}; MoeOrder S{TEX + 1, TEX[0] * 4, 4, C.G, C.bid}; EpiSwiglu E{WSP(bf16, WS_ACT)}; pg8::gemm_phase<EpiSwiglu, MoeOrder>(ring, g, S, E, nullptr); }
        { pg8::Gemm g{WSP(const bf16, WS_H2), W1, M1, 65 * 1024, D}; SharedOrder S{M1 / 256, 4, C.G, C.bid}; EpiSwiglu E{WSP(bf16, WS_ACTS)}; pg8::gemm_phase<EpiSwiglu, SharedOrder>(ring, g, S, E, nullptr); } } SEAM(18);
    if (IN(19)) { const int* TEX = WSP(const int, WS_ROUTE) + 4 * M0 * TOPK; const bf16* W2 = WSP(const bf16, WS_W2T) + (size_t)65 * D * DE;
        { pg8::Gemm g{WSP(const bf16, WS_ACT), W2, RMAX, 65 * 2048, DE}; MoeOrder S{TEX + 1, TEX[0] * 8, 8, C.G, C.bid}; EpiBf16Mod E{WSP(bf16, WS_Y), D, 7}; pg8::gemm_phase<EpiBf16Mod, MoeOrder>(ring, g, S, E, nullptr); }
        { pg8::Gemm g{WSP(const bf16, WS_ACTS), W2, M1, 65 * 2048, DE}; SharedOrder S{M1 / 256, 8, C.G, C.bid}; EpiBf16Mod E{WSP(bf16, WS_YS), D, 7}; pg8::gemm_phase<EpiBf16Mod, SharedOrder>(ring, g, S, E, nullptr); } } SEAM(19);
    if (IN(20)) { p_moe_combine<1>(C); }
#undef IN
#undef SEAM
}
#ifndef MK_ONE_LAUNCH
#define MK_ONE_LAUNCH 0
#endif
extern "C" void kernel_launch(void* const* d_in, const int* in_sizes, int n_in, void* d_out, int out_size, void* d_ws, size_t ws_size, hipStream_t stream) {
    static int grid = 0;
    if (grid == 0) {
        if (n_in != 43 || out_size != M1 * D || ws_size < WS_END) { fprintf(stderr, "kernel_launch: unexpected problem shape (n_in %d out %d ws %zu)\n", n_in, out_size, ws_size); grid = -1; return; }
        int dev = 0, cus = 0, per_cu = 0;
        if (hipGetDevice(&dev) != hipSuccess || hipDeviceGetAttribute(&cus, hipDeviceAttributeMultiprocessorCount, dev) != hipSuccess) { grid = -1; return; }
        if (hipFuncSetAttribute((const void*)fwd_kernel, hipFuncAttributeMaxDynamicSharedMemorySize, LDS_BYTES) != hipSuccess) { fprintf(stderr, "kernel_launch: hipFuncSetAttribute failed\n"); grid = -1; return; }
        if (hipOccupancyMaxActiveBlocksPerMultiprocessor(&per_cu, (const void*)fwd_kernel, NTHR, LDS_BYTES) != hipSuccess || per_cu < 1) { fprintf(stderr, "kernel_launch: occupancy query says %d workgroups per CU\n", per_cu); grid = -1; (void)hipGetLastError(); return; }
        grid = cus;
    }
    if (grid < 0) return;
    if (hipMemsetAsync((char*)d_ws + WS_CTL, 0, CTL_BYTES, stream) != hipSuccess) return;
    Args a{}; for (int i = 0; i < 43; ++i) a.in[i] = (const float*)d_in[i]; a.out = (float*)d_out; a.ws = (unsigned char*)d_ws;
#if MK_ONE_LAUNCH
    a.ph_lo = 0; a.ph_hi = NPHASE; hipLaunchKernelGGL(fwd_kernel, dim3(grid), dim3(NTHR), LDS_BYTES, stream, a);
#else
    for (int p = 0; p < NPHASE; ++p) { a.ph_lo = p; a.ph_hi = p + 1; hipLaunchKernelGGL(fwd_kernel, dim3(grid), dim3(NTHR), LDS_BYTES, stream, a); }
#endif
}
```

```cpp
#include <hip/hip_runtime.h>
#include <cstdio>
#include <cstdint>
namespace pg8 {
#define PG8_LAS __attribute__((address_space(3)))
typedef unsigned short bf16_t;
typedef short bf16x8 __attribute__((ext_vector_type(8)));
typedef float f32x4 __attribute__((ext_vector_type(4)));
typedef unsigned u32x4 __attribute__((ext_vector_type(4)));
constexpr int BM = 256, BK = 64, HALF = 128, HTB = HALF * BK * 2  , STAGE_BYTES = 8 * HTB, NXCD = 8, WGM = 8;

__host__ __device__ __forceinline__ int lds_byte(int r, int c) { const int st = (r >> 4) * 2 + (c >> 5), rr = r & 15, cc = c & 31, ob = rr * 64 + cc * 2; return st * 1024 + (ob ^ (((ob >> 9) & 1) << 5)); }
__host__ __device__ __forceinline__ void stage_rc(int b, int& R, int& C) { const int st = b / 1024, sb = b % 1024, swz = sb ^ (((sb >> 9) & 1) << 5); R = (st >> 1) * 16 + swz / 64; C = (st & 1) * 32 + (swz % 64) / 2; }
__host__ __device__ __forceinline__ int perm32(int rho) { const int n = rho >> 4, i = rho & 15; return 8 * (i >> 2) + 4 * n + (i & 3); }

struct Unit { int pm, pn; };
struct Gemm { const bf16_t* A; const bf16_t* Bt; int M, N, K; };

struct StaticOrder {
    int nM, nN, nwg, G, c;
    __host__ __device__ void init(int M, int N, int G_, int c_) { nM = M / BM; nN = N / BM; nwg = nM * nN; G = G_; c = c_; }
    __host__ __device__ bool next(int i, Unit& u) const {
        const long L = (long)i * G + c; if (L >= nwg) return false;
        int wgid = (int)L; { const int q = nwg / NXCD, r = nwg % NXCD, xcd = wgid % NXCD, off = wgid / NXCD; wgid = (xcd < r ? xcd * (q + 1) : r * (q + 1) + (xcd - r) * q) + off; }
        const int nig = WGM * nN, gid = wgid / nig, fm = gid * WGM, gsz = (nM - fm) < WGM ? (nM - fm) : WGM;
        u.pm = fm + ((wgid % nig) % gsz); u.pn = (wgid % nig) / gsz; return true;
    }
    __device__ __forceinline__ void a_ready(const Unit&) const {}
    __device__ __forceinline__ void done(const Unit&) const {}
};
struct CountedOrder : StaticOrder {
    const unsigned* ready; unsigned need; unsigned* tmo;
    __device__ __forceinline__ void a_ready(const Unit& u) const {
        if (threadIdx.x < 64) {
            const unsigned long long t0 = __builtin_amdgcn_s_memrealtime(); unsigned polls = 0;
            while ((unsigned)__builtin_amdgcn_readfirstlane(__hip_atomic_load(ready + 64 * u.pm, __ATOMIC_RELAXED, __HIP_MEMORY_SCOPE_AGENT)) < need) {
                if ((++polls & 255u) == 0u && __builtin_amdgcn_readfirstlane(__hip_atomic_load(tmo, __ATOMIC_RELAXED, __HIP_MEMORY_SCOPE_AGENT)) != 0u) break;
                if (__builtin_amdgcn_s_memrealtime() - t0 > 2000000ull) {
                    if (threadIdx.x == 0) { unsigned expect = 0u; __hip_atomic_compare_exchange_strong(tmo + 1, &expect, 0x600u | (unsigned)(u.pm & 0xff), __ATOMIC_RELAXED, __ATOMIC_RELAXED, __HIP_MEMORY_SCOPE_AGENT); __hip_atomic_store(tmo, 1u, __ATOMIC_RELAXED, __HIP_MEMORY_SCOPE_AGENT); }
                    break; }
                __builtin_amdgcn_s_sleep(2); }
            __builtin_amdgcn_fence(__ATOMIC_ACQUIRE, "agent");
            asm volatile("s_waitcnt vmcnt(0)" ::: "memory");
        }
#if !defined(BROKEN_HOOK_NO_BARRIER)
        asm volatile("" ::: "memory"); __builtin_amdgcn_s_barrier(); asm volatile("" ::: "memory");
#endif
    }
};

__device__ __forceinline__ unsigned cvt_pk_bf16(float lo, float hi) { unsigned r; asm volatile("v_cvt_pk_bf16_f32 %0, %1, %2" : "=v"(r) : "v"(lo), "v"(hi)); return r; }
typedef float f32x2 __attribute__((ext_vector_type(2)));
__device__ __forceinline__ f32x2 gelu_pk(f32x2 v) {
    const f32x2 av = __builtin_elementwise_abs(v), d = av * 0.2316418882f + 1.0f;
    f32x2 t; t.x = __builtin_amdgcn_rcpf(d.x); t.y = __builtin_amdgcn_rcpf(d.y);
    f32x2 q = t * 0.5307027145f + (-0.7265760135f); q = q * t + 0.7107068705f; q = q * t + (-0.142248368f); q = q * t + 0.127414796f; q = q * t;
    const f32x2 s = (v * v) * (-0.72134752044f);
    f32x2 e; e.x = __builtin_amdgcn_exp2f(s.x); e.y = __builtin_amdgcn_exp2f(s.y);
    const f32x2 m = v * (q * e), r = v - m;
    f32x2 o; o.x = v.x < 0.f ? m.x : r.x; o.y = v.y < 0.f ? m.y : r.y; return o;
}

struct EpiF32 {
    static constexpr bool PERM = false, AFTER_DRAIN = false;
    float* C; int ldc; const float* bias;
    __device__ __forceinline__ void operator()(const f32x4 (&acc)[2][2][4][2], const Unit& u, int wr, int wc, int fr, int fq) const {
        const int row0 = u.pm * BM + wr * 64 + fr, col0 = u.pn * BM + wc * 32 + 4 * fq;
        f32x4 bv[2][2];
#pragma unroll
        for (int bj = 0; bj < 2; ++bj)
#pragma unroll
            for (int n = 0; n < 2; ++n) bv[bj][n] = bias ? *(const f32x4*)(bias + col0 + bj * HALF + n * 16) : (f32x4){0.f, 0.f, 0.f, 0.f};
#pragma unroll
        for (int ai = 0; ai < 2; ++ai)
#pragma unroll
            for (int m = 0; m < 4; ++m) { float* rowp = C + (size_t)(row0 + ai * HALF + m * 16) * ldc + col0;
#pragma unroll
                for (int bj = 0; bj < 2; ++bj)
#pragma unroll
                    for (int n = 0; n < 2; ++n) *(f32x4*)(rowp + bj * HALF + n * 16) = acc[ai][bj][m][n] + bv[bj][n]; }
    }
};
template <int ACT  > struct EpiBf16 {
    static constexpr bool PERM = true, AFTER_DRAIN = false;
    bf16_t* O; int ldc; const float* bias; int split_cols; size_t split_stride;
    __device__ __forceinline__ void operator()(const f32x4 (&acc)[2][2][4][2], const Unit& u, int wr, int wc, int fr, int fq) const {
        const int row0 = u.pm * BM + wr * 64 + fr; int colt = u.pn * BM; bf16_t* base = O;
        if (split_cols) { const int t = colt / split_cols; base += (size_t)t * split_stride; colt -= t * split_cols; }
        const int col0 = colt + wc * 32 + 8 * fq, bcol0 = u.pn * BM + wc * 32 + 8 * fq;
        f32x4 bv[2][2];
#pragma unroll
        for (int bj = 0; bj < 2; ++bj)
#pragma unroll
            for (int n = 0; n < 2; ++n) bv[bj][n] = bias ? *(const f32x4*)(bias + bcol0 + bj * HALF + 4 * n) : (f32x4){0.f, 0.f, 0.f, 0.f};
#pragma unroll
        for (int ai = 0; ai < 2; ++ai)
#pragma unroll
            for (int m = 0; m < 4; ++m) { bf16_t* rowp = base + (size_t)(row0 + ai * HALF + m * 16) * ldc + col0;
#pragma unroll
                for (int bj = 0; bj < 2; ++bj) { f32x4 v0 = acc[ai][bj][m][0] + bv[bj][0], v1 = acc[ai][bj][m][1] + bv[bj][1];
                    if (ACT == 1) { f32x2 a = gelu_pk((f32x2){v0[0], v0[1]}), b = gelu_pk((f32x2){v0[2], v0[3]}), c = gelu_pk((f32x2){v1[0], v1[1]}), d = gelu_pk((f32x2){v1[2], v1[3]});
                        v0 = (f32x4){a.x, a.y, b.x, b.y}; v1 = (f32x4){c.x, c.y, d.x, d.y}; }
                    if (ACT == 2) {
#pragma unroll
                        for (int j = 0; j < 4; ++j) { v0[j] = 0.5f * v0[j] * (1.0f + erff(v0[j] * 0.70710678f)); v1[j] = 0.5f * v1[j] * (1.0f + erff(v1[j] * 0.70710678f)); } }
                    u32x4 w; w.x = cvt_pk_bf16(v0[0], v0[1]); w.y = cvt_pk_bf16(v0[2], v0[3]); w.z = cvt_pk_bf16(v1[0], v1[1]); w.w = cvt_pk_bf16(v1[2], v1[3]);
                    *(u32x4*)(rowp + bj * HALF) = w; } }
    }
};
template <class Epi, class Sched, bool STAMP = false>
__device__ __forceinline__ void gemm_phase(PG8_LAS unsigned char* lds, const Gemm g, const Sched& S, const Epi& E, unsigned long long* stamps) {
    const int tid = threadIdx.x, wid = __builtin_amdgcn_readfirstlane(tid >> 6), lane = tid & 63, wr = wid >> 2, wc = wid & 3, fr = lane & 15, fq = lane >> 4;
    const int K = g.K, nt = K / BK;
    int ts_lo = 0, ts_hi = 0, nts = 0; const unsigned long long rt_entry = STAMP ? (unsigned long long)wall_clock64() : 0ull;
#define PG8_STAMP() do { if (STAMP && wid == 0 && nts < 64) { const unsigned long long _c = (unsigned long long)clock64(); \
        ts_lo = (lane == nts) ? (int)(unsigned)_c : ts_lo; ts_hi = (lane == nts) ? (int)(unsigned)(_c >> 32) : ts_hi; ++nts; } } while (0)
    PG8_STAMP();
    unsigned voffA[2], voffB[2];
#pragma unroll
    for (int i = 0; i < 2; ++i) { int R, C; stage_rc(tid * 16 + i * 8192, R, C); const int Rb = Epi::PERM ? ((R & ~31) + perm32(R & 31)) : R;
        voffA[i] = (unsigned)(R * K + C) * 2u; voffB[i] = (unsigned)(Rb * K + C) * 2u; }
    const size_t kstep = (size_t)(BK * 2);
    const size_t hstep = (size_t)HALF * K * 2;
    const size_t tstep = 2 * hstep;
    const unsigned ldsw = (unsigned)wid * 1024u;
    const int aoff = lds_byte(wr * 64 + fr, fq * 8), boff = lds_byte(wc * 32 + fr, fq * 8);
#define PG8_SA(b, h) (((b) * 2 + (h)) * HTB)
#define PG8_SB(b, h) ((4 + (b) * 2 + (h)) * HTB)
#define PG8_STAGE(bufoff, gbase, voff) do { _Pragma("unroll") for (int _i = 0; _i < 2; ++_i) \
        __builtin_amdgcn_global_load_lds((const unsigned*)((const char*)(gbase) + (voff)[_i]), (PG8_LAS unsigned*)(lds + (bufoff) + ldsw + _i * 8192), 16, 0, 0); } while (0)
#define PG8_LDA(dst, b, h) do { _Pragma("unroll") for (int m = 0; m < 4; ++m) _Pragma("unroll") for (int k = 0; k < 2; ++k) dst[m][k] = *(const PG8_LAS bf16x8*)(lds + PG8_SA(b, h) + aoff + m * 2048 + k * 1024); } while (0)
#define PG8_LDB(dst, b, h) do { _Pragma("unroll") for (int n = 0; n < 2; ++n) _Pragma("unroll") for (int k = 0; k < 2; ++k) dst[n][k] = *(const PG8_LAS bf16x8*)(lds + PG8_SB(b, h) + boff + n * 2048 + k * 1024); } while (0)
#define PG8_MMA(ai, bj, At, Bt) do { __builtin_amdgcn_s_setprio(1); _Pragma("unroll") for (int m = 0; m < 4; ++m) _Pragma("unroll") for (int n = 0; n < 2; ++n) _Pragma("unroll") for (int k = 0; k < 2; ++k) \
        acc[ai][bj][m][n] = __builtin_amdgcn_mfma_f32_16x16x32_bf16(Bt[n][k], At[m][k], acc[ai][bj][m][n], 0, 0, 0); __builtin_amdgcn_s_setprio(0); } while (0)
#define PG8_WAIT_V(n) asm volatile("s_waitcnt vmcnt(" #n ")" ::: "memory")
#define PG8_WAIT_L(n) asm volatile("s_waitcnt lgkmcnt(" #n ")" ::: "memory")
#define PG8_BAR __builtin_amdgcn_s_barrier()
#define PG8_SCHED __builtin_amdgcn_sched_barrier(0)
    Unit cur, nxt; int ui = 0;
    if (!S.next(0, cur)) return;
    f32x4 acc[2][2][4][2];
#pragma unroll
    for (int a = 0; a < 2; ++a)
#pragma unroll
        for (int b = 0; b < 2; ++b)
#pragma unroll
            for (int m = 0; m < 4; ++m)
#pragma unroll
                for (int n = 0; n < 2; ++n) acc[a][b][m][n] = (f32x4){0.f, 0.f, 0.f, 0.f};
    bf16x8 At[4][2], B0[2][2], B1[2][2];
    const char* cA = (const char*)g.A + (size_t)cur.pm * tstep; const char* cB = (const char*)g.Bt + (size_t)cur.pn * tstep;
    S.a_ready(cur);
    PG8_STAGE(PG8_SB(0, 0), cB, voffB); PG8_STAGE(PG8_SA(0, 0), cA, voffA); PG8_STAGE(PG8_SB(0, 1), cB + hstep, voffB); PG8_STAGE(PG8_SA(0, 1), cA + hstep, voffA);
    if (wr == 1) PG8_BAR;
    PG8_WAIT_V(4); PG8_BAR;
    PG8_STAGE(PG8_SB(1, 0), cB + kstep, voffB); PG8_STAGE(PG8_SA(1, 0), cA + kstep, voffA); PG8_STAGE(PG8_SB(1, 1), cB + hstep + kstep, voffB);
    PG8_WAIT_V(6); PG8_BAR;
    PG8_STAMP();
    for (;;) {
        const bool has_next = S.next(ui + 1, nxt);
        const char* nA = has_next ? (const char*)g.A + (size_t)nxt.pm * tstep : cA; const char* nB = has_next ? (const char*)g.Bt + (size_t)nxt.pn * tstep : cB;
        for (int t = 0; t < nt; t += 2) {
            const bool last = (t == nt - 2);
            const char* a1 = cA + (size_t)(t + 1) * kstep;
            const char* a2 = last ? nA : cA + (size_t)(t + 2) * kstep; const char* b2 = last ? nB : cB + (size_t)(t + 2) * kstep;
            const char* a3 = a2 + kstep; const char* b3 = b2 + kstep;
            if (last && has_next) S.a_ready(nxt);
            PG8_LDB(B0, 0, 0); PG8_SCHED; PG8_LDA(At, 0, 0); PG8_STAGE(PG8_SA(1, 1), a1 + hstep, voffA);
            PG8_WAIT_L(8); PG8_BAR; PG8_WAIT_L(0); PG8_MMA(0, 0, At, B0); PG8_BAR; PG8_SCHED;
            PG8_LDB(B1, 0, 1); PG8_STAGE(PG8_SB(0, 0), b2, voffB);
            PG8_BAR; PG8_WAIT_L(0); PG8_MMA(0, 1, At, B1); PG8_BAR;
            PG8_LDA(At, 0, 1); PG8_STAGE(PG8_SA(0, 0), a2, voffA);
            PG8_BAR; PG8_WAIT_L(0); PG8_MMA(1, 0, At, B0); PG8_BAR; PG8_SCHED;
            PG8_STAGE(PG8_SB(0, 1), b2 + hstep, voffB);
            PG8_WAIT_V(6); PG8_BAR; PG8_MMA(1, 1, At, B1); PG8_BAR;
            PG8_LDB(B0, 1, 0); PG8_SCHED; PG8_LDA(At, 1, 0); PG8_STAGE(PG8_SA(0, 1), a2 + hstep, voffA);
            PG8_WAIT_L(8); PG8_BAR; PG8_WAIT_L(0); PG8_MMA(0, 0, At, B0); PG8_BAR; PG8_SCHED;
            PG8_LDB(B1, 1, 1); PG8_STAGE(PG8_SB(1, 0), b3, voffB);
            PG8_BAR; PG8_WAIT_L(0); PG8_MMA(0, 1, At, B1); PG8_BAR;
            PG8_LDA(At, 1, 1); PG8_STAGE(PG8_SA(1, 0), a3, voffA);
            PG8_BAR; PG8_WAIT_L(0); PG8_MMA(1, 0, At, B0); PG8_BAR; PG8_SCHED;
            PG8_STAGE(PG8_SB(1, 1), b3 + hstep, voffB);
            PG8_WAIT_V(6); PG8_BAR; PG8_MMA(1, 1, At, B1); PG8_BAR;
        }
        PG8_STAMP();
        if constexpr (!Epi::AFTER_DRAIN) { E(acc, cur, wr, wc, fr, fq); S.done(cur); }
        PG8_STAMP();
        if (!has_next) break;
#pragma unroll
        for (int a = 0; a < 2; ++a)
#pragma unroll
            for (int b = 0; b < 2; ++b)
#pragma unroll
                for (int m = 0; m < 4; ++m)
#pragma unroll
                    for (int n = 0; n < 2; ++n) acc[a][b][m][n] = (f32x4){0.f, 0.f, 0.f, 0.f};
        cur = nxt; cA = nA; cB = nB; ++ui;
    }
    PG8_WAIT_V(0);
    if (wr == 0) PG8_BAR;
    PG8_BAR;
    if constexpr (Epi::AFTER_DRAIN) { E.fused(acc, cur, wr, wc, fr, fq, lds, wid, lane); S.done(cur); }
    PG8_STAMP();
    if (STAMP && wid == 0) { stamps[lane] = lane < nts ? (((unsigned long long)(unsigned)ts_hi << 32) | (unsigned)ts_lo) : 0ull;
        if (lane == 62) stamps[62] = rt_entry; if (lane == 63) stamps[63] = (unsigned long long)wall_clock64(); }
#undef PG8_STAMP
#undef PG8_SA
#undef PG8_SB
#undef PG8_STAGE
#undef PG8_LDA
#undef PG8_LDB
#undef PG8_MMA
#undef PG8_WAIT_V
#undef PG8_WAIT_L
#undef PG8_BAR
#undef PG8_SCHED
}
template <class Epi, class Sched, bool STAMP = false>
__device__ __forceinline__ void gemm_phase_g(PG8_LAS unsigned char* lds, const Gemm g, const Sched& S, const Epi& E, unsigned long long* stamps) {
    const int tid = threadIdx.x, wid = __builtin_amdgcn_readfirstlane(tid >> 6), lane = tid & 63, wr = wid >> 2, wc = wid & 3, fr = lane & 15, fq = lane >> 4;
    const int K = g.K, nt = K / BK;
    int ts_lo = 0, ts_hi = 0, nts = 0; const unsigned long long rt_entry = STAMP ? (unsigned long long)wall_clock64() : 0ull;
#define PG8_STAMP() do { if (STAMP && wid == 0 && nts < 64) { const unsigned long long _c = (unsigned long long)clock64(); \
        ts_lo = (lane == nts) ? (int)(unsigned)_c : ts_lo; ts_hi = (lane == nts) ? (int)(unsigned)(_c >> 32) : ts_hi; ++nts; } } while (0)
    PG8_STAMP();
    unsigned voffB[2]; int RpA[2], CbA[2];
#pragma unroll
    for (int i = 0; i < 2; ++i) { int R, C; stage_rc(tid * 16 + i * 8192, R, C); const int Rb = Epi::PERM ? ((R & ~31) + perm32(R & 31)) : R;
        RpA[i] = R; CbA[i] = C * 2; voffB[i] = (unsigned)(Rb * K + C) * 2u; }
    const size_t kstep = (size_t)(BK * 2);
    const size_t hstep = (size_t)HALF * K * 2;
    const size_t tstep = 2 * hstep;
    const unsigned ldsw = (unsigned)wid * 1024u;
    const int aoff = lds_byte(wr * 64 + fr, fq * 8), boff = lds_byte(wc * 32 + fr, fq * 8);
#define PG8_SA(b, h) (((b) * 2 + (h)) * HTB)
#define PG8_SB(b, h) ((4 + (b) * 2 + (h)) * HTB)
#define PG8_STAGE(bufoff, gbase, voff) do { _Pragma("unroll") for (int _i = 0; _i < 2; ++_i) \
        __builtin_amdgcn_global_load_lds((const unsigned*)((const char*)(gbase) + (voff)[_i]), (PG8_LAS unsigned*)(lds + (bufoff) + ldsw + _i * 8192), 16, 0, 0); } while (0)
#define PG8_LDA(dst, b, h) do { _Pragma("unroll") for (int m = 0; m < 4; ++m) _Pragma("unroll") for (int k = 0; k < 2; ++k) dst[m][k] = *(const PG8_LAS bf16x8*)(lds + PG8_SA(b, h) + aoff + m * 2048 + k * 1024); } while (0)
#define PG8_LDB(dst, b, h) do { _Pragma("unroll") for (int n = 0; n < 2; ++n) _Pragma("unroll") for (int k = 0; k < 2; ++k) dst[n][k] = *(const PG8_LAS bf16x8*)(lds + PG8_SB(b, h) + boff + n * 2048 + k * 1024); } while (0)
#define PG8_MMA(ai, bj, At, Bt) do { __builtin_amdgcn_s_setprio(1); _Pragma("unroll") for (int m = 0; m < 4; ++m) _Pragma("unroll") for (int n = 0; n < 2; ++n) _Pragma("unroll") for (int k = 0; k < 2; ++k) \
        acc[ai][bj][m][n] = __builtin_amdgcn_mfma_f32_16x16x32_bf16(Bt[n][k], At[m][k], acc[ai][bj][m][n], 0, 0, 0); __builtin_amdgcn_s_setprio(0); } while (0)
#define PG8_WAIT_V(n) asm volatile("s_waitcnt vmcnt(" #n ")" ::: "memory")
#define PG8_WAIT_L(n) asm volatile("s_waitcnt lgkmcnt(" #n ")" ::: "memory")
#define PG8_BAR __builtin_amdgcn_s_barrier()
#define PG8_SCHED __builtin_amdgcn_sched_barrier(0)
    Unit cur, nxt; int ui = 0;
    if (!S.next(0, cur)) return;
    f32x4 acc[2][2][4][2];
#pragma unroll
    for (int a = 0; a < 2; ++a)
#pragma unroll
        for (int b = 0; b < 2; ++b)
#pragma unroll
            for (int m = 0; m < 4; ++m)
#pragma unroll
                for (int n = 0; n < 2; ++n) acc[a][b][m][n] = (f32x4){0.f, 0.f, 0.f, 0.f};
    bf16x8 At[4][2], B0[2][2], B1[2][2];
    const char* cA = (const char*)g.A; const char* cB = (const char*)g.Bt + (size_t)cur.pn * tstep;
    unsigned vA[2][2], vN[2][2];
#pragma unroll
    for (int h = 0; h < 2; ++h)
#pragma unroll
        for (int i = 0; i < 2; ++i) vA[h][i] = S.a_voff(cur, h, RpA[i], K) + (unsigned)CbA[i];
    S.a_ready(cur);
    PG8_STAGE(PG8_SB(0, 0), cB, voffB); PG8_STAGE(PG8_SA(0, 0), cA, vA[0]); PG8_STAGE(PG8_SB(0, 1), cB + hstep, voffB); PG8_STAGE(PG8_SA(0, 1), cA, vA[1]);
    if (wr == 1) PG8_BAR;
    PG8_WAIT_V(4); PG8_BAR;
    PG8_STAGE(PG8_SB(1, 0), cB + kstep, voffB); PG8_STAGE(PG8_SA(1, 0), cA + kstep, vA[0]); PG8_STAGE(PG8_SB(1, 1), cB + hstep + kstep, voffB);
    PG8_WAIT_V(6); PG8_BAR;
    PG8_STAMP();
    for (;;) {
        const bool has_next = S.next(ui + 1, nxt);
#pragma unroll
        for (int h = 0; h < 2; ++h)
#pragma unroll
            for (int i = 0; i < 2; ++i) vN[h][i] = has_next ? S.a_voff(nxt, h, RpA[i], K) + (unsigned)CbA[i] : vA[h][i];
        const char* nA = cA; const char* nB = has_next ? (const char*)g.Bt + (size_t)nxt.pn * tstep : cB;
        for (int t = 0; t < nt; t += 2) {
            const bool last = (t == nt - 2);
            const char* a1 = cA + (size_t)(t + 1) * kstep;
            const char* a2 = last ? nA : cA + (size_t)(t + 2) * kstep; const char* b2 = last ? nB : cB + (size_t)(t + 2) * kstep;
            const char* a3 = a2 + kstep; const char* b3 = b2 + kstep;
            if (last && has_next) S.a_ready(nxt);
            unsigned vX0[2], vX1[2];
#pragma unroll
            for (int i = 0; i < 2; ++i) { vX0[i] = last ? vN[0][i] : vA[0][i]; vX1[i] = last ? vN[1][i] : vA[1][i]; }
            PG8_LDB(B0, 0, 0); PG8_SCHED; PG8_LDA(At, 0, 0); PG8_STAGE(PG8_SA(1, 1), a1, vA[1]);
            PG8_WAIT_L(8); PG8_BAR; PG8_WAIT_L(0); PG8_MMA(0, 0, At, B0); PG8_BAR; PG8_SCHED;
            PG8_LDB(B1, 0, 1); PG8_STAGE(PG8_SB(0, 0), b2, voffB);
            PG8_BAR; PG8_WAIT_L(0); PG8_MMA(0, 1, At, B1); PG8_BAR;
            PG8_LDA(At, 0, 1); PG8_STAGE(PG8_SA(0, 0), a2, vX0);
            PG8_BAR; PG8_WAIT_L(0); PG8_MMA(1, 0, At, B0); PG8_BAR; PG8_SCHED;
            PG8_STAGE(PG8_SB(0, 1), b2 + hstep, voffB);
            PG8_WAIT_V(6); PG8_BAR; PG8_MMA(1, 1, At, B1); PG8_BAR;
            PG8_LDB(B0, 1, 0); PG8_SCHED; PG8_LDA(At, 1, 0); PG8_STAGE(PG8_SA(0, 1), a2, vX1);
            PG8_WAIT_L(8); PG8_BAR; PG8_WAIT_L(0); PG8_MMA(0, 0, At, B0); PG8_BAR; PG8_SCHED;
            PG8_LDB(B1, 1, 1); PG8_STAGE(PG8_SB(1, 0), b3, voffB);
            PG8_BAR; PG8_WAIT_L(0); PG8_MMA(0, 1, At, B1); PG8_BAR;
            PG8_LDA(At, 1, 1); PG8_STAGE(PG8_SA(1, 0), a3, vX0);
            PG8_BAR; PG8_WAIT_L(0); PG8_MMA(1, 0, At, B0); PG8_BAR; PG8_SCHED;
            PG8_STAGE(PG8_SB(1, 1), b3 + hstep, voffB);
            PG8_WAIT_V(6); PG8_BAR; PG8_MMA(1, 1, At, B1); PG8_BAR;
        }
        PG8_STAMP();
        if constexpr (!Epi::AFTER_DRAIN) { E(acc, cur, wr, wc, fr, fq); S.done(cur); }
        PG8_STAMP();
        if (!has_next) break;
#pragma unroll
        for (int a = 0; a < 2; ++a)
#pragma unroll
            for (int b = 0; b < 2; ++b)
#pragma unroll
                for (int m = 0; m < 4; ++m)
#pragma unroll
                    for (int n = 0; n < 2; ++n) acc[a][b][m][n] = (f32x4){0.f, 0.f, 0.f, 0.f};
        cur = nxt; cA = nA; cB = nB; ++ui;
#pragma unroll
        for (int h = 0; h < 2; ++h)
#pragma unroll
            for (int i = 0; i < 2; ++i) vA[h][i] = vN[h][i];
    }
    PG8_WAIT_V(0);
    if (wr == 0) PG8_BAR;
    PG8_BAR;
    if constexpr (Epi::AFTER_DRAIN) { E.fused(acc, cur, wr, wc, fr, fq, lds, wid, lane); S.done(cur); }
    PG8_STAMP();
    if (STAMP && wid == 0) { stamps[lane] = lane < nts ? (((unsigned long long)(unsigned)ts_hi << 32) | (unsigned)ts_lo) : 0ull;
        if (lane == 62) stamps[62] = rt_entry; if (lane == 63) stamps[63] = (unsigned long long)wall_clock64(); }
#undef PG8_STAMP
#undef PG8_SA
#undef PG8_SB
#undef PG8_STAGE
#undef PG8_LDA
#undef PG8_LDB
#undef PG8_MMA
#undef PG8_WAIT_V
#undef PG8_WAIT_L
#undef PG8_BAR
#undef PG8_SCHED
}
}
#define GAS __attribute__((address_space(1)))
#define LAS __attribute__((address_space(3)))
typedef unsigned short bf16;
typedef unsigned v4u __attribute__((ext_vector_type(4)));
typedef unsigned v2u __attribute__((ext_vector_type(2)));
typedef float f32x4 __attribute__((ext_vector_type(4)));
typedef short bf16x8 __attribute__((ext_vector_type(8)));
#define LDS_WAIT() asm volatile("s_waitcnt lgkmcnt(0)" ::: "memory")
constexpr int NWAVES = 8, NTHR = 512;
constexpr int D = 2048, NB = 2, SEQ = 4096, LCTX = 256, TT = SEQ + LCTX  , M0 = NB * TT  , M1 = NB * SEQ  ;
constexpr int NIN0 = 7200, NIN0P = 7424, NIN1 = 6144, NE = 64, DE = 512, TOPK = 6, GW = 64, GROWS = 64;
constexpr int C_NAQ = 0, C_NAK = 1024, C_NAV = 2048, C_MLQK = 3072, C_MLV = 5120, C_MLO = 6144, C_MLG = 7168;
constexpr int RMAX = 68608;
constexpr float EPS = 1e-6f;
constexpr size_t MiB = 1u << 20;
constexpr size_t WS_CTL = 0, CTL_BYTES = 1 * MiB;
constexpr size_t WS_MOD = 1 * MiB;
constexpr size_t WS_ROPE = WS_MOD + 512 * 1024;
constexpr size_t WS_GATE = 4 * MiB;
constexpr size_t WS_ROUTE = 6 * MiB;
constexpr size_t WS_WIN0 = 8 * MiB, WS_WOUT0 = 37 * MiB, WS_WIN1 = 45 * MiB, WS_WOUT1 = 69 * MiB;
constexpr size_t WS_W1T = 77 * MiB;
constexpr size_t WS_W2T = WS_W1T + 520 * MiB;
constexpr size_t WS_X = WS_W2T + 260 * MiB;
constexpr size_t WS_HB = WS_X + 68 * MiB;
constexpr size_t WS_H2 = WS_HB + 34 * MiB;
constexpr size_t WS_MIX = WS_H2 + 34 * MiB;
constexpr size_t WS_PROJ = WS_MIX, WS_QK = WS_PROJ + 124 * MiB, WS_HM = WS_QK + 68 * MiB, WS_AO = WS_HM + 68 * MiB, WS_SA = WS_MIX;
constexpr size_t WS_ACT = WS_MIX + 294 * MiB;
constexpr size_t WS_ACTS = WS_ACT + 67 * MiB;
constexpr size_t WS_Y = WS_ACTS + 9 * MiB;
constexpr size_t WS_YS = WS_Y + 268 * MiB;
constexpr size_t WS_GS = WS_YS + 34 * MiB;
constexpr size_t WS_TOK = WS_GS + 7 * MiB;
constexpr size_t WS_END = WS_TOK + 3 * MiB;
static_assert(WS_END <= 1900 * MiB, "d_ws map must stay under the guaranteed workspace (sum of inputs = 1957 MiB)");
static_assert((size_t)RMAX * D * 2 <= 294 * MiB && (size_t)M0 * NIN0P * 2 <= 124 * MiB, "overlay sizes");
constexpr int CW_CNT0 = 64, CW_CNT1 = 192, CW_NAQ = 320, CW_CVQ = 512, CW_CVQ0 = 576, CW_BAR = 4096;
constexpr int RING_BYTES = 131072, MISC_OFF = RING_BYTES, LDS_BYTES = 147456;
__device__ __forceinline__ float bf2f(unsigned v) { return __uint_as_float(v << 16); }
__device__ __forceinline__ unsigned f2bf(float f) { unsigned u = __float_as_uint(f); return (u + 0x7fffu + ((u >> 16) & 1u)) >> 16; }
__device__ __forceinline__ unsigned pk2(float lo, float hi) { return f2bf(lo) | (f2bf(hi) << 16); }
__device__ __forceinline__ float wave_sum(float v) {
#pragma unroll
    for (int o = 1; o < 64; o <<= 1) v += __shfl_xor(v, o);
    return v; }
__device__ __forceinline__ float siluf(float x) { return x / (1.f + __expf(-x)); }
__device__ __forceinline__ float sigmf(float x) { return 1.f / (1.f + __expf(-x)); }
#define XB_TMO      128
#define XB_XCNT(j)  (256  + 64 * (j))
#define XB_XSUB(j)  (1280 + 64 * (j))
#define XB_XGEN(j)  (2304 + 64 * (j))
#define XB_TOP      3328
#define XB_TOPGEN   3392
#define XCD_BAR_WORDS 3456
#define XB_SPIN_CAP (1u << 18)
#define LAS __attribute__((address_space(3)))

__device__ __forceinline__ unsigned xb_ld(unsigned* p)              { return __hip_atomic_load(p, __ATOMIC_RELAXED, __HIP_MEMORY_SCOPE_AGENT); }
__device__ __forceinline__ unsigned xb_add(unsigned* p, unsigned v) { return __hip_atomic_fetch_add(p, v, __ATOMIC_RELAXED, __HIP_MEMORY_SCOPE_AGENT); }
__device__ __forceinline__ unsigned xb_xcc_id() { return (unsigned)__builtin_amdgcn_s_getreg((3 << 11) | 20) & 0xFu; }
#define XB_SPIN(cond, bar) do { unsigned _sp = 0; while (cond) { __builtin_amdgcn_s_sleep(1); \
    if ((++_sp & 255u) == 0u) { if (xb_ld(&(bar)[XB_TMO])) break; if (_sp > XB_SPIN_CAP) { atomicAdd(&(bar)[XB_TMO], 1u); break; } } } } while (0)

struct XcdBarrier {
    unsigned* bar; unsigned x;
    volatile LAS unsigned* st;
};

__device__ __forceinline__ XcdBarrier xcd_barrier_post(unsigned* bar, volatile LAS unsigned* st) {
    XcdBarrier b; b.bar = bar; b.x = xb_xcc_id(); b.st = st;
    if (threadIdx.x == 0) (void)xb_add(&bar[XB_XCNT(b.x)], 1u);
    return b;
}
__device__ __forceinline__ void xcd_barrier_complete(unsigned* bar, unsigned x, unsigned& nloc, unsigned& nx) {
    const unsigned G = gridDim.x * gridDim.y * gridDim.z;
    unsigned sum, cnt, mine, sp = 0u;
    for (;;) {
        sum = 0u; cnt = 0u; mine = 0u;
#pragma unroll
        for (unsigned j = 0; j < 16; ++j) { const unsigned c = xb_ld(&bar[XB_XCNT(j)]); sum += c; cnt += (c > 0u) ? 1u : 0u; mine = (j == x) ? c : mine; }
        if (sum == G) break;
        __builtin_amdgcn_s_sleep(1);
        if ((++sp & 255u) == 0u) { if (xb_ld(&bar[XB_TMO])) break; if (sp > XB_SPIN_CAP) { atomicAdd(&bar[XB_TMO], 1u); break; } }
    }
    nloc = mine > 0u ? mine : 1u; nx = cnt > 0u ? cnt : 1u;
}

__device__ __forceinline__ void xcd_barrier(const XcdBarrier& b) {
    asm volatile("s_waitcnt vmcnt(0)" ::: "memory");
    __syncthreads();
    if (threadIdx.x == 0) {
        unsigned* bar = b.bar;
        __builtin_amdgcn_s_waitcnt(0);
        unsigned nloc = b.st[0], nx = b.st[1];
        if (nloc == 0u) { xcd_barrier_complete(bar, b.x, nloc, nx); b.st[0] = nloc; b.st[1] = nx; }
        const unsigned old = xb_add(&bar[XB_XSUB(b.x)], 1u);
        const unsigned gen = old / nloc;
        if (old + 1u == (gen + 1u) * nloc) {
            __builtin_amdgcn_fence(__ATOMIC_RELEASE, "agent");
            asm volatile("s_waitcnt vmcnt(0)" ::: "memory");
            const unsigned og = xb_add(&bar[XB_TOP], 1u);
            const unsigned tg = og / nx;
            if (og + 1u == (tg + 1u) * nx) xb_add(&bar[XB_TOPGEN], 1u);
            else XB_SPIN(xb_ld(&bar[XB_TOPGEN]) == tg, bar);
            __builtin_amdgcn_fence(__ATOMIC_ACQUIRE, "agent");
            xb_add(&bar[XB_XGEN(b.x)], 1u);
            asm volatile("s_waitcnt vmcnt(0)" ::: "memory");
        } else {
            XB_SPIN(xb_ld(&bar[XB_XGEN(b.x)]) == gen, bar);
            __builtin_amdgcn_fence(__ATOMIC_ACQUIRE, "agent");
            asm volatile("s_waitcnt vmcnt(0)" ::: "memory");
        }
    }
    __syncthreads();
}

struct Ctx {
    LAS unsigned char* lds; const float* const* in; float* out; unsigned char* ws;
    int tid, lane, wave, G, bid;
};
#define WSP(T, off) ((T*)(C.ws + (off)))
__device__ __forceinline__ Ctx phase_ctx(const Ctx& C0) { Ctx C = C0; int t = threadIdx.x; asm volatile("" : "+v"(t)); C.tid = t; C.lane = t & 63; C.wave = __builtin_amdgcn_readfirstlane(t >> 6);
    return C; }
enum { I_X = 0, I_C = 1, I_CTX = 2, I_CCTX = 3, I_L0 = 4, I_L1 = 25 };
enum { A_W = 0, A_B = 1, N1 = 2, N2 = 3, W_IN = 4 };
enum { E_QN = 5, E_KN = 6, E_RPB = 7, E_CW = 8, E_CB = 9, E_GB = 10, E_HN = 11, E_WOUT = 12, E_RW = 13 };
enum { O_QN = 5, O_KN = 6, O_LAM = 7, O_SUB = 8, O_WOUT = 9, O_RW = 10 };
__device__ __forceinline__ const float* in_row(const Ctx& C, int r) { const int b = r / TT, t = r - b * TT;
    return t < LCTX ? C.in[I_CTX] + ((size_t)b * LCTX + t) * D : C.in[I_X] + ((size_t)b * SEQ + (t - LCTX)) * D; }
__device__ __forceinline__ const float* mod_row(const Ctx& C, int layer, int r) { const int b = r / TT, t = r - b * TT;
    return WSP(const float, WS_MOD) + ((size_t)layer * 3 + (t < LCTX ? 2 : b)) * (6 * D); }

struct TItem { const float* W; bf16* WT; int N, K, k0, n0, drow; };
__device__ __forceinline__ void titem_load(f32x4 (&v)[8], const TItem& it, int lane) {
#pragma unroll
    for (int i = 0; i < 8; ++i) v[i] = __builtin_nontemporal_load((const f32x4*)(it.W + (size_t)(it.k0 + 8 * i + (lane >> 3)) * it.N + it.n0 + 4 * (lane & 7)));
}
__device__ __forceinline__ void titem_to_lds(const f32x4 (&v)[8], LAS float* scr, int lane) {
#pragma unroll
    for (int i = 0; i < 8; ++i) { LAS float* p = scr + (8 * i + (lane >> 3)) * 33 + 4 * (lane & 7); p[0] = v[i].x; p[1] = v[i].y; p[2] = v[i].z; p[3] = v[i].w; }
    LDS_WAIT(); asm volatile("" ::: "memory");
}
__device__ __forceinline__ void titem_store(const TItem& it, LAS float* scr, int lane) {
    const int c = lane & 7;
#pragma unroll
    for (int j = 0; j < 4; ++j) { const int n = (lane >> 3) + 8 * j; const LAS float* s = scr + (8 * c) * 33 + n;
        v4u o; o.x = pg8::cvt_pk_bf16(s[0 * 33], s[1 * 33]); o.y = pg8::cvt_pk_bf16(s[2 * 33], s[3 * 33]); o.z = pg8::cvt_pk_bf16(s[4 * 33], s[5 * 33]); o.w = pg8::cvt_pk_bf16(s[6 * 33], s[7 * 33]);
        *(v4u*)(it.WT + (size_t)(it.drow + n) * it.K + it.k0 + 8 * c) = o; }
    LDS_WAIT(); asm volatile("" ::: "memory");
}
constexpr int I_IN0 = 32 * (NIN0 / 32), I_OUT = 32 * 64, I_IN1 = 32 * (NIN1 / 32), I_GU = 32 * 16  , I_DN = 8 * 64;
constexpr int PER_L = 65 * (2 * I_GU + I_DN), NIT_EARLY = I_IN0 + I_OUT + I_IN1 + I_OUT + PER_L, NIT_ALL = NIT_EARLY + PER_L;
constexpr int CV_CHUNK = 32, CV_NCHUNK = PER_L / CV_CHUNK;
static_assert(PER_L % CV_CHUNK == 0, "chunking");
__device__ __forceinline__ TItem item_desc(const Ctx& C, int it) { TItem d; int r = it;
    if (r < I_IN0) { const int nb = NIN0 / 32; d = TItem{C.in[I_L0 + W_IN], WSP(bf16, WS_WIN0), NIN0, D, (r / nb) * 64, (r % nb) * 32, (r % nb) * 32}; return d; } r -= I_IN0;
    if (r < I_OUT) { d = TItem{C.in[I_L0 + E_WOUT], WSP(bf16, WS_WOUT0), D, D, (r / 64) * 64, (r % 64) * 32, (r % 64) * 32}; return d; } r -= I_OUT;
    if (r < I_IN1) { const int nb = NIN1 / 32; d = TItem{C.in[I_L1 + W_IN], WSP(bf16, WS_WIN1), NIN1, D, (r / nb) * 64, (r % nb) * 32, (r % nb) * 32}; return d; } r -= I_IN1;
    if (r < I_OUT) { d = TItem{C.in[I_L1 + O_WOUT], WSP(bf16, WS_WOUT1), D, D, (r / 64) * 64, (r % 64) * 32, (r % 64) * 32}; return d; } r -= I_OUT;
    const int layer = r / PER_L; r -= layer * PER_L; const int rb = (layer ? I_L1 + O_RW : I_L0 + E_RW);
    const int e = r / (2 * I_GU + I_DN); r -= e * (2 * I_GU + I_DN);
    if (r < 2 * I_GU) { const int sgu = r / I_GU, q = r % I_GU, n0 = (q % 16) * 32;
        d = TItem{e < NE ? C.in[rb + 2 + sgu] + (size_t)e * D * DE : C.in[rb + 5 + sgu], WSP(bf16, WS_W1T) + ((size_t)layer * 65 + e) * (1024 * (size_t)D), DE, D, (q / 16) * 64, n0, 256 * (n0 / 128) + 128 * sgu + (n0 % 128)}; return d; }
    r -= 2 * I_GU;
    d = TItem{e < NE ? C.in[rb + 4] + (size_t)e * DE * D : C.in[rb + 7], WSP(bf16, WS_W2T) + ((size_t)layer * 65 + e) * ((size_t)D * DE), D, DE, (r / 64) * 64, (r % 64) * 32, (r % 64) * 32}; return d; }
__device__ __forceinline__ void convert_items(const Ctx& C, int first, int last, int stride, LAS float* scr) {
    f32x4 va[8], vb[8]; int it = first; TItem cur{}; if (it < last) { cur = item_desc(C, it); titem_load(va, cur, C.lane); }
    while (it < last) { const int itn = it + stride; TItem nxt = cur; if (itn < last) { nxt = item_desc(C, itn); titem_load(vb, nxt, C.lane); }
        titem_to_lds(va, scr, C.lane); titem_store(cur, scr, C.lane); it = itn; cur = nxt;
#pragma unroll
        for (int i = 0; i < 8; ++i) va[i] = vb[i]; }
}
__device__ __forceinline__ void convert_queue(const Ctx& C0, int max_chunks, int qword, int item0, int nchunk) { const Ctx C = phase_ctx(C0);
    LAS int* sPop = (LAS int*)(C.lds + MISC_OFF + 512); LAS float* scr = (LAS float*)(C.lds + C.wave * 16384);
    if (max_chunks <= 0) return;
    unsigned* q = WSP(unsigned, WS_CTL) + qword;
    __syncthreads();
    if (C.tid == 0) sPop[0] = (int)atomicAdd(q, 1u);
    __syncthreads();
    int ch = sPop[0];
    for (int n = 0; n < max_chunks && ch < nchunk; ++n) {
        const bool more = n + 1 < max_chunks; unsigned nxt = 0u;
        if (C.tid == 0 && more) nxt = atomicAdd(q, 1u);
        const int base = item0 + ch * CV_CHUNK + C.wave * (CV_CHUNK / NWAVES); convert_items(C, base, base + CV_CHUNK / NWAVES, 1, scr);
        __syncthreads();
        if (C.tid == 0) sPop[0] = more ? (int)nxt : nchunk;
        __syncthreads();
        ch = sPop[0]; }
    __syncthreads();
}
__device__ __forceinline__ void p0_prologue(const Ctx& C0) { const Ctx C = phase_ctx(C0);
    LAS float* sv = (LAS float*)C.lds;
    LAS float* red = sv + 3 * D;
    for (int i = C.tid; i < 3 * D; i += NTHR) { const int r = i / D, k = i - r * D; const float v = r < 2 ? C.in[I_C][r * D + k] : C.in[I_CCTX][k]; sv[i] = v / (1.f + expf(-v)); }
    __syncthreads();
    for (int item = C.bid; item < 2 * 192; item += C.G) {
        const int layer = item / 192, c0 = (item % 192) * 64; const float* W = C.in[(layer ? I_L1 : I_L0) + A_W]; const float* bia = C.in[(layer ? I_L1 : I_L0) + A_B];
        const int cg = C.tid & 15, ks = C.tid >> 4; float acc[3][4] = {};
#pragma unroll 8
        for (int k = ks * 64; k < ks * 64 + 64; ++k) { const f32x4 w = __builtin_nontemporal_load((const f32x4*)(W + (size_t)k * (6 * D) + c0 + cg * 4));
#pragma unroll
            for (int r = 0; r < 3; ++r) { const float s = sv[r * D + k]; acc[r][0] += s * w.x; acc[r][1] += s * w.y; acc[r][2] += s * w.z; acc[r][3] += s * w.w; } }
#pragma unroll
        for (int r = 0; r < 3; ++r)
#pragma unroll
            for (int j = 0; j < 4; ++j) red[(ks * 3 + r) * 64 + cg * 4 + j] = acc[r][j];
        __syncthreads();
        if (C.tid < 192) { const int r = C.tid / 64, cc = C.tid % 64; float s = 0.f; for (int q = 0; q < 32; ++q) s += red[(q * 3 + r) * 64 + cc];
            WSP(float, WS_MOD)[((size_t)layer * 3 + r) * (6 * D) + c0 + cc] = s + bia[c0 + cc]; }
        __syncthreads();
    }
    for (int i = C.bid * NTHR + C.tid; i < SEQ * 64; i += C.G * NTHR) { const int t = i >> 6, f = i & 63; const float inv = powf(10000.f, -(float)(f & 31) / 32.f);
        const float ang = (float)(f < 32 ? t / GW : t % GW) * inv; WSP(float, WS_ROPE)[i] = cosf(ang); WSP(float, WS_ROPE)[SEQ * 64 + i] = sinf(ang); }
    LAS float* scr = (LAS float*)(C.lds + C.wave * 16384);
    const int gw = C.bid * NWAVES + C.wave, NGW = C.G * NWAVES;
    __syncthreads();
    static_assert(NIT_EARLY % CV_CHUNK == 0, "chunking");
    convert_queue(C, 1 << 30, CW_CVQ0, 0, NIT_EARLY / CV_CHUNK);
}

__device__ __forceinline__ void convert_chunks(const Ctx& C, int max_chunks) { convert_queue(C, max_chunks, CW_CVQ, NIT_EARLY, CV_NCHUNK); }

__device__ __forceinline__ void norm_mod_row(f32x4 (&v)[8], const float* gain, const float* shift, const float* scale, int lane) {
    float s = 0.f;
#pragma unroll
    for (int j = 0; j < 8; ++j) s += (v[j].x * v[j].x + v[j].y * v[j].y) + (v[j].z * v[j].z + v[j].w * v[j].w);
    const float r = 1.f / sqrtf(wave_sum(s) * (1.f / D) + EPS);
#pragma unroll
    for (int j = 0; j < 8; ++j) { const int c = 4 * lane + 256 * j; const f32x4 g = *(const f32x4*)(gain + c), sh = *(const f32x4*)(shift + c), sc = *(const f32x4*)(scale + c);
        v[j] = v[j] * r * g * (sc + 1.f) + sh; }
}
__device__ __forceinline__ void store_row_bf16(bf16* o, const f32x4 (&v)[8], int lane) {
#pragma unroll
    for (int j = 0; j < 8; ++j) { v2u w; w.x = pk2(v[j].x, v[j].y); w.y = pk2(v[j].z, v[j].w); *(v2u*)(o + 4 * lane + 256 * j) = w; }
}
__device__ __forceinline__ void p_norm1_l0(const Ctx& C0) { const Ctx C = phase_ctx(C0);
    const int gw = C.bid * NWAVES + C.wave, NGW = C.G * NWAVES;
    for (int r = gw; r < M0; r += NGW) { const float* x = in_row(C, r); f32x4 v[8];
#pragma unroll
        for (int j = 0; j < 8; ++j) v[j] = *(const f32x4*)(x + 4 * C.lane + 256 * j);
        const float* md = mod_row(C, 0, r); norm_mod_row(v, C.in[I_L0 + N1], md + 0 * D, md + 1 * D, C.lane);
        store_row_bf16(WSP(bf16, WS_HB) + (size_t)r * D, v, C.lane); }
}
__device__ __forceinline__ void p_prep_l0(const Ctx& C0) { const Ctx C = phase_ctx(C0);
    const int gw = C.bid * NWAVES + C.wave, NGW = C.G * NWAVES, lane = C.lane;
    const bf16* PB = WSP(const bf16, WS_PROJ); bf16* QN = WSP(bf16, WS_QK); bf16* KN = QN + (size_t)M0 * 1024; bf16* MQ = KN + (size_t)M0 * 1024; bf16* MK = MQ + (size_t)M0 * 1024;
    float* LI = WSP(float, WS_GATE); float* LF = LI + 2 * NB * 8 * TT;
    {
      const float* gqp = C.in[I_L0 + E_QN] + (16 * lane) % 128; const float* gkp = C.in[I_L0 + E_KN] + (16 * lane) % 128;
      const f32x4 gq0 = *(const f32x4*)(gqp), gq1 = *(const f32x4*)(gqp + 4), gq2 = *(const f32x4*)(gqp + 8), gq3 = *(const f32x4*)(gqp + 12);
      const f32x4 gk0 = *(const f32x4*)(gkp), gk1 = *(const f32x4*)(gkp + 4), gk2 = *(const f32x4*)(gkp + 8), gk3 = *(const f32x4*)(gkp + 12);
      const float gbias = C.in[I_L0 + E_GB][lane & 31];
      for (int r = gw; r < M0; r += NGW) { const int b = r / TT, t = r - b * TT; const bf16* pr = PB + (size_t)r * NIN0P;
        const v4u qa = *(const v4u*)(pr + C_NAQ + 16 * lane), qb = *(const v4u*)(pr + C_NAQ + 16 * lane + 8), ka = *(const v4u*)(pr + C_NAK + 16 * lane), kb = *(const v4u*)(pr + C_NAK + 16 * lane + 8);
        const float graw = bf2f(pr[C_MLG + (lane & 31)]);
#define HEADNORM(XA, XB, G0, G1, G2, G3, DST) do { const unsigned w_[8] = {XA.x, XA.y, XA.z, XA.w, XB.x, XB.y, XB.z, XB.w}; float f_[16]; float s_ = 0.f; \
            _Pragma("unroll") for (int i = 0; i < 8; ++i) { f_[2 * i] = bf2f(w_[i] & 0xffffu); f_[2 * i + 1] = bf2f(w_[i] >> 16); s_ += f_[2 * i] * f_[2 * i] + f_[2 * i + 1] * f_[2 * i + 1]; } \
            s_ += __shfl_xor(s_, 1); s_ += __shfl_xor(s_, 2); s_ += __shfl_xor(s_, 4); const float rr_ = 1.f / sqrtf(s_ * (1.f / 128.f) + EPS); \
            const v4u o0_ = (v4u){pk2(f_[0] * rr_ * G0.x, f_[1] * rr_ * G0.y), pk2(f_[2] * rr_ * G0.z, f_[3] * rr_ * G0.w), pk2(f_[4] * rr_ * G1.x, f_[5] * rr_ * G1.y), pk2(f_[6] * rr_ * G1.z, f_[7] * rr_ * G1.w)}; \
            const v4u o1_ = (v4u){pk2(f_[8] * rr_ * G2.x, f_[9] * rr_ * G2.y), pk2(f_[10] * rr_ * G2.z, f_[11] * rr_ * G2.w), pk2(f_[12] * rr_ * G3.x, f_[13] * rr_ * G3.y), pk2(f_[14] * rr_ * G3.z, f_[15] * rr_ * G3.w)}; \
            *(v4u*)(DST) = o0_; *(v4u*)((DST) + 8) = o1_; } while (0)
        HEADNORM(qa, qb, gq0, gq1, gq2, gq3, QN + (size_t)r * 1024 + 16 * lane);
        HEADNORM(ka, kb, gk0, gk1, gk2, gk3, KN + (size_t)r * 1024 + 16 * lane);
#undef HEADNORM
        if (lane < 32) { const float g = graw + gbias; const int dir = lane >> 4, isf = (lane >> 3) & 1, h = lane & 7;
            const size_t idx = (((size_t)dir * NB + b) * 8 + h) * TT + t;
            if (isf) LF[idx] = fminf(g, 0.f) - log1pf(expf(-fabsf(g))); else LI[idx] = g; } } }
    { const int sc = gw & 3, nblk = NGW >> 2, RB = (M0 + nblk - 1) / nblk, c0 = 512 * sc + 8 * lane; const float* cw = C.in[I_L0 + E_CW] + c0; const float* cb = C.in[I_L0 + E_CB] + c0;
      const f32x4 wa0 = *(const f32x4*)(cw), wb0 = *(const f32x4*)(cw + 4), wa1 = *(const f32x4*)(cw + 2048), wb1 = *(const f32x4*)(cw + 2048 + 4), wa2 = *(const f32x4*)(cw + 4096), wb2 = *(const f32x4*)(cw + 4096 + 4);
      const f32x4 wa3 = *(const f32x4*)(cw + 6144), wb3 = *(const f32x4*)(cw + 6144 + 4), wa4 = *(const f32x4*)(cw + 8192), wb4 = *(const f32x4*)(cw + 8192 + 4), ba = *(const f32x4*)(cb), bb = *(const f32x4*)(cb + 4);
      const float ksc = sc >= 2 ? 0.08838834764831845f : 1.f;
      const int r0 = (gw >> 2) * RB, r1 = (r0 + RB < M0) ? r0 + RB : M0;
      if (r0 < M0) {
#define LDROW(rr_) (*(const v4u*)(PB + (size_t)((rr_) < 0 ? 0 : ((rr_) >= M0 ? M0 - 1 : (rr_))) * NIN0P + C_MLQK + c0))
#define SEGID(rr_) (((rr_) < 0 || (rr_) >= M0) ? -1 : 2 * ((rr_) / TT) + (((rr_) % TT) >= LCTX ? 1 : 0))
        v4u x0 = LDROW(r0 - 2), x1 = LDROW(r0 - 1), x2 = LDROW(r0), x3 = LDROW(r0 + 1), x4 = LDROW(r0 + 2);
        int g0 = SEGID(r0 - 2), g1 = SEGID(r0 - 1), g2 = SEGID(r0), g3 = SEGID(r0 + 1), g4 = SEGID(r0 + 2);
        for (int r = r0; r < r1; ++r) { const v4u xn = LDROW(r + 3); const int gn = SEGID(r + 3);
            f32x4 aa = ba, ab = bb;
#define TAP(X, G, WA, WB) do { const unsigned m_ = (G == g2) ? 0xffffffffu : 0u; const unsigned x_ = X.x & m_, y_ = X.y & m_, z_ = X.z & m_, w_ = X.w & m_; \
                aa += WA * (f32x4){bf2f(x_ & 0xffffu), bf2f(x_ >> 16), bf2f(y_ & 0xffffu), bf2f(y_ >> 16)}; ab += WB * (f32x4){bf2f(z_ & 0xffffu), bf2f(z_ >> 16), bf2f(w_ & 0xffffu), bf2f(w_ >> 16)}; } while (0)
            TAP(x0, g0, wa0, wb0); TAP(x1, g1, wa1, wb1); TAP(x2, g2, wa2, wb2); TAP(x3, g3, wa3, wb3); TAP(x4, g4, wa4, wb4);
#undef TAP
            const v4u o = (v4u){pk2(siluf(aa.x) * ksc, siluf(aa.y) * ksc), pk2(siluf(aa.z) * ksc, siluf(aa.w) * ksc), pk2(siluf(ab.x) * ksc, siluf(ab.y) * ksc), pk2(siluf(ab.z) * ksc, siluf(ab.w) * ksc)};
            bf16* dst = (sc >= 2 ? MK + (size_t)r * 1024 + (c0 - 1024) : MQ + (size_t)r * 1024 + c0); *(v4u*)dst = o;
            x0 = x1; x1 = x2; x2 = x3; x3 = x4; x4 = xn; g0 = g1; g1 = g2; g2 = g3; g3 = g4; g4 = gn; }
#undef SEGID
#undef LDROW
      } }
}
__device__ __forceinline__ void p_mlfin_l0(const Ctx& C0) { const Ctx C = phase_ctx(C0);
    const int gw = C.bid * NWAVES + C.wave, NGW = C.G * NWAVES, lane = C.lane;
    const float* HM = WSP(const float, WS_HM); const bf16* PB = WSP(const bf16, WS_PROJ); bf16* AO = WSP(bf16, WS_AO);
    for (int r = gw; r < M0; r += NGW) { float f[16]; float s = 0.f;
#pragma unroll
        for (int q = 0; q < 4; ++q) { const f32x4 a = *(const f32x4*)(HM + (size_t)r * 1024 + 16 * lane + 4 * q), bq = *(const f32x4*)(HM + (size_t)(M0 + r) * 1024 + 16 * lane + 4 * q);
            f[4 * q] = a.x + bq.x; f[4 * q + 1] = a.y + bq.y; f[4 * q + 2] = a.z + bq.z; f[4 * q + 3] = a.w + bq.w; }
#pragma unroll
        for (int i = 0; i < 16; ++i) s += f[i] * f[i];
        s += __shfl_xor(s, 1); s += __shfl_xor(s, 2); s += __shfl_xor(s, 4);
        const float rr = 1.f / sqrtf(s * (1.f / 128.f) + EPS); const float* g = C.in[I_L0 + E_HN] + 16 * lane; const bf16* mo = PB + (size_t)r * NIN0P + C_MLO + 16 * lane; unsigned o[8];
#pragma unroll
        for (int i = 0; i < 8; ++i) o[i] = pk2(f[2 * i] * rr * g[2 * i] * sigmf(bf2f(mo[2 * i])), f[2 * i + 1] * rr * g[2 * i + 1] * sigmf(bf2f(mo[2 * i + 1])));
        bf16* dst = AO + (size_t)r * D + 1024 + 16 * lane; *(v4u*)dst = (v4u){o[0], o[1], o[2], o[3]}; *(v4u*)(dst + 8) = (v4u){o[4], o[5], o[6], o[7]}; }
}
__device__ __forceinline__ void p_prep_l1(const Ctx& C0) { const Ctx C = phase_ctx(C0);
    const int gw = C.bid * NWAVES + C.wave, NGW = C.G * NWAVES, lane = C.lane, grp = lane >> 2, dA = 16 * (lane & 3);
    const bf16* PB = WSP(const bf16, WS_PROJ); bf16* Q1 = WSP(bf16, WS_QK); bf16* K1 = Q1 + (size_t)32 * SEQ * 128;
    const float* rc = WSP(const float, WS_ROPE); const float* rs = rc + SEQ * 64;
    f32x4 gq[8], gk[8];
#pragma unroll
    for (int q = 0; q < 4; ++q) { gq[q] = *(const f32x4*)(C.in[I_L1 + O_QN] + dA + 4 * q); gq[4 + q] = *(const f32x4*)(C.in[I_L1 + O_QN] + 64 + dA + 4 * q);
                                  gk[q] = *(const f32x4*)(C.in[I_L1 + O_KN] + dA + 4 * q); gk[4 + q] = *(const f32x4*)(C.in[I_L1 + O_KN] + 64 + dA + 4 * q); }
    for (int r = gw; r < M0; r += NGW) { const int b = r / TT, t = r - b * TT; const bool lat = t >= LCTX; const int s = lat ? t - LCTX : 0;
        const bf16* src = PB + (size_t)r * NIN1 + grp * 128 + dA;
        v4u xq[4], xk[4]; f32x4 cs[4], sn[4];
#pragma unroll
        for (int q = 0; q < 2; ++q) { xk[q] = *(const v4u*)(src + 2048 + 8 * q); xk[2 + q] = *(const v4u*)(src + 2048 + 64 + 8 * q); xq[q] = *(const v4u*)(src + 8 * q); xq[2 + q] = *(const v4u*)(src + 64 + 8 * q); }
#pragma unroll
        for (int q = 0; q < 4; ++q) { cs[q] = *(const f32x4*)(rc + (size_t)s * 64 + dA + 4 * q); sn[q] = *(const f32x4*)(rs + (size_t)s * 64 + dA + 4 * q); }
#pragma unroll
        for (int qk = 0; qk < 2; ++qk) { if (qk == 0 && !lat) continue;
            float f[32]; float ss = 0.f;
#pragma unroll
            for (int q = 0; q < 4; ++q) { const v4u a = qk ? xk[q] : xq[q]; const unsigned w[4] = {a.x, a.y, a.z, a.w};
#pragma unroll
                for (int i = 0; i < 4; ++i) { f[8 * q + 2 * i] = bf2f(w[i] & 0xffffu); f[8 * q + 2 * i + 1] = bf2f(w[i] >> 16); } }
#pragma unroll
            for (int i = 0; i < 32; ++i) ss += f[i] * f[i];
            ss += __shfl_xor(ss, 1); ss += __shfl_xor(ss, 2);
            const float rr = 1.f / sqrtf(ss * (1.f / 128.f) + EPS);
#pragma unroll
            for (int i = 0; i < 32; ++i) f[i] = f[i] * rr * (qk ? gk[i >> 2][i & 3] : gq[i >> 2][i & 3]);
            if (lat) {
#pragma unroll
                for (int i = 0; i < 16; ++i) { const float c = cs[i >> 2][i & 3], sv = sn[i >> 2][i & 3], xa = f[i], xb = f[16 + i]; f[i] = xa * c - xb * sv; f[16 + i] = xb * c + xa * sv; } }
            bf16* dst = qk ? K1 + (((size_t)b * 16 + grp) * TT + t) * 128 + dA : Q1 + (((size_t)b * 16 + grp) * SEQ + s) * 128 + dA;
#pragma unroll
            for (int q = 0; q < 4; ++q) { unsigned ow[4];
#pragma unroll
                for (int i = 0; i < 4; ++i) ow[i] = pk2(f[8 * q + 2 * i], f[8 * q + 2 * i + 1]);
                *(v4u*)(dst + (q >> 1) * 64 + 8 * (q & 1)) = (v4u){ow[0], ow[1], ow[2], ow[3]}; } }
    }
}
namespace da {
typedef unsigned short bf16;
constexpr int D = 128, NW = 8, QBLK = 32, KVBLK = 64, SDEPTH = 2;
constexpr float SCALE = 0.088388347648318440f, THR = 8.f;
constexpr size_t SHM_V = KVBLK * D * 2, SHM_K = KVBLK * D * 2, SHM_ATTN = 2 * SHM_V + 2 * SHM_K + NW * 64 * 4;
using bf16x8 = __attribute__((ext_vector_type(8))) short;
using s16x4  = __attribute__((ext_vector_type(4))) short;
using f32x16 = __attribute__((ext_vector_type(16))) float;
using f32x8  = __attribute__((ext_vector_type(8))) float;
using u32x4  = __attribute__((ext_vector_type(4))) unsigned;
#define KSWZ(row, colB) ((row) * 256 + ((colB) ^ (((row) & 7) << 4)))
#define SBAR() __builtin_amdgcn_sched_barrier(0)
__device__ __forceinline__ int crow(int r, int hi) { return (r & 3) + 8 * (r >> 2) + 4 * hi; }
__device__ __forceinline__ unsigned cvtpk(float lo, float hi) {
  unsigned r; asm volatile("v_cvt_pk_bf16_f32 %0, %1, %2" : "=v"(r) : "v"(lo), "v"(hi)); return r;
}

__device__ __forceinline__ void partialSM(f32x16& p0, f32x16& p1, float& m_reg, float& mn, float& alpha) {
  constexpr float C = SCALE * 1.4426950408889634f;
  float pmax = p0[0]; for (int r = 1; r < 16; ++r) pmax = fmaxf(pmax, p0[r]); for (int r = 0; r < 16; ++r) pmax = fmaxf(pmax, p1[r]);
  { auto rr = __builtin_amdgcn_permlane32_swap(__float_as_uint(pmax), __float_as_uint(pmax), false, false);
    pmax = fmaxf(__uint_as_float(rr[0]), __uint_as_float(rr[1])); }
  if (__builtin_expect(__all(pmax - m_reg <= THR / SCALE), 1)) { mn = m_reg; alpha = 1.f; }
  else { mn = fmaxf(m_reg, pmax); alpha = __builtin_amdgcn_exp2f((m_reg - mn) * C); m_reg = mn; }
  float mnC = -mn * C;
  for (int r = 0; r < 16; ++r) p0[r] = fmaf(p0[r], C, mnC); for (int r = 0; r < 16; ++r) p1[r] = fmaf(p1[r], C, mnC);
  for (int r = 0; r < 16; ++r) p0[r] = __builtin_amdgcn_exp2f(p0[r]);
}
__device__ __forceinline__ void finishSM(f32x16& p0, f32x16& p1, float alpha, float& l_reg, bf16x8& pa0, bf16x8& pa1, bf16x8& pa2, bf16x8& pa3) {
  for (int r = 0; r < 16; ++r) p1[r] = __builtin_amdgcn_exp2f(p1[r]);
  float ps = 0; for (int r = 0; r < 16; ++r) ps += p0[r]; for (int r = 0; r < 16; ++r) ps += p1[r];
  { auto rr = __builtin_amdgcn_permlane32_swap(__float_as_uint(ps), __float_as_uint(ps), false, false);
    ps = __uint_as_float(rr[0]) + __uint_as_float(rr[1]); }
  l_reg = l_reg * alpha + ps;
#define PK4(P, BASE, OUT) do { unsigned a0 = cvtpk(P[BASE + 0], P[BASE + 1]), a1 = cvtpk(P[BASE + 2], P[BASE + 3]);   \
    unsigned b0 = cvtpk(P[BASE + 4], P[BASE + 5]), b1 = cvtpk(P[BASE + 6], P[BASE + 7]);                              \
    auto r0 = __builtin_amdgcn_permlane32_swap(a0, b0, false, false); auto r1 = __builtin_amdgcn_permlane32_swap(a1, b1, false, false); \
    u32x4 w = {r0[0], r1[0], r0[1], r1[1]}; OUT = *reinterpret_cast<bf16x8*>(&w); } while (0)
  PK4(p0, 0, pa0); PK4(p0, 8, pa1); PK4(p1, 0, pa2); PK4(p1, 8, pa3);
#undef PK4
}
__device__ __forceinline__ void qkt(f32x16& p0, f32x16& p1, const bf16* Ks, const bf16x8* qr, int r32, int hi) {
  p0 = f32x16{}; p1 = f32x16{};
  for (int d0 = 0; d0 < 8; ++d0) { int cb = (d0 * 16 + hi * 8) * 2;
    bf16x8 b0 = *reinterpret_cast<const bf16x8*>((const char*)Ks + KSWZ(r32, cb));
    bf16x8 b1 = *reinterpret_cast<const bf16x8*>((const char*)Ks + KSWZ(32 + r32, cb));
    p0 = __builtin_amdgcn_mfma_f32_32x32x16_bf16(b0, qr[d0], p0, 0, 0, 0);
    p1 = __builtin_amdgcn_mfma_f32_32x32x16_bf16(b1, qr[d0], p1, 0, 0, 0); }
}
__device__ __forceinline__ int v_st(int k, int c) { const int kk = (k & ~0xC) | ((k & 4) << 1) | ((k & 8) >> 1); return ((kk >> 3) * 4 + (c >> 5)) * 512 + ((kk & 7) * 32 + (c & 31)) * 2; }
__device__ __forceinline__ int v_rd_base(int lane) { return ((lane & 3) << 3) | (((lane >> 2) & 3) << 6) | (((lane >> 4) & 1) << 5) | (((lane >> 5) & 1) << 8); }
constexpr int v_rd_off(int d0, int ks, int half) { return d0 * 512 + ks * 4096 + half * 2048; }
template <int OFF> __device__ __forceinline__ s16x4 tr_read(int vb) {
  s16x4 r; asm volatile("ds_read_b64_tr_b16 %0, %1 offset:%2" : "=&v"(r) : "v"(vb), "i"(OFF) : "memory"); return r;
}
template <int D0> __device__ __forceinline__ void pv_one(f32x16& od, int vb, bf16x8 pa0, bf16x8 pa1, bf16x8 pa2, bf16x8 pa3) {
  const s16x4 l0 = tr_read<v_rd_off(D0, 0, 0)>(vb), h0 = tr_read<v_rd_off(D0, 0, 1)>(vb), l1 = tr_read<v_rd_off(D0, 1, 0)>(vb), h1 = tr_read<v_rd_off(D0, 1, 1)>(vb);
  const s16x4 l2 = tr_read<v_rd_off(D0, 2, 0)>(vb), h2 = tr_read<v_rd_off(D0, 2, 1)>(vb), l3 = tr_read<v_rd_off(D0, 3, 0)>(vb), h3 = tr_read<v_rd_off(D0, 3, 1)>(vb);
  asm volatile("s_waitcnt lgkmcnt(0)" ::: "memory"); SBAR();
#define PK(L, H) (bf16x8){L[0], L[1], L[2], L[3], H[0], H[1], H[2], H[3]}
  od = __builtin_amdgcn_mfma_f32_32x32x16_bf16(pa0, PK(l0, h0), od, 0, 0, 0);
  od = __builtin_amdgcn_mfma_f32_32x32x16_bf16(pa1, PK(l1, h1), od, 0, 0, 0);
  od = __builtin_amdgcn_mfma_f32_32x32x16_bf16(pa2, PK(l2, h2), od, 0, 0, 0);
  od = __builtin_amdgcn_mfma_f32_32x32x16_bf16(pa3, PK(l3, h3), od, 0, 0, 0);
#undef PK
}
__device__ __forceinline__ void pv_d0(f32x16* o, int vb, bf16x8 pa0, bf16x8 pa1, bf16x8 pa2, bf16x8 pa3) {
  pv_one<0>(o[0], vb, pa0, pa1, pa2, pa3); pv_one<1>(o[1], vb, pa0, pa1, pa2, pa3); pv_one<2>(o[2], vb, pa0, pa1, pa2, pa3); pv_one<3>(o[3], vb, pa0, pa1, pa2, pa3);
}

template <int LDQ, int LDK, int LDV, int LDO>
__device__ __forceinline__ void attn_dense_body(const bf16* __restrict__ Qb, const bf16* __restrict__ Kh, const bf16* __restrict__ Vh,
                                                int mode, float* Sw, const float* Sa, bf16* __restrict__ Ob, const float* __restrict__ gain, float lam, float post, int seq, char* lds) {
  int tz = threadIdx.x; asm volatile("" : "+v"(tz));
  const int tid = tz, wid = tid >> 6, lane = tid & 63, r32 = lane & 31, hi = lane >> 5;
  bf16* V_lds = (bf16*)lds; bf16* K_lds = (bf16*)(lds + 2 * SHM_V);
  float* ws = (float*)(lds + 2 * SHM_V + 2 * SHM_K) + wid * 64; float* li_l = ws; float* al_l = ws + 32;
  float m_reg = -1e30f, l_reg = 0; f32x16 o[4] = {}; bf16x8 qr[8];
  const bf16* Qw = Qb + (long)(wid * QBLK + r32) * LDQ + hi * 8;
#pragma unroll
  for (int d0 = 0; d0 < 8; ++d0) qr[d0] = *reinterpret_cast<const bf16x8*>(Qw + d0 * 16);
  const int sr = tid >> 4, sc = (tid & 15) * 8, vst0 = v_st(sr, sc), vst1 = v_st(32 + sr, sc);
  const int vb0 = (int)(uintptr_t)V_lds + v_rd_base(lane);
  struct { bf16x8 vs0, vs1, ks0, ks1; } sr_[SDEPTH];
#define SLOAD(i, k0) do { sr_[i].vs0 = *reinterpret_cast<const bf16x8*>(&Vh[(long)((k0) + sr) * LDV + sc]); sr_[i].vs1 = *reinterpret_cast<const bf16x8*>(&Vh[(long)((k0) + 32 + sr) * LDV + sc]); \
    sr_[i].ks0 = *reinterpret_cast<const bf16x8*>(&Kh[(long)((k0) + sr) * LDK + sc]); sr_[i].ks1 = *reinterpret_cast<const bf16x8*>(&Kh[(long)((k0) + 32 + sr) * LDK + sc]); } while (0)
#define SWRITE(b, i) do { *(bf16x8*)((char*)V_lds + (b) * SHM_V + vst0) = sr_[i].vs0;          \
    *(bf16x8*)((char*)V_lds + (b) * SHM_V + vst1) = sr_[i].vs1; int kc = sc * 2;               \
    *(bf16x8*)((char*)K_lds + (b) * SHM_K + KSWZ(sr, kc)) = sr_[i].ks0;                       \
    *(bf16x8*)((char*)K_lds + (b) * SHM_K + KSWZ(32 + sr, kc)) = sr_[i].ks1; } while (0)
#define SWAIT() do { if constexpr (SDEPTH == 2) asm volatile("s_waitcnt vmcnt(4)" ::: "memory"); else asm volatile("s_waitcnt vmcnt(0)" ::: "memory"); } while (0)
#define RESC(a) do { if (__any((a) < 1.f)) { if (hi == 0) al_l[r32] = (a); asm volatile("s_waitcnt lgkmcnt(0)" ::: "memory"); \
    for (int d = 0; d < 4; ++d) for (int r = 0; r < 16; ++r) o[d][r] *= al_l[crow(r, hi)]; } } while (0)
  f32x16 pA0, pA1, pB0, pB1; float mnA, mnB, alA, alB; bf16x8 pa0, pa1, pa2, pa3; const int NT = seq / KVBLK;
  constexpr int SE = 0, SO = SDEPTH - 1;
  SLOAD(SE, 0); asm volatile("s_waitcnt vmcnt(0)" ::: "memory"); SWRITE(0, SE); __syncthreads();
  qkt(pA0, pA1, K_lds, qr, r32, hi); partialSM(pA0, pA1, m_reg, mnA, alA);
  SLOAD(SO, KVBLK); if constexpr (SDEPTH == 2) { if (2 < NT) SLOAD(SE, 2 * KVBLK); }
  SWAIT(); SWRITE(1, SO); __syncthreads();
  for (int j = 1; j + 1 < NT; j += 2) {
    SBAR(); qkt(pB0, pB1, (bf16*)((char*)K_lds + SHM_K), qr, r32, hi);
    finishSM(pA0, pA1, alA, l_reg, pa0, pa1, pa2, pa3); SBAR();
    SLOAD(SO, (j + SDEPTH) * KVBLK); SBAR();
    pv_d0(o, vb0, pa0, pa1, pa2, pa3); partialSM(pB0, pB1, m_reg, mnB, alB);
    __syncthreads(); SWAIT(); SWRITE(0, SE);
    RESC(alB); __syncthreads();
    SBAR(); qkt(pA0, pA1, K_lds, qr, r32, hi);
    finishSM(pB0, pB1, alB, l_reg, pa0, pa1, pa2, pa3); SBAR();
    if (SDEPTH == 1 || j + 3 < NT) SLOAD(SE, (j + 1 + SDEPTH) * KVBLK); SBAR();
    pv_d0(o, vb0 + (int)SHM_V, pa0, pa1, pa2, pa3); partialSM(pA0, pA1, m_reg, mnA, alA);
    __syncthreads(); SWAIT(); SWRITE(1, SO);
    RESC(alA); __syncthreads();
  }
  SBAR(); qkt(pB0, pB1, (bf16*)((char*)K_lds + SHM_K), qr, r32, hi);
  finishSM(pA0, pA1, alA, l_reg, pa0, pa1, pa2, pa3); SBAR();
  pv_d0(o, vb0, pa0, pa1, pa2, pa3); partialSM(pB0, pB1, m_reg, mnB, alB);
  __syncthreads(); RESC(alB);
  finishSM(pB0, pB1, alB, l_reg, pa0, pa1, pa2, pa3); SBAR();
  pv_d0(o, vb0 + (int)SHM_V, pa0, pa1, pa2, pa3);
  if (hi == 0) li_l[r32] = l_reg; asm volatile("s_waitcnt lgkmcnt(0)" ::: "memory");
  float rli[16];
#pragma unroll
  for (int r = 0; r < 16; ++r) rli[r] = __builtin_amdgcn_rcpf(li_l[crow(r, hi)]);
  __syncthreads();
  { float* Ls = (float*)lds + wid * (QBLK * 128);
#pragma unroll
    for (int r = 0; r < 16; ++r) { const int orow = crow(r, hi);
#pragma unroll
      for (int d0 = 0; d0 < 4; ++d0) Ls[orow * 128 + d0 * 32 + r32] = o[d0][r] * rli[r]; }
    asm volatile("s_waitcnt lgkmcnt(0)" ::: "memory"); __builtin_amdgcn_wave_barrier();
    for (int r0 = 0; r0 < QBLK; r0 += 4) { float vx[4], vy[4];
      const long ob = (wid * QBLK + r0) * 128L + 2 * lane;
#pragma unroll
      for (int x = 0; x < 4; ++x) { vx[x] = Ls[(r0 + x) * 128 + 2 * lane]; vy[x] = Ls[(r0 + x) * 128 + 2 * lane + 1]; }
      if (mode == 0) {
#pragma unroll
        for (int x = 0; x < 4; ++x) { Sw[ob + 128 * x] = vx[x]; Sw[ob + 128 * x + 1] = vy[x]; } }
      else if (mode == 1) { float s0[4], s1[4];
#pragma unroll
        for (int x = 0; x < 4; ++x) { s0[x] = Sw[ob + 128 * x]; s1[x] = Sw[ob + 128 * x + 1]; }
#pragma unroll
        for (int x = 0; x < 4; ++x) { Sw[ob + 128 * x] = s0[x] - lam * vx[x]; Sw[ob + 128 * x + 1] = s1[x] - lam * vy[x]; } }
      else { float s0[4], s1[4], a0[4], a1[4], b0[4], b1[4], ss[4];
#pragma unroll
        for (int x = 0; x < 4; ++x) { s0[x] = Sw[ob + 128 * x]; s1[x] = Sw[ob + 128 * x + 1]; a0[x] = Sa[ob + 128 * x]; a1[x] = Sa[ob + 128 * x + 1]; }
#pragma unroll
        for (int x = 0; x < 4; ++x) { b0[x] = s0[x] - lam * vx[x]; b1[x] = s1[x] - lam * vy[x]; ss[x] = a0[x] * a0[x] + a1[x] * a1[x] + b0[x] * b0[x] + b1[x] * b1[x]; }
#pragma unroll
        for (int off = 1; off < 64; off <<= 1) {
#pragma unroll
          for (int x = 0; x < 4; ++x) ss[x] += __shfl_xor(ss[x], off); }
#pragma unroll
        for (int x = 0; x < 4; ++x) { const float rn = post / sqrtf(ss[x] * (1.f / 256.f) + 1e-6f); bf16* orp = Ob + (wid * QBLK + r0 + x) * (long)LDO + 2 * lane;
          *(unsigned*)orp = cvtpk(a0[x] * rn * gain[2 * lane], a1[x] * rn * gain[2 * lane + 1]); *(unsigned*)(orp + 128) = cvtpk(b0[x] * rn * gain[128 + 2 * lane], b1[x] * rn * gain[128 + 2 * lane + 1]); } } } }
#undef SLOAD
#undef SWRITE
#undef SWAIT
#undef RESC
}

#undef KSWZ
#undef SBAR
}
__device__ __forceinline__ bf16x8 ld_frag(const LAS bf16* base, int ld, int x0, int k0, int lane) { return *(const LAS bf16x8*)(base + (x0 + (lane & 15)) * ld + k0 + 8 * (lane >> 4)); }
#define MFMA16(a, b, c) __builtin_amdgcn_mfma_f32_16x16x32_bf16((a), (b), (c), 0, 0, 0)
__device__ __forceinline__ float grp16_max(float v) { v = fmaxf(v, __shfl_xor(v, 1)); v = fmaxf(v, __shfl_xor(v, 2)); v = fmaxf(v, __shfl_xor(v, 4)); v = fmaxf(v, __shfl_xor(v, 8)); return v; }
__device__ __forceinline__ float grp16_sum(float v) { v += __shfl_xor(v, 1); v += __shfl_xor(v, 2); v += __shfl_xor(v, 4); v += __shfl_xor(v, 8); return v; }
typedef short s16x4 __attribute__((ext_vector_type(4)));
__device__ __forceinline__ int lds_addr(const LAS void* p) { return (int)(unsigned)(unsigned long)p; }
__device__ __forceinline__ void tr_frag_issue(s16x4& lo, s16x4& hi, const LAS bf16* T, int ld, int k0, int n0, int lane) {
    const int g = lane >> 4, q = (lane >> 2) & 3, p = lane & 3; const int addr = lds_addr(T + (k0 + 8 * g + q) * ld + n0 + 4 * p);
    asm volatile("ds_read_b64_tr_b16 %0, %1" : "=&v"(lo) : "v"(addr) : "memory");
    asm volatile("ds_read_b64_tr_b16 %0, %1" : "=&v"(hi) : "v"(addr + 4 * ld * 2) : "memory");
}
#define TR_PK(L, H) (bf16x8){L[0], L[1], L[2], L[3], H[0], H[1], H[2], H[3]}
constexpr int LDK = 136, LDT = 72;
constexpr float NEG_BIG = -1e30f;

template <int DV> struct AttnState { f32x4 o[DV / 16]; float m[4], l[4];
    __device__ __forceinline__ void init() {
#pragma unroll
        for (int n = 0; n < DV / 16; ++n) o[n] = (f32x4){0.f, 0.f, 0.f, 0.f};
#pragma unroll
        for (int i = 0; i < 4; ++i) { m[i] = NEG_BIG; l[i] = 0.f; } } };
template <int DV, class Bias> __device__ __forceinline__ void attn_tile(AttnState<DV>& st, const bf16x8 (&qf)[4], const LAS bf16* sK, const LAS bf16* sV, LAS bf16* sP, float scale, const Bias& bias, int lane, int jlo, int jhi) {
    f32x4 s[4];
#pragma unroll
    for (int j = 0; j < 4; ++j) { s[j] = (f32x4){0.f, 0.f, 0.f, 0.f};
        if (j >= jlo && j < jhi) {
#pragma unroll
            for (int ks = 0; ks < 4; ++ks) s[j] = MFMA16(qf[ks], ld_frag(sK, LDK, 16 * j, 32 * ks, lane), s[j]); } }
    float alpha[4];
#pragma unroll
    for (int i = 0; i < 4; ++i) { float v[4]; bool ok[4]; float mx = NEG_BIG;
#pragma unroll
        for (int j = 0; j < 4; ++j) { ok[j] = false; v[j] = 0.f; if (j >= jlo && j < jhi) { const float bb = bias(i, j); ok[j] = bb > -1e29f; v[j] = s[j][i] * scale + bb; mx = ok[j] ? fmaxf(mx, v[j]) : mx; } }
        mx = grp16_max(mx); const float mn = fmaxf(st.m[i], mx); alpha[i] = __expf(st.m[i] - mn); st.m[i] = mn; float ps = 0.f;
#pragma unroll
        for (int j = 0; j < 4; ++j) { float p = 0.f; if (j >= jlo && j < jhi) p = ok[j] ? __expf(v[j] - mn) : 0.f; ps += p; sP[(4 * (lane >> 4) + i) * LDT + 16 * j + (lane & 15)] = (bf16)f2bf(p); }
        st.l[i] = st.l[i] * alpha[i] + ps; }
#pragma unroll
    for (int n = 0; n < DV / 16; ++n) { st.o[n][0] *= alpha[0]; st.o[n][1] *= alpha[1]; st.o[n][2] *= alpha[2]; st.o[n][3] *= alpha[3]; }
    LDS_WAIT(); __builtin_amdgcn_wave_barrier();
    const bf16x8 pa0 = ld_frag(sP, LDT, 0, 0, lane), pa1 = ld_frag(sP, LDT, 0, 32, lane);
#pragma unroll
    for (int half = 0; half < DV / 64; ++half) {
        s16x4 vl[4][2], vh[4][2];
#pragma unroll
        for (int n = 0; n < 4; ++n)
#pragma unroll
            for (int ks = 0; ks < 2; ++ks) tr_frag_issue(vl[n][ks], vh[n][ks], sV, LDK, 32 * ks, 16 * (4 * half + n), lane);
        asm volatile("s_waitcnt lgkmcnt(0)" ::: "memory"); __builtin_amdgcn_sched_barrier(0);
#pragma unroll
        for (int n = 0; n < 4; ++n) { if (jlo < 2) st.o[4 * half + n] = MFMA16(pa0, TR_PK(vl[n][0], vh[n][0]), st.o[4 * half + n]); if (jhi > 2) st.o[4 * half + n] = MFMA16(pa1, TR_PK(vl[n][1], vh[n][1]), st.o[4 * half + n]); }
        __builtin_amdgcn_sched_barrier(0); }
}
__device__ __forceinline__ void load_qfrag(bf16x8 (&qf)[4], const bf16* qrow0, size_t qld, int lane) {
#pragma unroll
    for (int ks = 0; ks < 4; ++ks) qf[ks] = *(const bf16x8*)(qrow0 + (size_t)(lane & 15) * qld + 32 * ks + 8 * (lane >> 4));
}
struct NoBias { __device__ __forceinline__ float operator()(int, int) const { return 0.f; } };

struct NaBias { const LAS float* rpb; int dr  , w0  ; int lane;
    __device__ __forceinline__ float operator()(int i, int j) const { const int w = w0 + i, col = 16 * j + (lane & 15); int c0 = w - 8; c0 = c0 < 0 ? 0 : (c0 > 48 ? 48 : c0);
        return (col >= c0 && col < c0 + 16) ? rpb[dr * 31 + (col - w + 15)] : NEG_BIG; } };
__device__ __forceinline__ void p_na_l0(const Ctx& C0, int qsel) { const Ctx C = phase_ctx(C0);
    LAS bf16* sK = (LAS bf16*)C.lds; LAS bf16* sV = sK + 64 * LDK; LAS bf16* sP = sV + 64 * LDK + C.wave * (16 * LDT); LAS float* sRpb = (LAS float*)(C.lds + 65536);
    const bf16* PB = WSP(const bf16, WS_PROJ); const bf16* QN = WSP(const bf16, WS_QK); const bf16* KN = QN + (size_t)M0 * 1024; bf16* AO = WSP(bf16, WS_AO);
    const float scale = 0.08838834764831845f; const int lane = C.lane, wave = C.wave;
    LAS int* sUnit = (LAS int*)(C.lds + 65536 + 2048);
    const int sj = C.tid >> 4, sq = C.tid & 15;
    unsigned* naq = WSP(unsigned, WS_CTL) + CW_NAQ + 64 * qsel;
    __syncthreads();
    if (C.tid == 0) sUnit[0] = (int)atomicAdd(naq, 1u);
    __syncthreads();
    int u = sUnit[0];
    while (u < 512 + 32) {
        unsigned nxtu = 0u; if (C.tid == 0) nxtu = atomicAdd(naq, 1u);
        const bool ctxq = u >= 512; const int v = ctxq ? u - 512 : u; const int b = ctxq ? v / 16 : v / 256, h = ctxq ? (v / 2) % 8 : (v / 32) % 8, rp = v % 32;
        const size_t rowb = (size_t)b * TT;
        int r = 0, q0; if (ctxq) q0 = 128 * (v & 1) + 16 * wave; else { r = 2 * rp + (wave >> 2); q0 = LCTX + r * 64 + 16 * (wave & 3); }
        bf16x8 qf[4]; load_qfrag(qf, QN + (rowb + q0) * 1024 + h * 128, 1024, lane);
        AttnState<128> st; st.init(); const int gq = wave & 3, jl = gq < 2 ? 0 : gq - 1, jh = gq > 1 ? 4 : gq + 2;
        int kr0 = r - 4; kr0 = kr0 < 0 ? 0 : (kr0 > 56 ? 56 : kr0);
        int lo = 2 * rp - 4; lo = lo < 0 ? 0 : (lo > 56 ? 56 : lo); int hi = 2 * rp + 1 - 4; hi = (hi < 0 ? 0 : (hi > 56 ? 56 : hi)) + 7;
        const int nloc = ctxq ? 0 : hi - lo + 1, ntile = nloc + 4;
        if (!ctxq) for (int i = C.tid; i < 15 * 31; i += NTHR) sRpb[i] = C.in[I_L0 + E_RPB][h * 465 + i];
#define NA_KROW(tl) (rowb + ((tl) < nloc ? LCTX + (lo + (tl)) * 64 : ((tl) - nloc) * 64))
#define NA_LOAD(tl) do { const size_t kr_ = NA_KROW(tl); const bf16* kp = KN + kr_ * 1024 + h * 128 + 8 * sq; const bf16* vp = PB + kr_ * NIN0P + C_NAV + h * 128 + 8 * sq; \
            pk0 = *(const v4u*)(kp + (size_t)sj * 1024); pk1 = *(const v4u*)(kp + (size_t)(32 + sj) * 1024); pv0 = *(const v4u*)(vp + (size_t)sj * NIN0P); pv1 = *(const v4u*)(vp + (size_t)(32 + sj) * NIN0P); } while (0)
        v4u pk0, pk1, pv0, pv1; NA_LOAD(0);
        for (int tl = 0; tl < ntile; ++tl) {
            const bool loc = tl < nloc; const int kr = lo + tl;
            int lz = lane; asm volatile("" : "+v"(lz));
            __syncthreads();
            *(LAS v4u*)(sK + sj * LDK + 8 * sq) = pk0; *(LAS v4u*)(sK + (32 + sj) * LDK + 8 * sq) = pk1; *(LAS v4u*)(sV + sj * LDK + 8 * sq) = pv0; *(LAS v4u*)(sV + (32 + sj) * LDK + 8 * sq) = pv1;
            if (tl + 1 < ntile) NA_LOAD(tl + 1);
            __syncthreads();
            if (loc) { if (kr >= kr0 && kr < kr0 + 8) { NaBias nb{sRpb, kr - r + 7, 16 * (wave & 3) + 4 * (lz >> 4), lz}; attn_tile<128>(st, qf, sK, sV, sP, scale, nb, lz, jl, jh); } }
            else attn_tile<128>(st, qf, sK, sV, sP, scale, NoBias(), lz, 0, 4);
        }
#undef NA_LOAD
#undef NA_KROW
#pragma unroll
        for (int i = 0; i < 4; ++i) { const float inv = 1.f / grp16_sum(st.l[i]); bf16* dst = AO + (rowb + q0 + 4 * (lane >> 4) + i) * D + h * 128 + (lane & 15);
#pragma unroll
            for (int n = 0; n < 8; ++n) dst[16 * n] = (bf16)f2bf(st.o[n][i] * inv); }
        __syncthreads();
        if (C.tid == 0) sUnit[0] = (int)nxtu;
        __syncthreads();
        u = sUnit[0];
    }
}
__device__ __forceinline__ void p_da_l1(const Ctx& C0) { const Ctx C = phase_ctx(C0);
    const bf16* PB = WSP(const bf16, WS_PROJ); const bf16* Q1 = WSP(const bf16, WS_QK); const bf16* K1 = Q1 + (size_t)32 * SEQ * 128; bf16* AO = WSP(bf16, WS_AO);
    float* S0 = WSP(float, WS_HM) + (size_t)C.bid * (2 * 256 * 128); float* S1 = S0 + 256 * 128;
    const float linit = 0.35550906759096926f;
    float lamf; { const float* lm = C.in[I_L1 + O_LAM]; float a = 0.f, bq = 0.f; for (int i = 0; i < 128; ++i) { a += lm[i] * lm[128 + i]; bq += lm[256 + i] * lm[384 + i]; } lamf = expf(a) - expf(bq) + linit; }
    for (int u = C.bid; u < 256; u += C.G) { const int b = u / 128, h = (u / 16) % 8, qb = u % 16;
        for (int call = 0; call < 4; ++call) { const int i = call & 1, vh = call >> 1, mode = call == 3 ? 2 : i; const size_t hi = (size_t)b * 16 + h * 2 + i;
            __syncthreads();
            da::attn_dense_body<128, 128, NIN1, D>(Q1 + (hi * SEQ + 256 * qb) * 128, K1 + hi * TT * 128, PB + (size_t)b * TT * NIN1 + 4096 + h * 256 + 128 * vh,
                mode, vh ? S1 : S0, S0, AO + ((size_t)b * SEQ + 256 * qb) * D + h * 256, C.in[I_L1 + O_SUB], lamf, 1.f - linit, TT, (char*)C.lds); } }
}
constexpr int LDV = 56;
__device__ __forceinline__ void p_mlstm_l0(const Ctx& C0) { const Ctx C = phase_ctx(C0);
    LAS bf16* sQ = (LAS bf16*)C.lds; LAS bf16* sK = sQ + 64 * LDK; LAS bf16* sKw = sK + 64 * LDK; LAS bf16* sV = sKw + 64 * LDK; LAS bf16* sP = sV + 64 * LDV; LAS bf16* sCt = sP + 64 * LDT;
    const bf16* PB = WSP(const bf16, WS_PROJ); const bf16* MQ = WSP(const bf16, WS_QK) + (size_t)2 * M0 * 1024; const bf16* MK = MQ + (size_t)M0 * 1024;
    const float* LI = WSP(const float, WS_GATE); const float* LF = LI + 2 * NB * 8 * TT; float* HM = WSP(float, WS_HM);
    const int lane = C.lane, wave = C.wave, tid = C.tid;
    for (int u = C.bid; u < 128; u += C.G) { const int sl = u & 3, dir = (u >> 2) & 1, h = (u >> 3) & 7, b = u >> 6; const size_t rowb = (size_t)b * TT;
        const float* li = LI + (((size_t)dir * NB + b) * 8 + h) * TT; const float* lf = LF + (((size_t)dir * NB + b) * 8 + h) * TT;
        f32x4 cT[2][3]; float m = 0.f;
#pragma unroll
        for (int x = 0; x < 2; ++x)
#pragma unroll
            for (int nt = 0; nt < 3; ++nt) cT[x][nt] = (f32x4){0.f, 0.f, 0.f, 0.f};
        __syncthreads();
        for (int i = tid; i < 48 * LDK; i += NTHR) sCt[i] = 0;
        for (int i = tid; i < 64 * 16; i += NTHR) sV[(i >> 4) * LDV + 32 + (i & 15)] = ((i & 15) == 0) ? (bf16)0x3F80 : (bf16)0;
#define TOK(p) (dir == 0 ? (p) : ((p) < LCTX ? LCTX - 1 - (p) : TT - 1 - ((p) - LCTX)))
        const int j0 = tid >> 4, cq = tid & 15, jv = tid >> 2, cv = tid & 3;
        float* GS = WSP(float, WS_GS) + (size_t)u * (3 * TT);
        { constexpr int NC2 = (TT / 64 + NWAVES - 1) / NWAVES;
          float bc[NC2], fi[NC2], pm[NC2];
#pragma unroll
          for (int x = 0; x < NC2; ++x) { const int c2 = wave + NWAVES * x; const int p = 64 * (c2 < TT / 64 ? c2 : 0) + lane, t = TOK(p); bc[x] = lf[t]; fi[x] = li[t]; }
#pragma unroll
          for (int o = 1; o < 64; o <<= 1) { float xv[NC2];
#pragma unroll
              for (int x = 0; x < NC2; ++x) xv[x] = __shfl_up(bc[x], o);
#pragma unroll
              for (int x = 0; x < NC2; ++x) if (lane >= o) bc[x] += xv[x]; }
#pragma unroll
          for (int x = 0; x < NC2; ++x) pm[x] = fi[x] - bc[x];
#pragma unroll
          for (int o = 1; o < 64; o <<= 1) { float xv[NC2];
#pragma unroll
              for (int x = 0; x < NC2; ++x) xv[x] = __shfl_up(pm[x], o);
#pragma unroll
              for (int x = 0; x < NC2; ++x) if (lane >= o) pm[x] = fmaxf(pm[x], xv[x]); }
#pragma unroll
          for (int x = 0; x < NC2; ++x) { const int c2 = wave + NWAVES * x; if (c2 < TT / 64) { const int p = 64 * c2 + lane; GS[p] = fi[x] - bc[x]; GS[TT + p] = pm[x]; GS[2 * TT + p] = bc[x]; } } }
        asm volatile("s_waitcnt vmcnt(0)" ::: "memory"); __syncthreads();
        v4u pq0, pq1, pk0, pk1, pv = (v4u){0u, 0u, 0u, 0u}; float pa_, ppm_, pbc_;
#define PREFETCH(p0) do { const size_t r0 = rowb + TOK((p0) + j0), r1 = rowb + TOK((p0) + 32 + j0); \
            pq0 = *(const v4u*)(MQ + r0 * 1024 + h * 128 + 8 * cq); pq1 = *(const v4u*)(MQ + r1 * 1024 + h * 128 + 8 * cq); \
            pk0 = *(const v4u*)(MK + r0 * 1024 + h * 128 + 8 * cq); pk1 = *(const v4u*)(MK + r1 * 1024 + h * 128 + 8 * cq); \
            if (tid < 256) pv = *(const v4u*)(PB + (rowb + TOK((p0) + jv)) * NIN0P + C_MLV + h * 128 + 32 * sl + 8 * cv); \
            { const int p_ = (p0) + lane; pa_ = __hip_atomic_load(GS + p_, __ATOMIC_RELAXED, __HIP_MEMORY_SCOPE_AGENT); ppm_ = __hip_atomic_load(GS + TT + p_, __ATOMIC_RELAXED, __HIP_MEMORY_SCOPE_AGENT); pbc_ = __hip_atomic_load(GS + 2 * TT + p_, __ATOMIC_RELAXED, __HIP_MEMORY_SCOPE_AGENT); } } while (0)
        PREFETCH(0);
        for (int ch = 0; ch < TT / 64; ++ch) { const int p0 = 64 * ch;
            const float a = pa_, bc = pbc_, Mt = fmaxf(m, ppm_);
            const float M63 = __builtin_bit_cast(float, __builtin_amdgcn_readlane(__builtin_bit_cast(int, Mt), 63)), bl = __builtin_bit_cast(float, __builtin_amdgcn_readlane(__builtin_bit_cast(int, bc), 63));
            const float wi = __expf(m - Mt), fl = __expf(-bc - Mt), wg = __expf(a - M63), dec = __expf(m - M63); m = bl + M63;
            __syncthreads();
            { const float w0 = __shfl(wg, j0), w1 = __shfl(wg, 32 + j0);
              *(LAS v4u*)(sQ + j0 * LDK + 8 * cq) = pq0; *(LAS v4u*)(sQ + (32 + j0) * LDK + 8 * cq) = pq1; *(LAS v4u*)(sK + j0 * LDK + 8 * cq) = pk0; *(LAS v4u*)(sK + (32 + j0) * LDK + 8 * cq) = pk1;
              const unsigned x0[4] = {pk0.x, pk0.y, pk0.z, pk0.w}, x1[4] = {pk1.x, pk1.y, pk1.z, pk1.w}; unsigned y0[4], y1[4];
#pragma unroll
              for (int i = 0; i < 4; ++i) { y0[i] = pk2(bf2f(x0[i] & 0xffffu) * w0, bf2f(x0[i] >> 16) * w0); y1[i] = pk2(bf2f(x1[i] & 0xffffu) * w1, bf2f(x1[i] >> 16) * w1); }
              *(LAS v4u*)(sKw + j0 * LDK + 8 * cq) = (v4u){y0[0], y0[1], y0[2], y0[3]}; *(LAS v4u*)(sKw + (32 + j0) * LDK + 8 * cq) = (v4u){y1[0], y1[1], y1[2], y1[3]};
              if (tid < 256) *(LAS v4u*)(sV + jv * LDV + 8 * cv) = pv; }
            if (ch + 1 < TT / 64) PREFETCH(p0 + 64);
            __syncthreads();
#pragma unroll
            for (int q = 0; q < 2; ++q) { const int tt = wave >> 1, stl = 2 * (wave & 1) + q; f32x4 s = (f32x4){0.f, 0.f, 0.f, 0.f};
                if (stl <= tt) {
#pragma unroll
                    for (int ks = 0; ks < 4; ++ks) s = MFMA16(ld_frag(sQ, LDK, 16 * tt, 32 * ks, lane), ld_frag(sK, LDK, 16 * stl, 32 * ks, lane), s); }
                const int sc = 16 * stl + (lane & 15); const float as = __shfl(a, sc);
#pragma unroll
                for (int i = 0; i < 4; ++i) { const int tr = 16 * tt + 4 * (lane >> 4) + i; const float mtr = __shfl(Mt, tr); const float p = (sc <= tr) ? s[i] * __expf(as - mtr) : 0.f; sP[tr * LDT + sc] = (bf16)f2bf(p); } }
            __syncthreads();
            const LAS bf16* sCr = sCt + (ch & 1) * (48 * LDK); LAS bf16* sCw = sCt + ((ch + 1) & 1) * (48 * LDK);
            if (wave < 4) {
                const int tt = wave; s16x4 vl[3][2], vh[3][2];
#pragma unroll
                for (int nt = 0; nt < 3; ++nt)
#pragma unroll
                    for (int ks = 0; ks < 2; ++ks) tr_frag_issue(vl[nt][ks], vh[nt][ks], sV, LDV, 32 * ks, 16 * nt, lane);
                f32x4 aq[3], ap[3];
#pragma unroll
                for (int nt = 0; nt < 3; ++nt) { aq[nt] = (f32x4){0.f, 0.f, 0.f, 0.f};
#pragma unroll
                    for (int ks = 0; ks < 4; ++ks) aq[nt] = MFMA16(ld_frag(sQ, LDK, 16 * tt, 32 * ks, lane), ld_frag(sCr, LDK, 16 * nt, 32 * ks, lane), aq[nt]); }
                const bf16x8 pa0 = ld_frag(sP, LDT, 16 * tt, 0, lane), pa1 = ld_frag(sP, LDT, 16 * tt, 32, lane);
                asm volatile("s_waitcnt lgkmcnt(0)" ::: "memory"); __builtin_amdgcn_sched_barrier(0);
#pragma unroll
                for (int nt = 0; nt < 3; ++nt) { ap[nt] = (f32x4){0.f, 0.f, 0.f, 0.f}; ap[nt] = MFMA16(pa0, TR_PK(vl[nt][0], vh[nt][0]), ap[nt]); ap[nt] = MFMA16(pa1, TR_PK(vl[nt][1], vh[nt][1]), ap[nt]); }
#pragma unroll
                for (int i = 0; i < 4; ++i) { const int tr = 16 * tt + 4 * (lane >> 4) + i; const float wit = __shfl(wi, tr), flt = __shfl(fl, tr);
                    const float den = __shfl(wit * aq[2][i] + ap[2][i], lane & 48);
                    const float inv = 1.f / fmaxf(fabsf(den), flt); float* hp = HM + ((size_t)dir * M0 + rowb + TOK(p0 + tr)) * 1024 + h * 128 + 32 * sl + (lane & 15);
                    hp[0] = (wit * aq[0][i] + ap[0][i]) * inv; hp[16] = (wit * aq[1][i] + ap[1][i]) * inv; }
            } else {
                s16x4 vl[3][2], vh[3][2], kl[2][2], kh[2][2];
#pragma unroll
                for (int nt = 0; nt < 3; ++nt)
#pragma unroll
                    for (int ks = 0; ks < 2; ++ks) tr_frag_issue(vl[nt][ks], vh[nt][ks], sV, LDV, 32 * ks, 16 * nt, lane);
#pragma unroll
                for (int x = 0; x < 2; ++x)
#pragma unroll
                    for (int ks = 0; ks < 2; ++ks) tr_frag_issue(kl[x][ks], kh[x][ks], sKw, LDK, 32 * ks, 16 * (2 * (wave - 4) + x), lane);
                asm volatile("s_waitcnt lgkmcnt(0)" ::: "memory"); __builtin_amdgcn_sched_barrier(0);
#pragma unroll
                for (int x = 0; x < 2; ++x)
#pragma unroll
                    for (int nt = 0; nt < 3; ++nt) { cT[x][nt] = cT[x][nt] * dec;
#pragma unroll
                        for (int ks = 0; ks < 2; ++ks) cT[x][nt] = MFMA16(TR_PK(vl[nt][ks], vh[nt][ks]), TR_PK(kl[x][ks], kh[x][ks]), cT[x][nt]);
#pragma unroll
                        for (int i = 0; i < 4; ++i) sCw[(16 * nt + 4 * (lane >> 4) + i) * LDK + 16 * (2 * (wave - 4) + x) + (lane & 15)] = (bf16)f2bf(cT[x][nt][i]); }
            }
        }
#undef PREFETCH
#undef TOK
    }
}
template <int MODE> struct EpiResid { static constexpr bool PERM = false, AFTER_DRAIN = false; Ctx C;
    __device__ __forceinline__ void operator()(const pg8::f32x4 (&acc)[2][2][4][2], const pg8::Unit& u, int wr, int wc, int fr, int fq) const {
        const int row0 = u.pm * 256 + wr * 64 + fr, col0 = u.pn * 256 + wc * 32 + 4 * fq; float* X = WSP(float, WS_X);
#pragma unroll
        for (int ai = 0; ai < 2; ++ai)
#pragma unroll
            for (int m = 0; m < 4; ++m) { const int r = row0 + ai * 128 + m * 16; int xr; const float* base; const float* gate;
                if (MODE == 0) { xr = r; base = in_row(C, r); gate = mod_row(C, 0, r) + 2 * D; }
                else { const int b = r / SEQ; xr = b * TT + LCTX + (r - b * SEQ); base = X + (size_t)xr * D; gate = WSP(const float, WS_MOD) + ((size_t)3 + b) * (6 * D) + 2 * D; }
#pragma unroll
                for (int bj = 0; bj < 2; ++bj)
#pragma unroll
                    for (int n = 0; n < 2; ++n) { const int c = col0 + bj * 128 + n * 16; const f32x4 bv = *(const f32x4*)(base + c), gv = *(const f32x4*)(gate + c);
                        *(f32x4*)(X + (size_t)xr * D + c) = bv + gv * acc[ai][bj][m][n]; } }
    } };
struct EpiSwiglu { static constexpr bool PERM = false, AFTER_DRAIN = false; bf16* act;
    __device__ __forceinline__ void operator()(const pg8::f32x4 (&acc)[2][2][4][2], const pg8::Unit& u, int wr, int wc, int fr, int fq) const {
        const int row0 = u.pm * 256 + wr * 64 + fr, col0 = (u.pn & 3) * 128 + wc * 32 + 4 * fq;
#pragma unroll
        for (int ai = 0; ai < 2; ++ai)
#pragma unroll
            for (int m = 0; m < 4; ++m) { bf16* rowp = act + (size_t)(row0 + ai * 128 + m * 16) * DE + col0;
#pragma unroll
                for (int n = 0; n < 2; ++n) { const f32x4 g = acc[ai][0][m][n], up = acc[ai][1][m][n]; v2u w; w.x = pg8::cvt_pk_bf16(siluf(g[0]) * up[0], siluf(g[1]) * up[1]); w.y = pg8::cvt_pk_bf16(siluf(g[2]) * up[2], siluf(g[3]) * up[3]);
                    *(v2u*)(rowp + n * 16) = w; } }
    } };
struct EpiBf16Mod { static constexpr bool PERM = true, AFTER_DRAIN = false; bf16* O; int ldc; int ntile_mask;
    __device__ __forceinline__ void operator()(const pg8::f32x4 (&acc)[2][2][4][2], const pg8::Unit& u, int wr, int wc, int fr, int fq) const {
        const int row0 = u.pm * 256 + wr * 64 + fr, col0 = (u.pn & ntile_mask) * 256 + wc * 32 + 8 * fq;
#pragma unroll
        for (int ai = 0; ai < 2; ++ai)
#pragma unroll
            for (int m = 0; m < 4; ++m) { bf16* rowp = O + (size_t)(row0 + ai * 128 + m * 16) * ldc + col0;
#pragma unroll
                for (int bj = 0; bj < 2; ++bj) { const f32x4 z4 = (f32x4){0.f, 0.f, 0.f, 0.f}; const f32x4 v0 = acc[ai][bj][m][0] + z4, v1 = acc[ai][bj][m][1] + z4;
                    v4u w; w.x = pg8::cvt_pk_bf16(v0[0], v0[1]); w.y = pg8::cvt_pk_bf16(v0[2], v0[3]); w.z = pg8::cvt_pk_bf16(v1[0], v1[1]); w.w = pg8::cvt_pk_bf16(v1[2], v1[3]);
                    *(v4u*)(rowp + bj * 128) = w; } }
    } };
constexpr int TBL_OFF = MISC_OFF + 1024, TBL_CNT = MISC_OFF + 1536, TBL_TEXP = MISC_OFF + 2048;
struct MoeOrder { const LAS int* sOff; const LAS int* sCnt; const LAS int* sTexp; const int* tokidx; int nunits, NT, G, c;
    __device__ __forceinline__ bool next(int i, pg8::Unit& u) const { const int L = i * G + c; if (L >= nunits) return false; const int mt = L / NT; u.pm = mt; u.pn = NT * sTexp[mt] + (L - mt * NT); return true; }
    __device__ __forceinline__ unsigned a_voff(const pg8::Unit& u, int half, int R, int K) const { const int e = u.pn / NT, r = (u.pm - (sOff[e] >> 8)) * 256 + 128 * half + R; int tok = r;
        if (e < NE) { const int last = sCnt[e] - 1; tok = tokidx[e * M0 + (r < last ? r : last)]; }
        return (unsigned)tok * (unsigned)(K * 2); }
    __device__ __forceinline__ void a_ready(const pg8::Unit&) const {}
    __device__ __forceinline__ void done(const pg8::Unit&) const {} };
template <int LAYER> __device__ __forceinline__ MoeOrder moe_tables(const Ctx& C, int NT) {
    constexpr int ntok = LAYER ? M1 : M0; LAS int* sOff = (LAS int*)(C.lds + TBL_OFF); LAS int* sCnt = (LAS int*)(C.lds + TBL_CNT); LAS int* sTexp = (LAS int*)(C.lds + TBL_TEXP);
    const unsigned* cnt = WSP(const unsigned, WS_CTL) + (LAYER ? CW_CNT1 : CW_CNT0); const int tid = threadIdx.x;
    __syncthreads();
    if (tid < 64) {
        const int c = (int)__hip_atomic_load(cnt + tid, __ATOMIC_RELAXED, __HIP_MEMORY_SCOPE_AGENT); const int pad = (c + 255) & ~255; int inc = pad;
#pragma unroll
        for (int o = 1; o < 64; o <<= 1) { const int x = __shfl_up(inc, o); if (tid >= o) inc += x; }
        sCnt[tid] = c; sOff[tid] = inc - pad;
        if (tid == 63) { sOff[NE] = inc; sCnt[NE] = ntok; sOff[NE + 1] = inc + ntok; } }
    __syncthreads();
    if (tid <= NE) for (int mt = sOff[tid] >> 8; mt < (sOff[tid + 1] >> 8); ++mt) sTexp[mt] = tid;
    __syncthreads();
    const int cx = (C.G % 8 == 0) ? (C.bid % 8) * (C.G / 8) + C.bid / 8 : C.bid;
    return MoeOrder{sOff, sCnt, sTexp, WSP(const int, WS_TOK), (sOff[NE + 1] >> 8) * NT, NT, C.G, cx};
}

template <int LAYER> __device__ __forceinline__ void p_norm2_route(const Ctx& C0) { const Ctx C = phase_ctx(C0);
    constexpr int ntok = LAYER ? M1 : M0; constexpr int IL = LAYER ? I_L1 : I_L0, RW = LAYER ? O_RW : E_RW;
    LAS float* sH = (LAS float*)C.lds;
    LAS float* sPart = sH + 8 * D;
    LAS int* sHist = (LAS int*)(sPart + 8 * 8 * 64);
    LAS int* sBase = sHist + 64;
    LAS int* sSel = sBase + 64;
    constexpr int MAXIT = (ntok / 8 + 255) / 256 + 1;
    const float* X = WSP(const float, WS_X); bf16* H2 = WSP(bf16, WS_H2); unsigned* cnt = WSP(unsigned, WS_CTL) + (LAYER ? CW_CNT1 : CW_CNT0);
    int* TE = WSP(int, WS_ROUTE); int* TP = TE + M0 * TOPK; float* TW = (float*)(TP + M0 * TOPK);
    const float* rw = C.in[IL + RW]; const float* rb = C.in[IL + RW + 1]; const int lane = C.lane, wave = C.wave;
    if (C.tid < 64) sHist[C.tid] = 0;
    int slot = 0;
    for (int it = C.bid; it < ntok / 8; it += C.G, ++slot) { const int i = it * 8 + wave; int xr; if (LAYER) { const int b = i / SEQ; xr = b * TT + LCTX + (i - b * SEQ); } else xr = i;
        __syncthreads();
        { f32x4 v[8]; const float* x = X + (size_t)xr * D;
#pragma unroll
          for (int j = 0; j < 8; ++j) v[j] = *(const f32x4*)(x + 4 * lane + 256 * j);
          const float* md = mod_row(C, LAYER, xr); norm_mod_row(v, C.in[IL + N2], md + 3 * D, md + 4 * D, lane);
          store_row_bf16(H2 + (size_t)i * D, v, lane);
#pragma unroll
          for (int j = 0; j < 8; ++j) *(LAS f32x4*)(sH + wave * D + 4 * lane + 256 * j) = v[j]; }
        __syncthreads();
        { float acc[8] = {}; const int k0 = wave * 256;
          for (int k = 0; k < 256; k += 16) { float w[16];
#pragma unroll
              for (int q = 0; q < 16; ++q) w[q] = rw[(size_t)(k0 + k + q) * NE + lane];
#pragma unroll
              for (int q = 0; q < 16; q += 4)
#pragma unroll
                  for (int r = 0; r < 8; ++r) { const f32x4 hv = *(const LAS f32x4*)(sH + r * D + k0 + k + q); acc[r] += hv.x * w[q] + hv.y * w[q + 1] + hv.z * w[q + 2] + hv.w * w[q + 3]; } }
#pragma unroll
          for (int r = 0; r < 8; ++r) sPart[(wave * 8 + r) * 64 + lane] = acc[r]; }
        __syncthreads();
        { float s = 0.f;
#pragma unroll
          for (int w = 0; w < 8; ++w) s += sPart[(w * 8 + wave) * 64 + lane];
          const float score = 1.f / (1.f + expf(-s)); const float sel = score + rb[lane];
          float m1 = sel, m2 = -3e38f;
#pragma unroll
          for (int o = 1; o < 8; o <<= 1) { const float a1 = __shfl_xor(m1, o), a2 = __shfl_xor(m2, o); const float hi = fmaxf(m1, a1), lo = fminf(m1, a1); m2 = fmaxf(lo, fmaxf(m2, a2)); m1 = hi; }
          const float gs = m1 + m2;
          int grank = 0; const int g = lane >> 3;
#pragma unroll
          for (int q = 0; q < 8; ++q) { const float og = __builtin_bit_cast(float, __builtin_amdgcn_readlane(__builtin_bit_cast(int, gs), q * 8)); grank += (og > gs || (og == gs && q < g)) ? 1 : 0; }
          const float cand = grank < 4 ? sel : -3e38f;
          int erank = 0;
#pragma unroll
          for (int q = 0; q < 64; ++q) { const float oc = __builtin_bit_cast(float, __builtin_amdgcn_readlane(__builtin_bit_cast(int, cand), q)); erank += (oc > cand || (oc == cand && q < lane)) ? 1 : 0; }
          const int myj = (grank < 4 && erank < TOPK) ? erank : -1;
          float wsum = wave_sum(myj >= 0 ? score : 0.f);
          if (myj >= 0) { const float wgt = score / wsum * 2.5f;
              if (slot < MAXIT) { const int lr = atomicAdd((int*)&sHist[lane], 1); LAS int* q = sSel + ((slot * 8 + wave) * TOPK + myj) * 3; q[0] = lane; q[1] = lr; q[2] = __float_as_int(wgt); }
              else { const unsigned pos = atomicAdd(&cnt[lane], 1u); TE[(size_t)i * TOPK + myj] = lane; TP[(size_t)i * TOPK + myj] = (int)pos; WSP(int, WS_TOK)[(size_t)lane * M0 + pos] = i; TW[(size_t)i * TOPK + myj] = wgt; } } }
    }
    __syncthreads();
    if (C.tid < 64) { const int h = sHist[C.tid]; sBase[C.tid] = h ? (int)atomicAdd(&cnt[C.tid], (unsigned)h) : 0; }
    __syncthreads();
    { const int nslot = slot < MAXIT ? slot : MAXIT;
      for (int x = C.tid; x < nslot * 8 * TOPK; x += NTHR) { const int sl = x / (8 * TOPK), w8 = (x / TOPK) % 8, j = x % TOPK; const int i = (C.bid + sl * C.G) * 8 + w8;
          const LAS int* q = sSel + x * 3; const int e = q[0], pos = sBase[e] + q[1];
          TE[(size_t)i * TOPK + j] = e; TP[(size_t)i * TOPK + j] = pos; WSP(int, WS_TOK)[(size_t)e * M0 + pos] = i; TW[(size_t)i * TOPK + j] = __int_as_float(q[2]); } }
}
template <int LAYER> __device__ __forceinline__ void p_moe_combine(const Ctx& C0) { const Ctx C = phase_ctx(C0);
    constexpr int ntok = LAYER ? M1 : M0;
    const MoeOrder T = moe_tables<LAYER>(C, 1);
    const int* TE = WSP(const int, WS_ROUTE); const int* TP = TE + M0 * TOPK; const float* TW = (const float*)(WSP(const int, WS_ROUTE) + 2 * M0 * TOPK);
    const bf16* Y = WSP(const bf16, WS_Y); const bf16* YS = Y + (size_t)T.sOff[NE] * D; float* X = WSP(float, WS_X);
    const int gw = C.bid * NWAVES + C.wave, NGW = C.G * NWAVES, lane = C.lane;
    for (int i = gw; i < ntok; i += NGW) { int xr; if (LAYER) { const int b = i / SEQ; xr = b * TT + LCTX + (i - b * SEQ); } else xr = i;
        f32x4 acc[8];
#pragma unroll
        for (int j = 0; j < 8; ++j) { const v2u a = *(const v2u*)(YS + (size_t)i * D + 4 * lane + 256 * j); acc[j] = (f32x4){bf2f(a.x & 0xffffu), bf2f(a.x >> 16), bf2f(a.y & 0xffffu), bf2f(a.y >> 16)}; }
#pragma unroll 2
        for (int s = 0; s < TOPK; ++s) { const float w = TW[(size_t)i * TOPK + s]; const bf16* yr = Y + (size_t)(T.sOff[TE[(size_t)i * TOPK + s]] + TP[(size_t)i * TOPK + s]) * D;
#pragma unroll
            for (int j = 0; j < 8; ++j) { const v2u a = *(const v2u*)(yr + 4 * lane + 256 * j); acc[j] += (f32x4){bf2f(a.x & 0xffffu), bf2f(a.x >> 16), bf2f(a.y & 0xffffu), bf2f(a.y >> 16)} * w; } }
        const float* gate = mod_row(C, LAYER, xr) + 5 * D; f32x4 v[8];
#pragma unroll
        for (int j = 0; j < 8; ++j) { const int c = 4 * lane + 256 * j; v[j] = *(const f32x4*)(X + (size_t)xr * D + c) + *(const f32x4*)(gate + c) * acc[j]; }
        if (LAYER) {
#pragma unroll
            for (int j = 0; j < 8; ++j) *(f32x4*)(C.out + (size_t)i * D + 4 * lane + 256 * j) = v[j]; }
        else {
#pragma unroll
            for (int j = 0; j < 8; ++j) *(f32x4*)(X + (size_t)xr * D + 4 * lane + 256 * j) = v[j];
            const float* md = mod_row(C, 1, xr); norm_mod_row(v, C.in[I_L1 + N1], md + 0 * D, md + 1 * D, lane); store_row_bf16(WSP(bf16, WS_HB) + (size_t)xr * D, v, lane); } }
}

__device__ __forceinline__ int slack_slots(int nunits, int G, int c) { const int maxr = (nunits + G - 1) / G, mine = nunits > c ? (nunits - c - 1) / G + 1 : 0; return maxr - mine; }
constexpr int NPHASE = 21;
struct Args { const float* in[43]; float* out; unsigned char* ws; int ph_lo, ph_hi, li, pad; };
__global__ void __launch_bounds__(NTHR, 2) fwd_kernel(Args args) {
    extern __shared__ __attribute__((aligned(16))) unsigned char lds_raw[];
    Ctx C; C.lds = (LAS unsigned char*)lds_raw; C.in = args.in; C.out = args.out; C.ws = args.ws;
    C.tid = threadIdx.x; C.lane = C.tid & 63; C.wave = __builtin_amdgcn_readfirstlane(C.tid >> 6); C.G = gridDim.x; C.bid = blockIdx.x;
    volatile LAS unsigned* MISC = (volatile LAS unsigned*)(C.lds + MISC_OFF);
    if (C.tid < 64) MISC[C.tid] = 0u;
    __syncthreads();
    const int lo = args.ph_lo, hi = args.ph_hi; const bool one = (hi - lo) > 1;
    XcdBarrier bar; bar.bar = WSP(unsigned, WS_CTL) + CW_BAR + args.li * XCD_BAR_WORDS; bar.x = 0; bar.st = nullptr;
    if (one) bar = xcd_barrier_post(WSP(unsigned, WS_CTL) + CW_BAR + args.li * XCD_BAR_WORDS, MISC + 8);
#ifndef PHASE_MASK
#define PHASE_MASK 0x1fffff
#endif
#define IN(k) (((PHASE_MASK >> (k)) & 1) && lo <= (k) && (k) < hi)
#define SEAM(k) do { if (IN(k) && IN((k) + 1)) xcd_barrier(bar); } while (0)
    LAS unsigned char* ring = C.lds;
#ifndef PROBE_REP0
#define PROBE_REP0 1
#endif
    if (IN(0)) { for (int rep = 0; rep < PROBE_REP0; ++rep) { p0_prologue(C); __syncthreads(); } } SEAM(0);
    if (IN(1)) { p_norm1_l0(C); } SEAM(1);
    if (IN(2)) { pg8::Gemm g{WSP(const bf16, WS_HB), WSP(const bf16, WS_WIN0), M0, NIN0P, D}; pg8::StaticOrder S; S.init(M0, NIN0P, C.G, C.bid);
        pg8::EpiBf16<0> E{WSP(bf16, WS_PROJ), NIN0P, nullptr, 0, 0}; pg8::gemm_phase<pg8::EpiBf16<0>, pg8::StaticOrder>(ring, g, S, E, nullptr);
        convert_chunks(C, 2 * slack_slots((M0 / 256) * (NIN0P / 256), C.G, C.bid)); } SEAM(2);
    if (IN(3)) { p_prep_l0(C); } SEAM(3);
    #ifndef PROBE_REP4
#define PROBE_REP4 1
#endif
    if (IN(4)) { for (int rep = 0; rep < PROBE_REP4; ++rep) { p_mlstm_l0(C); p_na_l0(C, rep); __syncthreads(); } } SEAM(4);
    if (IN(5)) { p_mlfin_l0(C); } SEAM(5);
    if (IN(6)) { pg8::Gemm g{WSP(const bf16, WS_AO), WSP(const bf16, WS_WOUT0), M0, D, D}; pg8::StaticOrder S; S.init(M0, D, C.G, C.bid);
        EpiResid<0> E{C}; pg8::gemm_phase<EpiResid<0>, pg8::StaticOrder>(ring, g, S, E, nullptr);
        convert_chunks(C, 2 * slack_slots((M0 / 256) * (D / 256), C.G, C.bid)); } SEAM(6);
    if (IN(7)) { p_norm2_route<0>(C); } SEAM(7);
    if (IN(9)) { const MoeOrder S = moe_tables<0>(C, 4); pg8::Gemm g{WSP(const bf16, WS_H2), WSP(const bf16, WS_W1T), M0, 65 * 1024, D}; EpiSwiglu E{WSP(bf16, WS_ACT)};
        pg8::gemm_phase_g<EpiSwiglu, MoeOrder>(ring, g, S, E, nullptr); convert_chunks(C, 2 * slack_slots(S.nunits, C.G, S.c)); } SEAM(9);
    if (IN(10)) { const MoeOrder S = moe_tables<0>(C, 8); pg8::Gemm g{WSP(const bf16, WS_ACT), WSP(const bf16, WS_W2T), RMAX + M0, 65 * 2048, DE}; EpiBf16Mod E{WSP(bf16, WS_Y), D, 7};
        pg8::gemm_phase<EpiBf16Mod, MoeOrder>(ring, g, S, E, nullptr); convert_chunks(C, slack_slots(S.nunits, C.G, S.c)); } SEAM(10);
    if (IN(11)) { p_moe_combine<0>(C); } SEAM(11);
    if (IN(12)) { pg8::Gemm g{WSP(const bf16, WS_HB), WSP(const bf16, WS_WIN1), M0, NIN1, D}; pg8::StaticOrder S; S.init(M0, NIN1, C.G, C.bid);
        pg8::EpiBf16<0> E{WSP(bf16, WS_PROJ), NIN1, nullptr, 0, 0}; pg8::gemm_phase<pg8::EpiBf16<0>, pg8::StaticOrder>(ring, g, S, E, nullptr);
        convert_chunks(C, 2 * slack_slots((M0 / 256) * (NIN1 / 256), C.G, C.bid)); } SEAM(12);
    if (IN(13)) { p_prep_l1(C); } SEAM(13);
    if (IN(14)) { p_da_l1(C); } SEAM(14);
    if (IN(15)) { pg8::Gemm g{WSP(const bf16, WS_AO), WSP(const bf16, WS_WOUT1), M1, D, D}; pg8::StaticOrder S; S.init(M1, D, C.G, C.bid);
        EpiResid<1> E{C}; pg8::gemm_phase<EpiResid<1>, pg8::StaticOrder>(ring, g, S, E, nullptr); } SEAM(15);
    if (IN(16)) { p_norm2_route<1>(C); convert_chunks(C, 1 << 30); } SEAM(16);
    if (IN(18)) { const MoeOrder S = moe_tables<1>(C, 4); pg8::Gemm g{WSP(const bf16, WS_H2), WSP(const bf16, WS_W1T) + (size_t)65 * 1024 * D, M1, 65 * 1024, D}; EpiSwiglu E{WSP(bf16, WS_ACT)};
        pg8::gemm_phase_g<EpiSwiglu, MoeOrder>(ring, g, S, E, nullptr); } SEAM(18);
    if (IN(19)) { const MoeOrder S = moe_tables<1>(C, 8); pg8::Gemm g{WSP(const bf16, WS_ACT), WSP(const bf16, WS_W2T) + (size_t)65 * D * DE, RMAX + M1, 65 * 2048, DE}; EpiBf16Mod E{WSP(bf16, WS_Y), D, 7};
        pg8::gemm_phase<EpiBf16Mod, MoeOrder>(ring, g, S, E, nullptr); } SEAM(19);
    if (IN(20)) { p_moe_combine<1>(C); }
#undef IN
#undef SEAM
}
#ifndef MK_ONE_LAUNCH
#define MK_ONE_LAUNCH 1
#endif
extern "C" void kernel_launch(void* const* d_in, const int* in_sizes, int n_in, void* d_out, int out_size, void* d_ws, size_t ws_size, hipStream_t stream) {
    static int grid = 0;
    if (grid == 0) {
        if (n_in != 43 || out_size != M1 * D || ws_size < WS_END) { fprintf(stderr, "kernel_launch: unexpected problem shape (n_in %d out %d ws %zu)\n", n_in, out_size, ws_size); grid = -1; return; }
        int dev = 0, cus = 0, per_cu = 0;
        if (hipGetDevice(&dev) != hipSuccess || hipDeviceGetAttribute(&cus, hipDeviceAttributeMultiprocessorCount, dev) != hipSuccess) { grid = -1; return; }
        if (hipFuncSetAttribute((const void*)fwd_kernel, hipFuncAttributeMaxDynamicSharedMemorySize, LDS_BYTES) != hipSuccess) { fprintf(stderr, "kernel_launch: hipFuncSetAttribute failed\n"); grid = -1; return; }
        if (hipOccupancyMaxActiveBlocksPerMultiprocessor(&per_cu, (const void*)fwd_kernel, NTHR, LDS_BYTES) != hipSuccess || per_cu < 1) { fprintf(stderr, "kernel_launch: occupancy query says %d workgroups per CU\n", per_cu); grid = -1; (void)hipGetLastError(); return; }
        grid = cus;
    }
    if (grid < 0) return;
    if (hipMemsetAsync((char*)d_ws + WS_CTL, 0, CTL_BYTES, stream) != hipSuccess) return;
    Args a{}; for (int i = 0; i < 43; ++i) a.in[i] = (const float*)d_in[i]; a.out = (float*)d_out; a.ws = (unsigned char*)d_ws;
#if defined(PROBE_LO)
    a.ph_lo = 0; a.ph_hi = PROBE_HI; a.li = 0; hipLaunchKernelGGL(fwd_kernel, dim3(grid), dim3(NTHR), LDS_BYTES, stream, a);
    a.ph_lo = PROBE_LO; a.ph_hi = NPHASE; a.li = 1; hipLaunchKernelGGL(fwd_kernel, dim3(grid), dim3(NTHR), LDS_BYTES, stream, a);
#elif MK_ONE_LAUNCH
    a.ph_lo = 0; a.ph_hi = NPHASE; hipLaunchKernelGGL(fwd_kernel, dim3(grid), dim3(NTHR), LDS_BYTES, stream, a);
#else
    for (int p = 0; p < NPHASE; ++p) { a.ph_lo = p; a.ph_hi = p + 1; hipLaunchKernelGGL(fwd_kernel, dim3(grid), dim3(NTHR), LDS_BYTES, stream, a); }
#endif
}
```

```cpp
#include <hip/hip_runtime.h>
#include <cstdio>
#include <cstdint>
namespace pg8 {
#define PG8_LAS __attribute__((address_space(3)))
typedef unsigned short bf16_t;
typedef short bf16x8 __attribute__((ext_vector_type(8)));
typedef float f32x4 __attribute__((ext_vector_type(4)));
typedef unsigned u32x4 __attribute__((ext_vector_type(4)));
constexpr int BM = 256, BK = 64, HALF = 128, HTB = HALF * BK * 2  , STAGE_BYTES = 8 * HTB, NXCD = 8, WGM = 8;

__host__ __device__ __forceinline__ int lds_byte(int r, int c) { const int st = (r >> 4) * 2 + (c >> 5), rr = r & 15, cc = c & 31, ob = rr * 64 + cc * 2; return st * 1024 + (ob ^ (((ob >> 9) & 1) << 5)); }
__host__ __device__ __forceinline__ void stage_rc(int b, int& R, int& C) { const int st = b / 1024, sb = b % 1024, swz = sb ^ (((sb >> 9) & 1) << 5); R = (st >> 1) * 16 + swz / 64; C = (st & 1) * 32 + (swz % 64) / 2; }
__host__ __device__ __forceinline__ int perm32(int rho) { const int n = rho >> 4, i = rho & 15; return 8 * (i >> 2) + 4 * n + (i & 3); }

struct Unit { int pm, pn; };
struct Gemm { const bf16_t* A; const bf16_t* Bt; int M, N, K; };

struct StaticOrder {
    int nM, nN, nwg, G, c;
    __host__ __device__ void init(int M, int N, int G_, int c_) { nM = M / BM; nN = N / BM; nwg = nM * nN; G = G_; c = c_; }
    __host__ __device__ bool next(int i, Unit& u) const {
        const long L = (long)i * G + c; if (L >= nwg) return false;
        int wgid = (int)L; { const int q = nwg / NXCD, r = nwg % NXCD, xcd = wgid % NXCD, off = wgid / NXCD; wgid = (xcd < r ? xcd * (q + 1) : r * (q + 1) + (xcd - r) * q) + off; }
        const int nig = WGM * nN, gid = wgid / nig, fm = gid * WGM, gsz = (nM - fm) < WGM ? (nM - fm) : WGM;
        u.pm = fm + ((wgid % nig) % gsz); u.pn = (wgid % nig) / gsz; return true;
    }
    __device__ __forceinline__ void a_ready(const Unit&) const {}
    __device__ __forceinline__ void done(const Unit&) const {}
};
struct CountedOrder : StaticOrder {
    const unsigned* ready; unsigned need; unsigned* tmo;
    __device__ __forceinline__ void a_ready(const Unit& u) const {
        if (threadIdx.x < 64) {
            const unsigned long long t0 = __builtin_amdgcn_s_memrealtime(); unsigned polls = 0;
            while ((unsigned)__builtin_amdgcn_readfirstlane(__hip_atomic_load(ready + 64 * u.pm, __ATOMIC_RELAXED, __HIP_MEMORY_SCOPE_AGENT)) < need) {
                if ((++polls & 255u) == 0u && __builtin_amdgcn_readfirstlane(__hip_atomic_load(tmo, __ATOMIC_RELAXED, __HIP_MEMORY_SCOPE_AGENT)) != 0u) break;
                if (__builtin_amdgcn_s_memrealtime() - t0 > 2000000ull) {
                    if (threadIdx.x == 0) { unsigned expect = 0u; __hip_atomic_compare_exchange_strong(tmo + 1, &expect, 0x600u | (unsigned)(u.pm & 0xff), __ATOMIC_RELAXED, __ATOMIC_RELAXED, __HIP_MEMORY_SCOPE_AGENT); __hip_atomic_store(tmo, 1u, __ATOMIC_RELAXED, __HIP_MEMORY_SCOPE_AGENT); }
                    break; }
                __builtin_amdgcn_s_sleep(2); }
            __builtin_amdgcn_fence(__ATOMIC_ACQUIRE, "agent");
            asm volatile("s_waitcnt vmcnt(0)" ::: "memory");
        }
#if !defined(BROKEN_HOOK_NO_BARRIER)
        asm volatile("" ::: "memory"); __builtin_amdgcn_s_barrier(); asm volatile("" ::: "memory");
#endif
    }
};

__device__ __forceinline__ unsigned cvt_pk_bf16(float lo, float hi) { unsigned r; asm volatile("v_cvt_pk_bf16_f32 %0, %1, %2" : "=v"(r) : "v"(lo), "v"(hi)); return r; }
typedef float f32x2 __attribute__((ext_vector_type(2)));
__device__ __forceinline__ f32x2 gelu_pk(f32x2 v) {
    const f32x2 av = __builtin_elementwise_abs(v), d = av * 0.2316418882f + 1.0f;
    f32x2 t; t.x = __builtin_amdgcn_rcpf(d.x); t.y = __builtin_amdgcn_rcpf(d.y);
    f32x2 q = t * 0.5307027145f + (-0.7265760135f); q = q * t + 0.7107068705f; q = q * t + (-0.142248368f); q = q * t + 0.127414796f; q = q * t;
    const f32x2 s = (v * v) * (-0.72134752044f);
    f32x2 e; e.x = __builtin_amdgcn_exp2f(s.x); e.y = __builtin_amdgcn_exp2f(s.y);
    const f32x2 m = v * (q * e), r = v - m;
    f32x2 o; o.x = v.x < 0.f ? m.x : r.x; o.y = v.y < 0.f ? m.y : r.y; return o;
}

struct EpiF32 {
    static constexpr bool PERM = false, AFTER_DRAIN = false;
    float* C; int ldc; const float* bias;
    __device__ __forceinline__ void operator()(const f32x4 (&acc)[2][2][4][2], const Unit& u, int wr, int wc, int fr, int fq) const {
        const int row0 = u.pm * BM + wr * 64 + fr, col0 = u.pn * BM + wc * 32 + 4 * fq;
        f32x4 bv[2][2];
#pragma unroll
        for (int bj = 0; bj < 2; ++bj)
#pragma unroll
            for (int n = 0; n < 2; ++n) bv[bj][n] = bias ? *(const f32x4*)(bias + col0 + bj * HALF + n * 16) : (f32x4){0.f, 0.f, 0.f, 0.f};
#pragma unroll
        for (int ai = 0; ai < 2; ++ai)
#pragma unroll
            for (int m = 0; m < 4; ++m) { float* rowp = C + (size_t)(row0 + ai * HALF + m * 16) * ldc + col0;
#pragma unroll
                for (int bj = 0; bj < 2; ++bj)
#pragma unroll
                    for (int n = 0; n < 2; ++n) *(f32x4*)(rowp + bj * HALF + n * 16) = acc[ai][bj][m][n] + bv[bj][n]; }
    }
};
template <int ACT  > struct EpiBf16 {
    static constexpr bool PERM = true, AFTER_DRAIN = false;
    bf16_t* O; int ldc; const float* bias; int split_cols; size_t split_stride;
    __device__ __forceinline__ void operator()(const f32x4 (&acc)[2][2][4][2], const Unit& u, int wr, int wc, int fr, int fq) const {
        const int row0 = u.pm * BM + wr * 64 + fr; int colt = u.pn * BM; bf16_t* base = O;
        if (split_cols) { const int t = colt / split_cols; base += (size_t)t * split_stride; colt -= t * split_cols; }
        const int col0 = colt + wc * 32 + 8 * fq, bcol0 = u.pn * BM + wc * 32 + 8 * fq;
        f32x4 bv[2][2];
#pragma unroll
        for (int bj = 0; bj < 2; ++bj)
#pragma unroll
            for (int n = 0; n < 2; ++n) bv[bj][n] = bias ? *(const f32x4*)(bias + bcol0 + bj * HALF + 4 * n) : (f32x4){0.f, 0.f, 0.f, 0.f};
#pragma unroll
        for (int ai = 0; ai < 2; ++ai)
#pragma unroll
            for (int m = 0; m < 4; ++m) { bf16_t* rowp = base + (size_t)(row0 + ai * HALF + m * 16) * ldc + col0;
#pragma unroll
                for (int bj = 0; bj < 2; ++bj) { f32x4 v0 = acc[ai][bj][m][0] + bv[bj][0], v1 = acc[ai][bj][m][1] + bv[bj][1];
                    if (ACT == 1) { f32x2 a = gelu_pk((f32x2){v0[0], v0[1]}), b = gelu_pk((f32x2){v0[2], v0[3]}), c = gelu_pk((f32x2){v1[0], v1[1]}), d = gelu_pk((f32x2){v1[2], v1[3]});
                        v0 = (f32x4){a.x, a.y, b.x, b.y}; v1 = (f32x4){c.x, c.y, d.x, d.y}; }
                    if (ACT == 2) {
#pragma unroll
                        for (int j = 0; j < 4; ++j) { v0[j] = 0.5f * v0[j] * (1.0f + erff(v0[j] * 0.70710678f)); v1[j] = 0.5f * v1[j] * (1.0f + erff(v1[j] * 0.70710678f)); } }
                    u32x4 w; w.x = cvt_pk_bf16(v0[0], v0[1]); w.y = cvt_pk_bf16(v0[2], v0[3]); w.z = cvt_pk_bf16(v1[0], v1[1]); w.w = cvt_pk_bf16(v1[2], v1[3]);
                    *(u32x4*)(rowp + bj * HALF) = w; } }
    }
};
template <class Epi, class Sched, bool STAMP = false>
__device__ __forceinline__ void gemm_phase(PG8_LAS unsigned char* lds, const Gemm g, const Sched& S, const Epi& E, unsigned long long* stamps) {
    const int tid = threadIdx.x, wid = __builtin_amdgcn_readfirstlane(tid >> 6), lane = tid & 63, wr = wid >> 2, wc = wid & 3, fr = lane & 15, fq = lane >> 4;
    const int K = g.K, nt = K / BK;
    int ts_lo = 0, ts_hi = 0, nts = 0; const unsigned long long rt_entry = STAMP ? (unsigned long long)wall_clock64() : 0ull;
#define PG8_STAMP() do { if (STAMP && wid == 0 && nts < 64) { const unsigned long long _c = (unsigned long long)clock64(); \
        ts_lo = (lane == nts) ? (int)(unsigned)_c : ts_lo; ts_hi = (lane == nts) ? (int)(unsigned)(_c >> 32) : ts_hi; ++nts; } } while (0)
    PG8_STAMP();
    unsigned voffA[2], voffB[2];
#pragma unroll
    for (int i = 0; i < 2; ++i) { int R, C; stage_rc(tid * 16 + i * 8192, R, C); const int Rb = Epi::PERM ? ((R & ~31) + perm32(R & 31)) : R;
        voffA[i] = (unsigned)(R * K + C) * 2u; voffB[i] = (unsigned)(Rb * K + C) * 2u; }
    const size_t kstep = (size_t)(BK * 2);
    const size_t hstep = (size_t)HALF * K * 2;
    const size_t tstep = 2 * hstep;
    const unsigned ldsw = (unsigned)wid * 1024u;
    const int aoff = lds_byte(wr * 64 + fr, fq * 8), boff = lds_byte(wc * 32 + fr, fq * 8);
#define PG8_SA(b, h) (((b) * 2 + (h)) * HTB)
#define PG8_SB(b, h) ((4 + (b) * 2 + (h)) * HTB)
#define PG8_STAGE(bufoff, gbase, voff) do { _Pragma("unroll") for (int _i = 0; _i < 2; ++_i) \
        __builtin_amdgcn_global_load_lds((const unsigned*)((const char*)(gbase) + (voff)[_i]), (PG8_LAS unsigned*)(lds + (bufoff) + ldsw + _i * 8192), 16, 0, 0); } while (0)
#define PG8_LDA(dst, b, h) do { _Pragma("unroll") for (int m = 0; m < 4; ++m) _Pragma("unroll") for (int k = 0; k < 2; ++k) dst[m][k] = *(const PG8_LAS bf16x8*)(lds + PG8_SA(b, h) + aoff + m * 2048 + k * 1024); } while (0)
#define PG8_LDB(dst, b, h) do { _Pragma("unroll") for (int n = 0; n < 2; ++n) _Pragma("unroll") for (int k = 0; k < 2; ++k) dst[n][k] = *(const PG8_LAS bf16x8*)(lds + PG8_SB(b, h) + boff + n * 2048 + k * 1024); } while (0)
#define PG8_MMA(ai, bj, At, Bt) do { __builtin_amdgcn_s_setprio(1); _Pragma("unroll") for (int m = 0; m < 4; ++m) _Pragma("unroll") for (int n = 0; n < 2; ++n) _Pragma("unroll") for (int k = 0; k < 2; ++k) \
        acc[ai][bj][m][n] = __builtin_amdgcn_mfma_f32_16x16x32_bf16(Bt[n][k], At[m][k], acc[ai][bj][m][n], 0, 0, 0); __builtin_amdgcn_s_setprio(0); } while (0)
#define PG8_WAIT_V(n) asm volatile("s_waitcnt vmcnt(" #n ")" ::: "memory")
#define PG8_WAIT_L(n) asm volatile("s_waitcnt lgkmcnt(" #n ")" ::: "memory")
#define PG8_BAR __builtin_amdgcn_s_barrier()
#define PG8_SCHED __builtin_amdgcn_sched_barrier(0)
    Unit cur, nxt; int ui = 0;
    if (!S.next(0, cur)) return;
    f32x4 acc[2][2][4][2];
#pragma unroll
    for (int a = 0; a < 2; ++a)
#pragma unroll
        for (int b = 0; b < 2; ++b)
#pragma unroll
            for (int m = 0; m < 4; ++m)
#pragma unroll
                for (int n = 0; n < 2; ++n) acc[a][b][m][n] = (f32x4){0.f, 0.f, 0.f, 0.f};
    bf16x8 At[4][2], B0[2][2], B1[2][2];
    const char* cA = (const char*)g.A + (size_t)cur.pm * tstep; const char* cB = (const char*)g.Bt + (size_t)cur.pn * tstep;
    S.a_ready(cur);
    PG8_STAGE(PG8_SB(0, 0), cB, voffB); PG8_STAGE(PG8_SA(0, 0), cA, voffA); PG8_STAGE(PG8_SB(0, 1), cB + hstep, voffB); PG8_STAGE(PG8_SA(0, 1), cA + hstep, voffA);
    if (wr == 1) PG8_BAR;
    PG8_WAIT_V(4); PG8_BAR;
    PG8_STAGE(PG8_SB(1, 0), cB + kstep, voffB); PG8_STAGE(PG8_SA(1, 0), cA + kstep, voffA); PG8_STAGE(PG8_SB(1, 1), cB + hstep + kstep, voffB);
    PG8_WAIT_V(6); PG8_BAR;
    PG8_STAMP();
    for (;;) {
        const bool has_next = S.next(ui + 1, nxt);
        const char* nA = has_next ? (const char*)g.A + (size_t)nxt.pm * tstep : cA; const char* nB = has_next ? (const char*)g.Bt + (size_t)nxt.pn * tstep : cB;
        for (int t = 0; t < nt; t += 2) {
            const bool last = (t == nt - 2);
            const char* a1 = cA + (size_t)(t + 1) * kstep;
            const char* a2 = last ? nA : cA + (size_t)(t + 2) * kstep; const char* b2 = last ? nB : cB + (size_t)(t + 2) * kstep;
            const char* a3 = a2 + kstep; const char* b3 = b2 + kstep;
            if (last && has_next) S.a_ready(nxt);
            PG8_LDB(B0, 0, 0); PG8_SCHED; PG8_LDA(At, 0, 0); PG8_STAGE(PG8_SA(1, 1), a1 + hstep, voffA);
            PG8_WAIT_L(8); PG8_BAR; PG8_WAIT_L(0); PG8_MMA(0, 0, At, B0); PG8_BAR; PG8_SCHED;
            PG8_LDB(B1, 0, 1); PG8_STAGE(PG8_SB(0, 0), b2, voffB);
            PG8_BAR; PG8_WAIT_L(0); PG8_MMA(0, 1, At, B1); PG8_BAR;
            PG8_LDA(At, 0, 1); PG8_STAGE(PG8_SA(0, 0), a2, voffA);
            PG8_BAR; PG8_WAIT_L(0); PG8_MMA(1, 0, At, B0); PG8_BAR; PG8_SCHED;
            PG8_STAGE(PG8_SB(0, 1), b2 + hstep, voffB);
            PG8_WAIT_V(6); PG8_BAR; PG8_MMA(1, 1, At, B1); PG8_BAR;
            PG8_LDB(B0, 1, 0); PG8_SCHED; PG8_LDA(At, 1, 0); PG8_STAGE(PG8_SA(0, 1), a2 + hstep, voffA);
            PG8_WAIT_L(8); PG8_BAR; PG8_WAIT_L(0); PG8_MMA(0, 0, At, B0); PG8_BAR; PG8_SCHED;
            PG8_LDB(B1, 1, 1); PG8_STAGE(PG8_SB(1, 0), b3, voffB);
            PG8_BAR; PG8_WAIT_L(0); PG8_MMA(0, 1, At, B1); PG8_BAR;
            PG8_LDA(At, 1, 1); PG8_STAGE(PG8_SA(1, 0), a3, voffA);
            PG8_BAR; PG8_WAIT_L(0); PG8_MMA(1, 0, At, B0); PG8_BAR; PG8_SCHED;
            PG8_STAGE(PG8_SB(1, 1), b3 + hstep, voffB);
            PG8_WAIT_V(6); PG8_BAR; PG8_MMA(1, 1, At, B1); PG8_BAR;
        }
        PG8_STAMP();
        if constexpr (!Epi::AFTER_DRAIN) { E(acc, cur, wr, wc, fr, fq); S.done(cur); }
        PG8_STAMP();
        if (!has_next) break;
#pragma unroll
        for (int a = 0; a < 2; ++a)
#pragma unroll
            for (int b = 0; b < 2; ++b)
#pragma unroll
                for (int m = 0; m < 4; ++m)
#pragma unroll
                    for (int n = 0; n < 2; ++n) acc[a][b][m][n] = (f32x4){0.f, 0.f, 0.f, 0.f};
        cur = nxt; cA = nA; cB = nB; ++ui;
    }
    PG8_WAIT_V(0);
    if (wr == 0) PG8_BAR;
    PG8_BAR;
    if constexpr (Epi::AFTER_DRAIN) { E.fused(acc, cur, wr, wc, fr, fq, lds, wid, lane); S.done(cur); }
    PG8_STAMP();
    if (STAMP && wid == 0) { stamps[lane] = lane < nts ? (((unsigned long long)(unsigned)ts_hi << 32) | (unsigned)ts_lo) : 0ull;
        if (lane == 62) stamps[62] = rt_entry; if (lane == 63) stamps[63] = (unsigned long long)wall_clock64(); }
#undef PG8_STAMP
#undef PG8_SA
#undef PG8_SB
#undef PG8_STAGE
#undef PG8_LDA
#undef PG8_LDB
#undef PG8_MMA
#undef PG8_WAIT_V
#undef PG8_WAIT_L
#undef PG8_BAR
#undef PG8_SCHED
}
template <class Epi, class Sched, bool STAMP = false>
__device__ __forceinline__ void gemm_phase_g(PG8_LAS unsigned char* lds, const Gemm g, const Sched& S, const Epi& E, unsigned long long* stamps) {
    const int tid = threadIdx.x, wid = __builtin_amdgcn_readfirstlane(tid >> 6), lane = tid & 63, wr = wid >> 2, wc = wid & 3, fr = lane & 15, fq = lane >> 4;
    const int K = g.K, nt = K / BK;
    int ts_lo = 0, ts_hi = 0, nts = 0; const unsigned long long rt_entry = STAMP ? (unsigned long long)wall_clock64() : 0ull;
#define PG8_STAMP() do { if (STAMP && wid == 0 && nts < 64) { const unsigned long long _c = (unsigned long long)clock64(); \
        ts_lo = (lane == nts) ? (int)(unsigned)_c : ts_lo; ts_hi = (lane == nts) ? (int)(unsigned)(_c >> 32) : ts_hi; ++nts; } } while (0)
    PG8_STAMP();
    unsigned voffB[2]; int RpA[2], CbA[2];
#pragma unroll
    for (int i = 0; i < 2; ++i) { int R, C; stage_rc(tid * 16 + i * 8192, R, C); const int Rb = Epi::PERM ? ((R & ~31) + perm32(R & 31)) : R;
        RpA[i] = R; CbA[i] = C * 2; voffB[i] = (unsigned)(Rb * K + C) * 2u; }
    const size_t kstep = (size_t)(BK * 2);
    const size_t hstep = (size_t)HALF * K * 2;
    const size_t tstep = 2 * hstep;
    const unsigned ldsw = (unsigned)wid * 1024u;
    const int aoff = lds_byte(wr * 64 + fr, fq * 8), boff = lds_byte(wc * 32 + fr, fq * 8);
#define PG8_SA(b, h) (((b) * 2 + (h)) * HTB)
#define PG8_SB(b, h) ((4 + (b) * 2 + (h)) * HTB)
#define PG8_STAGE(bufoff, gbase, voff) do { _Pragma("unroll") for (int _i = 0; _i < 2; ++_i) \
        __builtin_amdgcn_global_load_lds((const unsigned*)((const char*)(gbase) + (voff)[_i]), (PG8_LAS unsigned*)(lds + (bufoff) + ldsw + _i * 8192), 16, 0, 0); } while (0)
#define PG8_LDA(dst, b, h) do { _Pragma("unroll") for (int m = 0; m < 4; ++m) _Pragma("unroll") for (int k = 0; k < 2; ++k) dst[m][k] = *(const PG8_LAS bf16x8*)(lds + PG8_SA(b, h) + aoff + m * 2048 + k * 1024); } while (0)
#define PG8_LDB(dst, b, h) do { _Pragma("unroll") for (int n = 0; n < 2; ++n) _Pragma("unroll") for (int k = 0; k < 2; ++k) dst[n][k] = *(const PG8_LAS bf16x8*)(lds + PG8_SB(b, h) + boff + n * 2048 + k * 1024); } while (0)
#define PG8_MMA(ai, bj, At, Bt) do { __builtin_amdgcn_s_setprio(1); _Pragma("unroll") for (int m = 0; m < 4; ++m) _Pragma("unroll") for (int n = 0; n < 2; ++n) _Pragma("unroll") for (int k = 0; k < 2; ++k) \
        acc[ai][bj][m][n] = __builtin_amdgcn_mfma_f32_16x16x32_bf16(Bt[n][k], At[m][k], acc[ai][bj][m][n], 0, 0, 0); __builtin_amdgcn_s_setprio(0); } while (0)
#define PG8_WAIT_V(n) asm volatile("s_waitcnt vmcnt(" #n ")" ::: "memory")
#define PG8_WAIT_L(n) asm volatile("s_waitcnt lgkmcnt(" #n ")" ::: "memory")
#define PG8_BAR __builtin_amdgcn_s_barrier()
#define PG8_SCHED __builtin_amdgcn_sched_barrier(0)
    Unit cur, nxt; int ui = 0;
    if (!S.next(0, cur)) return;
    f32x4 acc[2][2][4][2];
#pragma unroll
    for (int a = 0; a < 2; ++a)
#pragma unroll
        for (int b = 0; b < 2; ++b)
#pragma unroll
            for (int m = 0; m < 4; ++m)
#pragma unroll
                for (int n = 0; n < 2; ++n) acc[a][b][m][n] = (f32x4){0.f, 0.f, 0.f, 0.f};
    bf16x8 At[4][2], B0[2][2], B1[2][2];
    const char* cA = (const char*)g.A; const char* cB = (const char*)g.Bt + (size_t)cur.pn * tstep;
    unsigned vA[2][2], vN[2][2];
#pragma unroll
    for (int h = 0; h < 2; ++h)
#pragma unroll
        for (int i = 0; i < 2; ++i) vA[h][i] = S.a_voff(cur, h, RpA[i], K) + (unsigned)CbA[i];
    S.a_ready(cur);
    PG8_STAGE(PG8_SB(0, 0), cB, voffB); PG8_STAGE(PG8_SA(0, 0), cA, vA[0]); PG8_STAGE(PG8_SB(0, 1), cB + hstep, voffB); PG8_STAGE(PG8_SA(0, 1), cA, vA[1]);
    if (wr == 1) PG8_BAR;
    PG8_WAIT_V(4); PG8_BAR;
    PG8_STAGE(PG8_SB(1, 0), cB + kstep, voffB); PG8_STAGE(PG8_SA(1, 0), cA + kstep, vA[0]); PG8_STAGE(PG8_SB(1, 1), cB + hstep + kstep, voffB);
    PG8_WAIT_V(6); PG8_BAR;
    PG8_STAMP();
    for (;;) {
        const bool has_next = S.next(ui + 1, nxt);
#pragma unroll
        for (int h = 0; h < 2; ++h)
#pragma unroll
            for (int i = 0; i < 2; ++i) vN[h][i] = has_next ? S.a_voff(nxt, h, RpA[i], K) + (unsigned)CbA[i] : vA[h][i];
        const char* nA = cA; const char* nB = has_next ? (const char*)g.Bt + (size_t)nxt.pn * tstep : cB;
        for (int t = 0; t < nt; t += 2) {
            const bool last = (t == nt - 2);
            const char* a1 = cA + (size_t)(t + 1) * kstep;
            const char* a2 = last ? nA : cA + (size_t)(t + 2) * kstep; const char* b2 = last ? nB : cB + (size_t)(t + 2) * kstep;
            const char* a3 = a2 + kstep; const char* b3 = b2 + kstep;
            if (last && has_next) S.a_ready(nxt);
            unsigned vX0[2], vX1[2];
#pragma unroll
            for (int i = 0; i < 2; ++i) { vX0[i] = last ? vN[0][i] : vA[0][i]; vX1[i] = last ? vN[1][i] : vA[1][i]; }
            PG8_LDB(B0, 0, 0); PG8_SCHED; PG8_LDA(At, 0, 0); PG8_STAGE(PG8_SA(1, 1), a1, vA[1]);
            PG8_WAIT_L(8); PG8_BAR; PG8_WAIT_L(0); PG8_MMA(0, 0, At, B0); PG8_BAR; PG8_SCHED;
            PG8_LDB(B1, 0, 1); PG8_STAGE(PG8_SB(0, 0), b2, voffB);
            PG8_BAR; PG8_WAIT_L(0); PG8_MMA(0, 1, At, B1); PG8_BAR;
            PG8_LDA(At, 0, 1); PG8_STAGE(PG8_SA(0, 0), a2, vX0);
            PG8_BAR; PG8_WAIT_L(0); PG8_MMA(1, 0, At, B0); PG8_BAR; PG8_SCHED;
            PG8_STAGE(PG8_SB(0, 1), b2 + hstep, voffB);
            PG8_WAIT_V(6); PG8_BAR; PG8_MMA(1, 1, At, B1); PG8_BAR;
            PG8_LDB(B0, 1, 0); PG8_SCHED; PG8_LDA(At, 1, 0); PG8_STAGE(PG8_SA(0, 1), a2, vX1);
            PG8_WAIT_L(8); PG8_BAR; PG8_WAIT_L(0); PG8_MMA(0, 0, At, B0); PG8_BAR; PG8_SCHED;
            PG8_LDB(B1, 1, 1); PG8_STAGE(PG8_SB(1, 0), b3, voffB);
            PG8_BAR; PG8_WAIT_L(0); PG8_MMA(0, 1, At, B1); PG8_BAR;
            PG8_LDA(At, 1, 1); PG8_STAGE(PG8_SA(1, 0), a3, vX0);
            PG8_BAR; PG8_WAIT_L(0); PG8_MMA(1, 0, At, B0); PG8_BAR; PG8_SCHED;
            PG8_STAGE(PG8_SB(1, 1), b3 + hstep, voffB);
            PG8_WAIT_V(6); PG8_BAR; PG8_MMA(1, 1, At, B1); PG8_BAR;
        }
        PG8_STAMP();
        if constexpr (!Epi::AFTER_DRAIN) { E(acc, cur, wr, wc, fr, fq); S.done(cur); }
        PG8_STAMP();
        if (!has_next) break;
#pragma unroll
        for (int a = 0; a < 2; ++a)
#pragma unroll
            for (int b = 0; b < 2; ++b)
#pragma unroll
                for (int m = 0; m < 4; ++m)
#pragma unroll
                    for (int n = 0; n < 2; ++n) acc[a][b][m][n] = (f32x4){0.f, 0.f, 0.f, 0.f};
        cur = nxt; cA = nA; cB = nB; ++ui;
#pragma unroll
        for (int h = 0; h < 2; ++h)
#pragma unroll
            for (int i = 0; i < 2; ++i) vA[h][i] = vN[h][i];
    }
    PG8_WAIT_V(0);
    if (wr == 0) PG8_BAR;
    PG8_BAR;
    if constexpr (Epi::AFTER_DRAIN) { E.fused(acc, cur, wr, wc, fr, fq, lds, wid, lane); S.done(cur); }
    PG8_STAMP();
    if (STAMP && wid == 0) { stamps[lane] = lane < nts ? (((unsigned long long)(unsigned)ts_hi << 32) | (unsigned)ts_lo) : 0ull;
        if (lane == 62) stamps[62] = rt_entry; if (lane == 63) stamps[63] = (unsigned long long)wall_clock64(); }
#undef PG8_STAMP
#undef PG8_SA
#undef PG8_SB
#undef PG8_STAGE
#undef PG8_LDA
#undef PG8_LDB
#undef PG8_MMA
#undef PG8_WAIT_V
#undef PG8_WAIT_L
#undef PG8_BAR
#undef PG8_SCHED
}
}
#define GAS __attribute__((address_space(1)))
#define LAS __attribute__((address_space(3)))
typedef unsigned short bf16;
typedef unsigned v4u __attribute__((ext_vector_type(4)));
typedef unsigned v2u __attribute__((ext_vector_type(2)));
typedef float f32x4 __attribute__((ext_vector_type(4)));
typedef short bf16x8 __attribute__((ext_vector_type(8)));
#define LDS_WAIT() asm volatile("s_waitcnt lgkmcnt(0)" ::: "memory")
constexpr int NWAVES = 8, NTHR = 512;
constexpr int D = 2048, NB = 2, SEQ = 4096, LCTX = 256, TT = SEQ + LCTX  , M0 = NB * TT  , M1 = NB * SEQ  ;
constexpr int NIN0 = 7200, NIN0P = 7424, NIN1 = 6144, NE = 64, DE = 512, TOPK = 6, GW = 64, GROWS = 64;
constexpr int C_NAQ = 0, C_NAK = 1024, C_NAV = 2048, C_MLQK = 3072, C_MLV = 5120, C_MLO = 6144, C_MLG = 7168;
constexpr int RMAX = 68608;
constexpr float EPS = 1e-6f;
constexpr size_t MiB = 1u << 20;
constexpr size_t WS_CTL = 0, CTL_BYTES = 1 * MiB;
constexpr size_t WS_MOD = 1 * MiB;
constexpr size_t WS_ROPE = WS_MOD + 512 * 1024;
constexpr size_t WS_GATE = 4 * MiB;
constexpr size_t WS_ROUTE = 6 * MiB;
constexpr size_t WS_WIN0 = 8 * MiB, WS_WOUT0 = 37 * MiB, WS_WIN1 = 45 * MiB, WS_WOUT1 = 69 * MiB;
constexpr size_t WS_W1T = 77 * MiB;
constexpr size_t WS_W2T = WS_W1T + 520 * MiB;
constexpr size_t WS_X = WS_W2T + 260 * MiB;
constexpr size_t WS_HB = WS_X + 68 * MiB;
constexpr size_t WS_H2 = WS_HB + 34 * MiB;
constexpr size_t WS_MIX = WS_H2 + 34 * MiB;
constexpr size_t WS_PROJ = WS_MIX, WS_QK = WS_PROJ + 124 * MiB, WS_HM = WS_QK + 68 * MiB, WS_AO = WS_HM + 68 * MiB, WS_SA = WS_MIX;
constexpr size_t WS_ACT = WS_MIX + 294 * MiB;
constexpr size_t WS_ACTS = WS_ACT + 67 * MiB;
constexpr size_t WS_Y = WS_ACTS + 9 * MiB;
constexpr size_t WS_YS = WS_Y + 268 * MiB;
constexpr size_t WS_GS = WS_YS + 34 * MiB;
constexpr size_t WS_TOK = WS_GS + 7 * MiB;
constexpr size_t WS_RWT = WS_TOK + 3 * MiB;
constexpr size_t WS_END = WS_RWT + 1 * MiB;
static_assert(WS_END <= 1900 * MiB, "d_ws map must stay under the guaranteed workspace (sum of inputs = 1957 MiB)");
static_assert((size_t)RMAX * D * 2 <= 294 * MiB && (size_t)M0 * NIN0P * 2 <= 124 * MiB, "overlay sizes");
constexpr int CW_CNT0 = 64, CW_CNT1 = 192, CW_NAQ = 320, CW_CVQ = 512, CW_CVQ0 = 576, CW_BAR = 4096;
constexpr int RING_BYTES = 131072, MISC_OFF = RING_BYTES, LDS_BYTES = 147456;
__device__ __forceinline__ float bf2f(unsigned v) { return __uint_as_float(v << 16); }
__device__ __forceinline__ unsigned f2bf(float f) { unsigned u = __float_as_uint(f); return (u + 0x7fffu + ((u >> 16) & 1u)) >> 16; }
__device__ __forceinline__ unsigned pk2(float lo, float hi) { return f2bf(lo) | (f2bf(hi) << 16); }
__device__ __forceinline__ float wave_sum(float v) {
#pragma unroll
    for (int o = 1; o < 64; o <<= 1) v += __shfl_xor(v, o);
    return v; }
__device__ __forceinline__ float siluf(float x) { return x / (1.f + __expf(-x)); }
__device__ __forceinline__ float sigmf(float x) { return 1.f / (1.f + __expf(-x)); }
#define XB_TMO      128
#define XB_XCNT(j)  (256  + 64 * (j))
#define XB_XSUB(j)  (1280 + 64 * (j))
#define XB_XGEN(j)  (2304 + 64 * (j))
#define XB_TOP      3328
#define XB_TOPGEN   3392
#define XCD_BAR_WORDS 3456
#define XB_SPIN_CAP (1u << 18)
#define LAS __attribute__((address_space(3)))

__device__ __forceinline__ unsigned xb_ld(unsigned* p)              { return __hip_atomic_load(p, __ATOMIC_RELAXED, __HIP_MEMORY_SCOPE_AGENT); }
__device__ __forceinline__ unsigned xb_add(unsigned* p, unsigned v) { return __hip_atomic_fetch_add(p, v, __ATOMIC_RELAXED, __HIP_MEMORY_SCOPE_AGENT); }
__device__ __forceinline__ unsigned xb_xcc_id() { return (unsigned)__builtin_amdgcn_s_getreg((3 << 11) | 20) & 0xFu; }
#define XB_SPIN(cond, bar) do { unsigned _sp = 0; while (cond) { __builtin_amdgcn_s_sleep(1); \
    if ((++_sp & 255u) == 0u) { if (xb_ld(&(bar)[XB_TMO])) break; if (_sp > XB_SPIN_CAP) { atomicAdd(&(bar)[XB_TMO], 1u); break; } } } } while (0)

struct XcdBarrier {
    unsigned* bar; unsigned x;
    volatile LAS unsigned* st;
};

__device__ __forceinline__ XcdBarrier xcd_barrier_post(unsigned* bar, volatile LAS unsigned* st) {
    XcdBarrier b; b.bar = bar; b.x = xb_xcc_id(); b.st = st;
    if (threadIdx.x == 0) (void)xb_add(&bar[XB_XCNT(b.x)], 1u);
    return b;
}
__device__ __forceinline__ void xcd_barrier_complete(unsigned* bar, unsigned x, unsigned& nloc, unsigned& nx) {
    const unsigned G = gridDim.x * gridDim.y * gridDim.z;
    unsigned sum, cnt, mine, sp = 0u;
    for (;;) {
        sum = 0u; cnt = 0u; mine = 0u;
#pragma unroll
        for (unsigned j = 0; j < 16; ++j) { const unsigned c = xb_ld(&bar[XB_XCNT(j)]); sum += c; cnt += (c > 0u) ? 1u : 0u; mine = (j == x) ? c : mine; }
        if (sum == G) break;
        __builtin_amdgcn_s_sleep(1);
        if ((++sp & 255u) == 0u) { if (xb_ld(&bar[XB_TMO])) break; if (sp > XB_SPIN_CAP) { atomicAdd(&bar[XB_TMO], 1u); break; } }
    }
    nloc = mine > 0u ? mine : 1u; nx = cnt > 0u ? cnt : 1u;
}

__device__ __forceinline__ void xcd_barrier(const XcdBarrier& b) {
    asm volatile("s_waitcnt vmcnt(0)" ::: "memory");
    __syncthreads();
    if (threadIdx.x == 0) {
        unsigned* bar = b.bar;
        __builtin_amdgcn_s_waitcnt(0);
        unsigned nloc = b.st[0], nx = b.st[1];
        if (nloc == 0u) { xcd_barrier_complete(bar, b.x, nloc, nx); b.st[0] = nloc; b.st[1] = nx; }
        const unsigned old = xb_add(&bar[XB_XSUB(b.x)], 1u);
        const unsigned gen = old / nloc;
        if (old + 1u == (gen + 1u) * nloc) {
            __builtin_amdgcn_fence(__ATOMIC_RELEASE, "agent");
            asm volatile("s_waitcnt vmcnt(0)" ::: "memory");
            const unsigned og = xb_add(&bar[XB_TOP], 1u);
            const unsigned tg = og / nx;
            if (og + 1u == (tg + 1u) * nx) xb_add(&bar[XB_TOPGEN], 1u);
            else XB_SPIN(xb_ld(&bar[XB_TOPGEN]) == tg, bar);
            __builtin_amdgcn_fence(__ATOMIC_ACQUIRE, "agent");
            xb_add(&bar[XB_XGEN(b.x)], 1u);
            asm volatile("s_waitcnt vmcnt(0)" ::: "memory");
        } else {
            XB_SPIN(xb_ld(&bar[XB_XGEN(b.x)]) == gen, bar);
            __builtin_amdgcn_fence(__ATOMIC_ACQUIRE, "agent");
            asm volatile("s_waitcnt vmcnt(0)" ::: "memory");
        }
    }
    __syncthreads();
}

struct Ctx {
    LAS unsigned char* lds; const float* const* in; float* out; unsigned char* ws;
    int tid, lane, wave, G, bid;
};
#define WSP(T, off) ((T*)(C.ws + (off)))
__device__ __forceinline__ Ctx phase_ctx(const Ctx& C0) { Ctx C = C0; int t = threadIdx.x; asm volatile("" : "+v"(t)); C.tid = t; C.lane = t & 63; C.wave = __builtin_amdgcn_readfirstlane(t >> 6);
    return C; }
enum { I_X = 0, I_C = 1, I_CTX = 2, I_CCTX = 3, I_L0 = 4, I_L1 = 25 };
enum { A_W = 0, A_B = 1, N1 = 2, N2 = 3, W_IN = 4 };
enum { E_QN = 5, E_KN = 6, E_RPB = 7, E_CW = 8, E_CB = 9, E_GB = 10, E_HN = 11, E_WOUT = 12, E_RW = 13 };
enum { O_QN = 5, O_KN = 6, O_LAM = 7, O_SUB = 8, O_WOUT = 9, O_RW = 10 };
__device__ __forceinline__ const float* in_row(const Ctx& C, int r) { const int b = r / TT, t = r - b * TT;
    return t < LCTX ? C.in[I_CTX] + ((size_t)b * LCTX + t) * D : C.in[I_X] + ((size_t)b * SEQ + (t - LCTX)) * D; }
__device__ __forceinline__ const float* mod_row(const Ctx& C, int layer, int r) { const int b = r / TT, t = r - b * TT;
    return WSP(const float, WS_MOD) + ((size_t)layer * 3 + (t < LCTX ? 2 : b)) * (6 * D); }

struct TItem { const float* W; bf16* WT; int N, K, k0, n0, drow; };
__device__ __forceinline__ void titem_load(f32x4 (&v)[8], const TItem& it, int lane) {
#pragma unroll
    for (int i = 0; i < 8; ++i) v[i] = __builtin_nontemporal_load((const f32x4*)(it.W + (size_t)(it.k0 + 8 * i + (lane >> 3)) * it.N + it.n0 + 4 * (lane & 7)));
}
__device__ __forceinline__ void titem_to_lds(const f32x4 (&v)[8], LAS float* scr, int lane) {
#pragma unroll
    for (int i = 0; i < 8; ++i) { LAS float* p = scr + (8 * i + (lane >> 3)) * 33 + 4 * (lane & 7); p[0] = v[i].x; p[1] = v[i].y; p[2] = v[i].z; p[3] = v[i].w; }
    LDS_WAIT(); asm volatile("" ::: "memory");
}
__device__ __forceinline__ void titem_store(const TItem& it, LAS float* scr, int lane) {
    const int c = lane & 7;
#pragma unroll
    for (int j = 0; j < 4; ++j) { const int n = (lane >> 3) + 8 * j; const LAS float* s = scr + (8 * c) * 33 + n;
        v4u o; o.x = pg8::cvt_pk_bf16(s[0 * 33], s[1 * 33]); o.y = pg8::cvt_pk_bf16(s[2 * 33], s[3 * 33]); o.z = pg8::cvt_pk_bf16(s[4 * 33], s[5 * 33]); o.w = pg8::cvt_pk_bf16(s[6 * 33], s[7 * 33]);
        *(v4u*)(it.WT + (size_t)(it.drow + n) * it.K + it.k0 + 8 * c) = o; }
    LDS_WAIT(); asm volatile("" ::: "memory");
}
constexpr int I_IN0 = 32 * (NIN0 / 32), I_OUT = 32 * 64, I_IN1 = 32 * (NIN1 / 32), I_GU = 32 * 16  , I_DN = 8 * 64;
constexpr int PER_L = 65 * (2 * I_GU + I_DN), NIT_EARLY = I_IN0 + I_OUT + I_IN1 + I_OUT + PER_L, NIT_ALL = NIT_EARLY + PER_L;
constexpr int CV_CHUNK = 32, CV_NCHUNK = PER_L / CV_CHUNK;
static_assert(PER_L % CV_CHUNK == 0, "chunking");
__device__ __forceinline__ TItem item_desc(const Ctx& C, int it) { TItem d; int r = it;
    if (r < I_IN0) { const int nb = NIN0 / 32; d = TItem{C.in[I_L0 + W_IN], WSP(bf16, WS_WIN0), NIN0, D, (r / nb) * 64, (r % nb) * 32, (r % nb) * 32}; return d; } r -= I_IN0;
    if (r < I_OUT) { d = TItem{C.in[I_L0 + E_WOUT], WSP(bf16, WS_WOUT0), D, D, (r / 64) * 64, (r % 64) * 32, (r % 64) * 32}; return d; } r -= I_OUT;
    if (r < I_IN1) { const int nb = NIN1 / 32; d = TItem{C.in[I_L1 + W_IN], WSP(bf16, WS_WIN1), NIN1, D, (r / nb) * 64, (r % nb) * 32, (r % nb) * 32}; return d; } r -= I_IN1;
    if (r < I_OUT) { d = TItem{C.in[I_L1 + O_WOUT], WSP(bf16, WS_WOUT1), D, D, (r / 64) * 64, (r % 64) * 32, (r % 64) * 32}; return d; } r -= I_OUT;
    const int layer = r / PER_L; r -= layer * PER_L; const int rb = (layer ? I_L1 + O_RW : I_L0 + E_RW);
    const int e = r / (2 * I_GU + I_DN); r -= e * (2 * I_GU + I_DN);
    if (r < 2 * I_GU) { const int sgu = r / I_GU, q = r % I_GU, n0 = (q % 16) * 32;
        d = TItem{e < NE ? C.in[rb + 2 + sgu] + (size_t)e * D * DE : C.in[rb + 5 + sgu], WSP(bf16, WS_W1T) + ((size_t)layer * 65 + e) * (1024 * (size_t)D), DE, D, (q / 16) * 64, n0, 256 * (n0 / 128) + 128 * sgu + (n0 % 128)}; return d; }
    r -= 2 * I_GU;
    d = TItem{e < NE ? C.in[rb + 4] + (size_t)e * DE * D : C.in[rb + 7], WSP(bf16, WS_W2T) + ((size_t)layer * 65 + e) * ((size_t)D * DE), D, DE, (r / 64) * 64, (r % 64) * 32, (r % 64) * 32}; return d; }
__device__ __forceinline__ void convert_items(const Ctx& C, int first, int last, int stride, LAS float* scr) {
    f32x4 va[8], vb[8]; int it = first; TItem cur{}; if (it < last) { cur = item_desc(C, it); titem_load(va, cur, C.lane); }
    while (it < last) { const int itn = it + stride; TItem nxt = cur; if (itn < last) { nxt = item_desc(C, itn); titem_load(vb, nxt, C.lane); }
        titem_to_lds(va, scr, C.lane); titem_store(cur, scr, C.lane); it = itn; cur = nxt;
#pragma unroll
        for (int i = 0; i < 8; ++i) va[i] = vb[i]; }
}
__device__ __forceinline__ void convert_queue(const Ctx& C0, int max_chunks, int qword, int item0, int nchunk) { const Ctx C = phase_ctx(C0);
    LAS int* sPop = (LAS int*)(C.lds + MISC_OFF + 512); LAS float* scr = (LAS float*)(C.lds + C.wave * 16384);
    if (max_chunks <= 0) return;
    unsigned* q = WSP(unsigned, WS_CTL) + qword;
    __syncthreads();
    if (C.tid == 0) sPop[0] = (int)atomicAdd(q, 1u);
    __syncthreads();
    int ch = sPop[0];
    for (int n = 0; n < max_chunks && ch < nchunk; ++n) {
        const bool more = n + 1 < max_chunks; unsigned nxt = 0u;
        if (C.tid == 0 && more) nxt = atomicAdd(q, 1u);
        const int base = item0 + ch * CV_CHUNK + C.wave * (CV_CHUNK / NWAVES); convert_items(C, base, base + CV_CHUNK / NWAVES, 1, scr);
        __syncthreads();
        if (C.tid == 0) sPop[0] = more ? (int)nxt : nchunk;
        __syncthreads();
        ch = sPop[0]; }
    __syncthreads();
}
__device__ __forceinline__ void p0_prologue(const Ctx& C0) { const Ctx C = phase_ctx(C0);
    LAS float* sv = (LAS float*)C.lds;
    LAS float* red = sv + 3 * D;
    for (int i = C.tid; i < 3 * D; i += NTHR) { const int r = i / D, k = i - r * D; const float v = r < 2 ? C.in[I_C][r * D + k] : C.in[I_CCTX][k]; sv[i] = v / (1.f + expf(-v)); }
    __syncthreads();
    for (int item = C.bid; item < 2 * 192; item += C.G) {
        const int layer = item / 192, c0 = (item % 192) * 64; const float* W = C.in[(layer ? I_L1 : I_L0) + A_W]; const float* bia = C.in[(layer ? I_L1 : I_L0) + A_B];
        const int cg = C.tid & 15, ks = C.tid >> 4; float acc[3][4] = {};
#pragma unroll 8
        for (int k = ks * 64; k < ks * 64 + 64; ++k) { const f32x4 w = __builtin_nontemporal_load((const f32x4*)(W + (size_t)k * (6 * D) + c0 + cg * 4));
#pragma unroll
            for (int r = 0; r < 3; ++r) { const float s = sv[r * D + k]; acc[r][0] += s * w.x; acc[r][1] += s * w.y; acc[r][2] += s * w.z; acc[r][3] += s * w.w; } }
#pragma unroll
        for (int r = 0; r < 3; ++r)
#pragma unroll
            for (int j = 0; j < 4; ++j) red[(ks * 3 + r) * 64 + cg * 4 + j] = acc[r][j];
        __syncthreads();
        if (C.tid < 192) { const int r = C.tid / 64, cc = C.tid % 64; float s = 0.f; for (int q = 0; q < 32; ++q) s += red[(q * 3 + r) * 64 + cc];
            WSP(float, WS_MOD)[((size_t)layer * 3 + r) * (6 * D) + c0 + cc] = s + bia[c0 + cc]; }
        __syncthreads();
    }
    for (int i = C.bid * NTHR + C.tid; i < SEQ * 64; i += C.G * NTHR) { const int t = i >> 6, f = i & 63; const float inv = powf(10000.f, -(float)(f & 31) / 32.f);
        const float ang = (float)(f < 32 ? t / GW : t % GW) * inv; WSP(float, WS_ROPE)[i] = cosf(ang); WSP(float, WS_ROPE)[SEQ * 64 + i] = sinf(ang); }
    for (int i = C.bid * NTHR + C.tid; i < 2 * NE * D; i += C.G * NTHR) { const int layer = i / (NE * D), e = (i / D) % NE, k = i % D;
        const float x = C.in[(layer ? I_L1 + O_RW : I_L0 + E_RW)][(size_t)k * NE + e]; const unsigned hi = f2bf(x); const unsigned lo = f2bf(x - bf2f(hi));
        bf16* o = WSP(bf16, WS_RWT) + ((size_t)layer * 2 * NE + e) * D + k; o[0] = (bf16)hi; o[(size_t)NE * D] = (bf16)lo; }
    LAS float* scr = (LAS float*)(C.lds + C.wave * 16384);
    const int gw = C.bid * NWAVES + C.wave, NGW = C.G * NWAVES;
    __syncthreads();
    static_assert(NIT_EARLY % CV_CHUNK == 0, "chunking");
    convert_queue(C, 1 << 30, CW_CVQ0, 0, NIT_EARLY / CV_CHUNK);
}

__device__ __forceinline__ void convert_chunks(const Ctx& C, int max_chunks) { convert_queue(C, max_chunks, CW_CVQ, NIT_EARLY, CV_NCHUNK); }

__device__ __forceinline__ void norm_mod_row(f32x4 (&v)[8], const float* gain, const float* shift, const float* scale, int lane) {
    float s = 0.f;
#pragma unroll
    for (int j = 0; j < 8; ++j) s += (v[j].x * v[j].x + v[j].y * v[j].y) + (v[j].z * v[j].z + v[j].w * v[j].w);
    const float r = 1.f / sqrtf(wave_sum(s) * (1.f / D) + EPS);
#pragma unroll
    for (int j = 0; j < 8; ++j) { const int c = 4 * lane + 256 * j; const f32x4 g = *(const f32x4*)(gain + c), sh = *(const f32x4*)(shift + c), sc = *(const f32x4*)(scale + c);
        v[j] = v[j] * r * g * (sc + 1.f) + sh; }
}
__device__ __forceinline__ void store_row_bf16(bf16* o, const f32x4 (&v)[8], int lane) {
#pragma unroll
    for (int j = 0; j < 8; ++j) { v2u w; w.x = pk2(v[j].x, v[j].y); w.y = pk2(v[j].z, v[j].w); *(v2u*)(o + 4 * lane + 256 * j) = w; }
}
__device__ __forceinline__ void p_norm1_l0(const Ctx& C0) { const Ctx C = phase_ctx(C0);
    const int gw = C.bid * NWAVES + C.wave, NGW = C.G * NWAVES;
    for (int r = gw; r < M0; r += NGW) { const float* x = in_row(C, r); f32x4 v[8];
#pragma unroll
        for (int j = 0; j < 8; ++j) v[j] = *(const f32x4*)(x + 4 * C.lane + 256 * j);
        const float* md = mod_row(C, 0, r); norm_mod_row(v, C.in[I_L0 + N1], md + 0 * D, md + 1 * D, C.lane);
        store_row_bf16(WSP(bf16, WS_HB) + (size_t)r * D, v, C.lane); }
}
__device__ __forceinline__ void p_prep_l0(const Ctx& C0) { const Ctx C = phase_ctx(C0);
    const int gw = C.bid * NWAVES + C.wave, NGW = C.G * NWAVES, lane = C.lane;
    const bf16* PB = WSP(const bf16, WS_PROJ); bf16* QN = WSP(bf16, WS_QK); bf16* KN = QN + (size_t)M0 * 1024; bf16* MQ = KN + (size_t)M0 * 1024; bf16* MK = MQ + (size_t)M0 * 1024;
    float* LI = WSP(float, WS_GATE); float* LF = LI + 2 * NB * 8 * TT;
    {
      const float* gqp = C.in[I_L0 + E_QN] + (16 * lane) % 128; const float* gkp = C.in[I_L0 + E_KN] + (16 * lane) % 128;
      const f32x4 gq0 = *(const f32x4*)(gqp), gq1 = *(const f32x4*)(gqp + 4), gq2 = *(const f32x4*)(gqp + 8), gq3 = *(const f32x4*)(gqp + 12);
      const f32x4 gk0 = *(const f32x4*)(gkp), gk1 = *(const f32x4*)(gkp + 4), gk2 = *(const f32x4*)(gkp + 8), gk3 = *(const f32x4*)(gkp + 12);
      const float gbias = C.in[I_L0 + E_GB][lane & 31];
      for (int r = gw; r < M0; r += NGW) { const int b = r / TT, t = r - b * TT; const bf16* pr = PB + (size_t)r * NIN0P;
        const v4u qa = *(const v4u*)(pr + C_NAQ + 16 * lane), qb = *(const v4u*)(pr + C_NAQ + 16 * lane + 8), ka = *(const v4u*)(pr + C_NAK + 16 * lane), kb = *(const v4u*)(pr + C_NAK + 16 * lane + 8);
        const float graw = bf2f(pr[C_MLG + (lane & 31)]);
#define HEADNORM(XA, XB, G0, G1, G2, G3, DST) do { const unsigned w_[8] = {XA.x, XA.y, XA.z, XA.w, XB.x, XB.y, XB.z, XB.w}; float f_[16]; float s_ = 0.f; \
            _Pragma("unroll") for (int i = 0; i < 8; ++i) { f_[2 * i] = bf2f(w_[i] & 0xffffu); f_[2 * i + 1] = bf2f(w_[i] >> 16); s_ += f_[2 * i] * f_[2 * i] + f_[2 * i + 1] * f_[2 * i + 1]; } \
            s_ += __shfl_xor(s_, 1); s_ += __shfl_xor(s_, 2); s_ += __shfl_xor(s_, 4); const float rr_ = 1.f / sqrtf(s_ * (1.f / 128.f) + EPS); \
            const v4u o0_ = (v4u){pk2(f_[0] * rr_ * G0.x, f_[1] * rr_ * G0.y), pk2(f_[2] * rr_ * G0.z, f_[3] * rr_ * G0.w), pk2(f_[4] * rr_ * G1.x, f_[5] * rr_ * G1.y), pk2(f_[6] * rr_ * G1.z, f_[7] * rr_ * G1.w)}; \
            const v4u o1_ = (v4u){pk2(f_[8] * rr_ * G2.x, f_[9] * rr_ * G2.y), pk2(f_[10] * rr_ * G2.z, f_[11] * rr_ * G2.w), pk2(f_[12] * rr_ * G3.x, f_[13] * rr_ * G3.y), pk2(f_[14] * rr_ * G3.z, f_[15] * rr_ * G3.w)}; \
            *(v4u*)(DST) = o0_; *(v4u*)((DST) + 8) = o1_; } while (0)
        HEADNORM(qa, qb, gq0, gq1, gq2, gq3, QN + (size_t)r * 1024 + 16 * lane);
        HEADNORM(ka, kb, gk0, gk1, gk2, gk3, KN + (size_t)r * 1024 + 16 * lane);
#undef HEADNORM
        if (lane < 32) { const float g = graw + gbias; const int dir = lane >> 4, isf = (lane >> 3) & 1, h = lane & 7;
            const size_t idx = (((size_t)dir * NB + b) * 8 + h) * TT + t;
            if (isf) LF[idx] = fminf(g, 0.f) - log1pf(expf(-fabsf(g))); else LI[idx] = g; } } }
    { const int sc = gw & 3, nblk = NGW >> 2, RB = (M0 + nblk - 1) / nblk, c0 = 512 * sc + 8 * lane; const float* cw = C.in[I_L0 + E_CW] + c0; const float* cb = C.in[I_L0 + E_CB] + c0;
      const f32x4 wa0 = *(const f32x4*)(cw), wb0 = *(const f32x4*)(cw + 4), wa1 = *(const f32x4*)(cw + 2048), wb1 = *(const f32x4*)(cw + 2048 + 4), wa2 = *(const f32x4*)(cw + 4096), wb2 = *(const f32x4*)(cw + 4096 + 4);
      const f32x4 wa3 = *(const f32x4*)(cw + 6144), wb3 = *(const f32x4*)(cw + 6144 + 4), wa4 = *(const f32x4*)(cw + 8192), wb4 = *(const f32x4*)(cw + 8192 + 4), ba = *(const f32x4*)(cb), bb = *(const f32x4*)(cb + 4);
      const float ksc = sc >= 2 ? 0.08838834764831845f : 1.f;
      const int r0 = (gw >> 2) * RB, r1 = (r0 + RB < M0) ? r0 + RB : M0;
      if (r0 < M0) {
#define LDROW(rr_) (*(const v4u*)(PB + (size_t)((rr_) < 0 ? 0 : ((rr_) >= M0 ? M0 - 1 : (rr_))) * NIN0P + C_MLQK + c0))
#define SEGID(rr_) (((rr_) < 0 || (rr_) >= M0) ? -1 : 2 * ((rr_) / TT) + (((rr_) % TT) >= LCTX ? 1 : 0))
        v4u x0 = LDROW(r0 - 2), x1 = LDROW(r0 - 1), x2 = LDROW(r0), x3 = LDROW(r0 + 1), x4 = LDROW(r0 + 2);
        int g0 = SEGID(r0 - 2), g1 = SEGID(r0 - 1), g2 = SEGID(r0), g3 = SEGID(r0 + 1), g4 = SEGID(r0 + 2);
        for (int r = r0; r < r1; ++r) { const v4u xn = LDROW(r + 3); const int gn = SEGID(r + 3);
            f32x4 aa = ba, ab = bb;
#define TAP(X, G, WA, WB) do { const unsigned m_ = (G == g2) ? 0xffffffffu : 0u; const unsigned x_ = X.x & m_, y_ = X.y & m_, z_ = X.z & m_, w_ = X.w & m_; \
                aa += WA * (f32x4){bf2f(x_ & 0xffffu), bf2f(x_ >> 16), bf2f(y_ & 0xffffu), bf2f(y_ >> 16)}; ab += WB * (f32x4){bf2f(z_ & 0xffffu), bf2f(z_ >> 16), bf2f(w_ & 0xffffu), bf2f(w_ >> 16)}; } while (0)
            TAP(x0, g0, wa0, wb0); TAP(x1, g1, wa1, wb1); TAP(x2, g2, wa2, wb2); TAP(x3, g3, wa3, wb3); TAP(x4, g4, wa4, wb4);
#undef TAP
            const v4u o = (v4u){pk2(siluf(aa.x) * ksc, siluf(aa.y) * ksc), pk2(siluf(aa.z) * ksc, siluf(aa.w) * ksc), pk2(siluf(ab.x) * ksc, siluf(ab.y) * ksc), pk2(siluf(ab.z) * ksc, siluf(ab.w) * ksc)};
            bf16* dst = (sc >= 2 ? MK + (size_t)r * 1024 + (c0 - 1024) : MQ + (size_t)r * 1024 + c0); *(v4u*)dst = o;
            x0 = x1; x1 = x2; x2 = x3; x3 = x4; x4 = xn; g0 = g1; g1 = g2; g2 = g3; g3 = g4; g4 = gn; }
#undef SEGID
#undef LDROW
      } }
}
__device__ __forceinline__ void p_mlfin_l0(const Ctx& C0) { const Ctx C = phase_ctx(C0);
    const int gw = C.bid * NWAVES + C.wave, NGW = C.G * NWAVES, lane = C.lane;
    const float* HM = WSP(const float, WS_HM); const bf16* PB = WSP(const bf16, WS_PROJ); bf16* AO = WSP(bf16, WS_AO);
    for (int r = gw; r < M0; r += NGW) { float f[16]; float s = 0.f;
#pragma unroll
        for (int q = 0; q < 4; ++q) { const f32x4 a = *(const f32x4*)(HM + (size_t)r * 1024 + 16 * lane + 4 * q), bq = *(const f32x4*)(HM + (size_t)(M0 + r) * 1024 + 16 * lane + 4 * q);
            f[4 * q] = a.x + bq.x; f[4 * q + 1] = a.y + bq.y; f[4 * q + 2] = a.z + bq.z; f[4 * q + 3] = a.w + bq.w; }
#pragma unroll
        for (int i = 0; i < 16; ++i) s += f[i] * f[i];
        s += __shfl_xor(s, 1); s += __shfl_xor(s, 2); s += __shfl_xor(s, 4);
        const float rr = 1.f / sqrtf(s * (1.f / 128.f) + EPS); const float* g = C.in[I_L0 + E_HN] + 16 * lane; const bf16* mo = PB + (size_t)r * NIN0P + C_MLO + 16 * lane; unsigned o[8];
#pragma unroll
        for (int i = 0; i < 8; ++i) o[i] = pk2(f[2 * i] * rr * g[2 * i] * sigmf(bf2f(mo[2 * i])), f[2 * i + 1] * rr * g[2 * i + 1] * sigmf(bf2f(mo[2 * i + 1])));
        bf16* dst = AO + (size_t)r * D + 1024 + 16 * lane; *(v4u*)dst = (v4u){o[0], o[1], o[2], o[3]}; *(v4u*)(dst + 8) = (v4u){o[4], o[5], o[6], o[7]}; }
}
__device__ __forceinline__ void p_prep_l1(const Ctx& C0) { const Ctx C = phase_ctx(C0);
    const int gw = C.bid * NWAVES + C.wave, NGW = C.G * NWAVES, lane = C.lane, grp = lane >> 2, dA = 16 * (lane & 3);
    const bf16* PB = WSP(const bf16, WS_PROJ); bf16* Q1 = WSP(bf16, WS_QK); bf16* K1 = Q1 + (size_t)32 * SEQ * 128;
    const float* rc = WSP(const float, WS_ROPE); const float* rs = rc + SEQ * 64;
    f32x4 gq[8], gk[8];
#pragma unroll
    for (int q = 0; q < 4; ++q) { gq[q] = *(const f32x4*)(C.in[I_L1 + O_QN] + dA + 4 * q); gq[4 + q] = *(const f32x4*)(C.in[I_L1 + O_QN] + 64 + dA + 4 * q);
                                  gk[q] = *(const f32x4*)(C.in[I_L1 + O_KN] + dA + 4 * q); gk[4 + q] = *(const f32x4*)(C.in[I_L1 + O_KN] + 64 + dA + 4 * q); }
    for (int r = gw; r < M0; r += NGW) { const int b = r / TT, t = r - b * TT; const bool lat = t >= LCTX; const int s = lat ? t - LCTX : 0;
        const bf16* src = PB + (size_t)r * NIN1 + grp * 128 + dA;
        v4u xq[4], xk[4]; f32x4 cs[4], sn[4];
#pragma unroll
        for (int q = 0; q < 2; ++q) { xk[q] = *(const v4u*)(src + 2048 + 8 * q); xk[2 + q] = *(const v4u*)(src + 2048 + 64 + 8 * q); xq[q] = *(const v4u*)(src + 8 * q); xq[2 + q] = *(const v4u*)(src + 64 + 8 * q); }
#pragma unroll
        for (int q = 0; q < 4; ++q) { cs[q] = *(const f32x4*)(rc + (size_t)s * 64 + dA + 4 * q); sn[q] = *(const f32x4*)(rs + (size_t)s * 64 + dA + 4 * q); }
#pragma unroll
        for (int qk = 0; qk < 2; ++qk) { if (qk == 0 && !lat) continue;
            float f[32]; float ss = 0.f;
#pragma unroll
            for (int q = 0; q < 4; ++q) { const v4u a = qk ? xk[q] : xq[q]; const unsigned w[4] = {a.x, a.y, a.z, a.w};
#pragma unroll
                for (int i = 0; i < 4; ++i) { f[8 * q + 2 * i] = bf2f(w[i] & 0xffffu); f[8 * q + 2 * i + 1] = bf2f(w[i] >> 16); } }
#pragma unroll
            for (int i = 0; i < 32; ++i) ss += f[i] * f[i];
            ss += __shfl_xor(ss, 1); ss += __shfl_xor(ss, 2);
            const float rr = 1.f / sqrtf(ss * (1.f / 128.f) + EPS);
#pragma unroll
            for (int i = 0; i < 32; ++i) f[i] = f[i] * rr * (qk ? gk[i >> 2][i & 3] : gq[i >> 2][i & 3]);
            if (lat) {
#pragma unroll
                for (int i = 0; i < 16; ++i) { const float c = cs[i >> 2][i & 3], sv = sn[i >> 2][i & 3], xa = f[i], xb = f[16 + i]; f[i] = xa * c - xb * sv; f[16 + i] = xb * c + xa * sv; } }
            bf16* dst = qk ? K1 + (((size_t)b * 16 + grp) * TT + t) * 128 + dA : Q1 + (((size_t)b * 16 + grp) * SEQ + s) * 128 + dA;
#pragma unroll
            for (int q = 0; q < 4; ++q) { unsigned ow[4];
#pragma unroll
                for (int i = 0; i < 4; ++i) ow[i] = pk2(f[8 * q + 2 * i], f[8 * q + 2 * i + 1]);
                *(v4u*)(dst + (q >> 1) * 64 + 8 * (q & 1)) = (v4u){ow[0], ow[1], ow[2], ow[3]}; } }
    }
}
namespace da {
typedef unsigned short bf16;
constexpr int D = 128, NW = 8, QBLK = 32, KVBLK = 64, SDEPTH = 2;
constexpr float SCALE = 0.088388347648318440f, THR = 8.f;
constexpr size_t SHM_V = KVBLK * D * 2, SHM_K = KVBLK * D * 2, SHM_ATTN = 2 * SHM_V + 2 * SHM_K + NW * 64 * 4;
using bf16x8 = __attribute__((ext_vector_type(8))) short;
using s16x4  = __attribute__((ext_vector_type(4))) short;
using f32x16 = __attribute__((ext_vector_type(16))) float;
using f32x8  = __attribute__((ext_vector_type(8))) float;
using u32x4  = __attribute__((ext_vector_type(4))) unsigned;
#define KSWZ(row, colB) ((row) * 256 + ((colB) ^ (((row) & 7) << 4)))
#define SBAR() __builtin_amdgcn_sched_barrier(0)
__device__ __forceinline__ int crow(int r, int hi) { return (r & 3) + 8 * (r >> 2) + 4 * hi; }
__device__ __forceinline__ unsigned cvtpk(float lo, float hi) {
  unsigned r; asm volatile("v_cvt_pk_bf16_f32 %0, %1, %2" : "=v"(r) : "v"(lo), "v"(hi)); return r;
}

__device__ __forceinline__ void partialSM(f32x16& p0, f32x16& p1, float& m_reg, float& mn, float& alpha) {
  constexpr float C = SCALE * 1.4426950408889634f;
  float pmax = p0[0]; for (int r = 1; r < 16; ++r) pmax = fmaxf(pmax, p0[r]); for (int r = 0; r < 16; ++r) pmax = fmaxf(pmax, p1[r]);
  { auto rr = __builtin_amdgcn_permlane32_swap(__float_as_uint(pmax), __float_as_uint(pmax), false, false);
    pmax = fmaxf(__uint_as_float(rr[0]), __uint_as_float(rr[1])); }
  if (__builtin_expect(__all(pmax - m_reg <= THR / SCALE), 1)) { mn = m_reg; alpha = 1.f; }
  else { mn = fmaxf(m_reg, pmax); alpha = __builtin_amdgcn_exp2f((m_reg - mn) * C); m_reg = mn; }
  float mnC = -mn * C;
  for (int r = 0; r < 16; ++r) p0[r] = fmaf(p0[r], C, mnC); for (int r = 0; r < 16; ++r) p1[r] = fmaf(p1[r], C, mnC);
  for (int r = 0; r < 16; ++r) p0[r] = __builtin_amdgcn_exp2f(p0[r]);
}
__device__ __forceinline__ void finishSM(f32x16& p0, f32x16& p1, float alpha, float& l_reg, bf16x8& pa0, bf16x8& pa1, bf16x8& pa2, bf16x8& pa3) {
  for (int r = 0; r < 16; ++r) p1[r] = __builtin_amdgcn_exp2f(p1[r]);
  float ps = 0; for (int r = 0; r < 16; ++r) ps += p0[r]; for (int r = 0; r < 16; ++r) ps += p1[r];
  { auto rr = __builtin_amdgcn_permlane32_swap(__float_as_uint(ps), __float_as_uint(ps), false, false);
    ps = __uint_as_float(rr[0]) + __uint_as_float(rr[1]); }
  l_reg = l_reg * alpha + ps;
#define PK4(P, BASE, OUT) do { unsigned a0 = cvtpk(P[BASE + 0], P[BASE + 1]), a1 = cvtpk(P[BASE + 2], P[BASE + 3]);   \
    unsigned b0 = cvtpk(P[BASE + 4], P[BASE + 5]), b1 = cvtpk(P[BASE + 6], P[BASE + 7]);                              \
    auto r0 = __builtin_amdgcn_permlane32_swap(a0, b0, false, false); auto r1 = __builtin_amdgcn_permlane32_swap(a1, b1, false, false); \
    u32x4 w = {r0[0], r1[0], r0[1], r1[1]}; OUT = *reinterpret_cast<bf16x8*>(&w); } while (0)
  PK4(p0, 0, pa0); PK4(p0, 8, pa1); PK4(p1, 0, pa2); PK4(p1, 8, pa3);
#undef PK4
}
__device__ __forceinline__ void qkt(f32x16& p0, f32x16& p1, const bf16* Ks, const bf16x8* qr, int r32, int hi) {
  p0 = f32x16{}; p1 = f32x16{};
  for (int d0 = 0; d0 < 8; ++d0) { int cb = (d0 * 16 + hi * 8) * 2;
    bf16x8 b0 = *reinterpret_cast<const bf16x8*>((const char*)Ks + KSWZ(r32, cb));
    bf16x8 b1 = *reinterpret_cast<const bf16x8*>((const char*)Ks + KSWZ(32 + r32, cb));
    p0 = __builtin_amdgcn_mfma_f32_32x32x16_bf16(b0, qr[d0], p0, 0, 0, 0);
    p1 = __builtin_amdgcn_mfma_f32_32x32x16_bf16(b1, qr[d0], p1, 0, 0, 0); }
}
__device__ __forceinline__ int v_st(int k, int c) { const int kk = (k & ~0xC) | ((k & 4) << 1) | ((k & 8) >> 1); return ((kk >> 3) * 4 + (c >> 5)) * 512 + ((kk & 7) * 32 + (c & 31)) * 2; }
__device__ __forceinline__ int v_rd_base(int lane) { return ((lane & 3) << 3) | (((lane >> 2) & 3) << 6) | (((lane >> 4) & 1) << 5) | (((lane >> 5) & 1) << 8); }
constexpr int v_rd_off(int d0, int ks, int half) { return d0 * 512 + ks * 4096 + half * 2048; }
template <int OFF> __device__ __forceinline__ s16x4 tr_read(int vb) {
  s16x4 r; asm volatile("ds_read_b64_tr_b16 %0, %1 offset:%2" : "=&v"(r) : "v"(vb), "i"(OFF) : "memory"); return r;
}
template <int D0> __device__ __forceinline__ void pv_one(f32x16& od, int vb, bf16x8 pa0, bf16x8 pa1, bf16x8 pa2, bf16x8 pa3) {
  const s16x4 l0 = tr_read<v_rd_off(D0, 0, 0)>(vb), h0 = tr_read<v_rd_off(D0, 0, 1)>(vb), l1 = tr_read<v_rd_off(D0, 1, 0)>(vb), h1 = tr_read<v_rd_off(D0, 1, 1)>(vb);
  const s16x4 l2 = tr_read<v_rd_off(D0, 2, 0)>(vb), h2 = tr_read<v_rd_off(D0, 2, 1)>(vb), l3 = tr_read<v_rd_off(D0, 3, 0)>(vb), h3 = tr_read<v_rd_off(D0, 3, 1)>(vb);
  asm volatile("s_waitcnt lgkmcnt(0)" ::: "memory"); SBAR();
#define PK(L, H) (bf16x8){L[0], L[1], L[2], L[3], H[0], H[1], H[2], H[3]}
  od = __builtin_amdgcn_mfma_f32_32x32x16_bf16(pa0, PK(l0, h0), od, 0, 0, 0);
  od = __builtin_amdgcn_mfma_f32_32x32x16_bf16(pa1, PK(l1, h1), od, 0, 0, 0);
  od = __builtin_amdgcn_mfma_f32_32x32x16_bf16(pa2, PK(l2, h2), od, 0, 0, 0);
  od = __builtin_amdgcn_mfma_f32_32x32x16_bf16(pa3, PK(l3, h3), od, 0, 0, 0);
#undef PK
}
__device__ __forceinline__ void pv_d0(f32x16* o, int vb, bf16x8 pa0, bf16x8 pa1, bf16x8 pa2, bf16x8 pa3) {
  pv_one<0>(o[0], vb, pa0, pa1, pa2, pa3); pv_one<1>(o[1], vb, pa0, pa1, pa2, pa3); pv_one<2>(o[2], vb, pa0, pa1, pa2, pa3); pv_one<3>(o[3], vb, pa0, pa1, pa2, pa3);
}

template <int LDQ, int LDK, int LDV, int LDO>
__device__ __forceinline__ void attn_dense_body(const bf16* __restrict__ Qb, const bf16* __restrict__ Kh, const bf16* __restrict__ Vh,
                                                int mode, float* Sw, const float* Sa, bf16* __restrict__ Ob, const float* __restrict__ gain, float lam, float post, int seq, char* lds) {
  int tz = threadIdx.x; asm volatile("" : "+v"(tz));
  const int tid = tz, wid = tid >> 6, lane = tid & 63, r32 = lane & 31, hi = lane >> 5;
  bf16* V_lds = (bf16*)lds; bf16* K_lds = (bf16*)(lds + 2 * SHM_V);
  float* ws = (float*)(lds + 2 * SHM_V + 2 * SHM_K) + wid * 64; float* li_l = ws; float* al_l = ws + 32;
  float m_reg = -1e30f, l_reg = 0; f32x16 o[4] = {}; bf16x8 qr[8];
  const bf16* Qw = Qb + (long)(wid * QBLK + r32) * LDQ + hi * 8;
#pragma unroll
  for (int d0 = 0; d0 < 8; ++d0) qr[d0] = *reinterpret_cast<const bf16x8*>(Qw + d0 * 16);
  const int sr = tid >> 4, sc = (tid & 15) * 8, vst0 = v_st(sr, sc), vst1 = v_st(32 + sr, sc);
  const int vb0 = (int)(uintptr_t)V_lds + v_rd_base(lane);
  struct { bf16x8 vs0, vs1, ks0, ks1; } sr_[SDEPTH];
#define SLOAD(i, k0) do { sr_[i].vs0 = *reinterpret_cast<const bf16x8*>(&Vh[(long)((k0) + sr) * LDV + sc]); sr_[i].vs1 = *reinterpret_cast<const bf16x8*>(&Vh[(long)((k0) + 32 + sr) * LDV + sc]); \
    sr_[i].ks0 = *reinterpret_cast<const bf16x8*>(&Kh[(long)((k0) + sr) * LDK + sc]); sr_[i].ks1 = *reinterpret_cast<const bf16x8*>(&Kh[(long)((k0) + 32 + sr) * LDK + sc]); } while (0)
#define SWRITE(b, i) do { *(bf16x8*)((char*)V_lds + (b) * SHM_V + vst0) = sr_[i].vs0;          \
    *(bf16x8*)((char*)V_lds + (b) * SHM_V + vst1) = sr_[i].vs1; int kc = sc * 2;               \
    *(bf16x8*)((char*)K_lds + (b) * SHM_K + KSWZ(sr, kc)) = sr_[i].ks0;                       \
    *(bf16x8*)((char*)K_lds + (b) * SHM_K + KSWZ(32 + sr, kc)) = sr_[i].ks1; } while (0)
#define SWAIT() do { if constexpr (SDEPTH == 2) asm volatile("s_waitcnt vmcnt(4)" ::: "memory"); else asm volatile("s_waitcnt vmcnt(0)" ::: "memory"); } while (0)
#define RESC(a) do { if (__any((a) < 1.f)) { if (hi == 0) al_l[r32] = (a); asm volatile("s_waitcnt lgkmcnt(0)" ::: "memory"); \
    for (int d = 0; d < 4; ++d) for (int r = 0; r < 16; ++r) o[d][r] *= al_l[crow(r, hi)]; } } while (0)
  f32x16 pA0, pA1, pB0, pB1; float mnA, mnB, alA, alB; bf16x8 pa0, pa1, pa2, pa3; const int NT = seq / KVBLK;
  constexpr int SE = 0, SO = SDEPTH - 1;
  SLOAD(SE, 0); asm volatile("s_waitcnt vmcnt(0)" ::: "memory"); SWRITE(0, SE); __syncthreads();
  qkt(pA0, pA1, K_lds, qr, r32, hi); partialSM(pA0, pA1, m_reg, mnA, alA);
  SLOAD(SO, KVBLK); if constexpr (SDEPTH == 2) { if (2 < NT) SLOAD(SE, 2 * KVBLK); }
  SWAIT(); SWRITE(1, SO); __syncthreads();
  for (int j = 1; j + 1 < NT; j += 2) {
    SBAR(); qkt(pB0, pB1, (bf16*)((char*)K_lds + SHM_K), qr, r32, hi);
    finishSM(pA0, pA1, alA, l_reg, pa0, pa1, pa2, pa3); SBAR();
    SLOAD(SO, (j + SDEPTH) * KVBLK); SBAR();
    pv_d0(o, vb0, pa0, pa1, pa2, pa3); partialSM(pB0, pB1, m_reg, mnB, alB);
    __syncthreads(); SWAIT(); SWRITE(0, SE);
    RESC(alB); __syncthreads();
    SBAR(); qkt(pA0, pA1, K_lds, qr, r32, hi);
    finishSM(pB0, pB1, alB, l_reg, pa0, pa1, pa2, pa3); SBAR();
    if (SDEPTH == 1 || j + 3 < NT) SLOAD(SE, (j + 1 + SDEPTH) * KVBLK); SBAR();
    pv_d0(o, vb0 + (int)SHM_V, pa0, pa1, pa2, pa3); partialSM(pA0, pA1, m_reg, mnA, alA);
    __syncthreads(); SWAIT(); SWRITE(1, SO);
    RESC(alA); __syncthreads();
  }
  SBAR(); qkt(pB0, pB1, (bf16*)((char*)K_lds + SHM_K), qr, r32, hi);
  finishSM(pA0, pA1, alA, l_reg, pa0, pa1, pa2, pa3); SBAR();
  pv_d0(o, vb0, pa0, pa1, pa2, pa3); partialSM(pB0, pB1, m_reg, mnB, alB);
  __syncthreads(); RESC(alB);
  finishSM(pB0, pB1, alB, l_reg, pa0, pa1, pa2, pa3); SBAR();
  pv_d0(o, vb0 + (int)SHM_V, pa0, pa1, pa2, pa3);
  if (hi == 0) li_l[r32] = l_reg; asm volatile("s_waitcnt lgkmcnt(0)" ::: "memory");
  float rli[16];
#pragma unroll
  for (int r = 0; r < 16; ++r) rli[r] = __builtin_amdgcn_rcpf(li_l[crow(r, hi)]);
  __syncthreads();
  { float* Ls = (float*)lds + wid * (QBLK * 128);
#pragma unroll
    for (int r = 0; r < 16; ++r) { const int orow = crow(r, hi);
#pragma unroll
      for (int d0 = 0; d0 < 4; ++d0) Ls[orow * 128 + d0 * 32 + r32] = o[d0][r] * rli[r]; }
    asm volatile("s_waitcnt lgkmcnt(0)" ::: "memory"); __builtin_amdgcn_wave_barrier();
    for (int r0 = 0; r0 < QBLK; r0 += 4) { float vx[4], vy[4];
      const long ob = (wid * QBLK + r0) * 128L + 2 * lane;
#pragma unroll
      for (int x = 0; x < 4; ++x) { vx[x] = Ls[(r0 + x) * 128 + 2 * lane]; vy[x] = Ls[(r0 + x) * 128 + 2 * lane + 1]; }
      if (mode == 0) {
#pragma unroll
        for (int x = 0; x < 4; ++x) { Sw[ob + 128 * x] = vx[x]; Sw[ob + 128 * x + 1] = vy[x]; } }
      else if (mode == 1) { float s0[4], s1[4];
#pragma unroll
        for (int x = 0; x < 4; ++x) { s0[x] = Sw[ob + 128 * x]; s1[x] = Sw[ob + 128 * x + 1]; }
#pragma unroll
        for (int x = 0; x < 4; ++x) { Sw[ob + 128 * x] = s0[x] - lam * vx[x]; Sw[ob + 128 * x + 1] = s1[x] - lam * vy[x]; } }
      else { float s0[4], s1[4], a0[4], a1[4], b0[4], b1[4], ss[4];
#pragma unroll
        for (int x = 0; x < 4; ++x) { s0[x] = Sw[ob + 128 * x]; s1[x] = Sw[ob + 128 * x + 1]; a0[x] = Sa[ob + 128 * x]; a1[x] = Sa[ob + 128 * x + 1]; }
#pragma unroll
        for (int x = 0; x < 4; ++x) { b0[x] = s0[x] - lam * vx[x]; b1[x] = s1[x] - lam * vy[x]; ss[x] = a0[x] * a0[x] + a1[x] * a1[x] + b0[x] * b0[x] + b1[x] * b1[x]; }
#pragma unroll
        for (int off = 1; off < 64; off <<= 1) {
#pragma unroll
          for (int x = 0; x < 4; ++x) ss[x] += __shfl_xor(ss[x], off); }
#pragma unroll
        for (int x = 0; x < 4; ++x) { const float rn = post / sqrtf(ss[x] * (1.f / 256.f) + 1e-6f); bf16* orp = Ob + (wid * QBLK + r0 + x) * (long)LDO + 2 * lane;
          *(unsigned*)orp = cvtpk(a0[x] * rn * gain[2 * lane], a1[x] * rn * gain[2 * lane + 1]); *(unsigned*)(orp + 128) = cvtpk(b0[x] * rn * gain[128 + 2 * lane], b1[x] * rn * gain[128 + 2 * lane + 1]); } } } }
#undef SLOAD
#undef SWRITE
#undef SWAIT
#undef RESC
}

#undef KSWZ
#undef SBAR
}
__device__ __forceinline__ bf16x8 ld_frag(const LAS bf16* base, int ld, int x0, int k0, int lane) { return *(const LAS bf16x8*)(base + (x0 + (lane & 15)) * ld + k0 + 8 * (lane >> 4)); }
#define MFMA16(a, b, c) __builtin_amdgcn_mfma_f32_16x16x32_bf16((a), (b), (c), 0, 0, 0)
__device__ __forceinline__ float grp16_max(float v) { v = fmaxf(v, __shfl_xor(v, 1)); v = fmaxf(v, __shfl_xor(v, 2)); v = fmaxf(v, __shfl_xor(v, 4)); v = fmaxf(v, __shfl_xor(v, 8)); return v; }
__device__ __forceinline__ float grp16_sum(float v) { v += __shfl_xor(v, 1); v += __shfl_xor(v, 2); v += __shfl_xor(v, 4); v += __shfl_xor(v, 8); return v; }
typedef short s16x4 __attribute__((ext_vector_type(4)));
__device__ __forceinline__ int lds_addr(const LAS void* p) { return (int)(unsigned)(unsigned long)p; }
__device__ __forceinline__ void tr_frag_issue(s16x4& lo, s16x4& hi, const LAS bf16* T, int ld, int k0, int n0, int lane) {
    const int g = lane >> 4, q = (lane >> 2) & 3, p = lane & 3; const int addr = lds_addr(T + (k0 + 8 * g + q) * ld + n0 + 4 * p);
    asm volatile("ds_read_b64_tr_b16 %0, %1" : "=&v"(lo) : "v"(addr) : "memory");
    asm volatile("ds_read_b64_tr_b16 %0, %1" : "=&v"(hi) : "v"(addr + 4 * ld * 2) : "memory");
}
#define TR_PK(L, H) (bf16x8){L[0], L[1], L[2], L[3], H[0], H[1], H[2], H[3]}
constexpr int LDK = 136, LDT = 72;
constexpr float NEG_BIG = -1e30f;

template <int DV> struct AttnState { f32x4 o[DV / 16]; float m[4], l[4];
    __device__ __forceinline__ void init() {
#pragma unroll
        for (int n = 0; n < DV / 16; ++n) o[n] = (f32x4){0.f, 0.f, 0.f, 0.f};
#pragma unroll
        for (int i = 0; i < 4; ++i) { m[i] = NEG_BIG; l[i] = 0.f; } } };
template <int DV, class Bias> __device__ __forceinline__ void attn_tile(AttnState<DV>& st, const bf16x8 (&qf)[4], const LAS bf16* sK, const LAS bf16* sV, LAS bf16* sP, float scale, const Bias& bias, int lane, int jlo, int jhi) {
    f32x4 s[4];
#pragma unroll
    for (int j = 0; j < 4; ++j) { s[j] = (f32x4){0.f, 0.f, 0.f, 0.f};
        if (j >= jlo && j < jhi) {
#pragma unroll
            for (int ks = 0; ks < 4; ++ks) s[j] = MFMA16(qf[ks], ld_frag(sK, LDK, 16 * j, 32 * ks, lane), s[j]); } }
    float alpha[4];
#pragma unroll
    for (int i = 0; i < 4; ++i) { float v[4]; bool ok[4]; float mx = NEG_BIG;
#pragma unroll
        for (int j = 0; j < 4; ++j) { ok[j] = false; v[j] = 0.f; if (j >= jlo && j < jhi) { const float bb = bias(i, j); ok[j] = bb > -1e29f; v[j] = s[j][i] * scale + bb; mx = ok[j] ? fmaxf(mx, v[j]) : mx; } }
        mx = grp16_max(mx); const float mn = fmaxf(st.m[i], mx); alpha[i] = __expf(st.m[i] - mn); st.m[i] = mn; float ps = 0.f;
#pragma unroll
        for (int j = 0; j < 4; ++j) { float p = 0.f; if (j >= jlo && j < jhi) p = ok[j] ? __expf(v[j] - mn) : 0.f; ps += p; sP[(4 * (lane >> 4) + i) * LDT + 16 * j + (lane & 15)] = (bf16)f2bf(p); }
        st.l[i] = st.l[i] * alpha[i] + ps; }
#pragma unroll
    for (int n = 0; n < DV / 16; ++n) { st.o[n][0] *= alpha[0]; st.o[n][1] *= alpha[1]; st.o[n][2] *= alpha[2]; st.o[n][3] *= alpha[3]; }
    LDS_WAIT(); __builtin_amdgcn_wave_barrier();
    const bf16x8 pa0 = ld_frag(sP, LDT, 0, 0, lane), pa1 = ld_frag(sP, LDT, 0, 32, lane);
#pragma unroll
    for (int half = 0; half < DV / 64; ++half) {
        s16x4 vl[4][2], vh[4][2];
#pragma unroll
        for (int n = 0; n < 4; ++n)
#pragma unroll
            for (int ks = 0; ks < 2; ++ks) tr_frag_issue(vl[n][ks], vh[n][ks], sV, LDK, 32 * ks, 16 * (4 * half + n), lane);
        asm volatile("s_waitcnt lgkmcnt(0)" ::: "memory"); __builtin_amdgcn_sched_barrier(0);
#pragma unroll
        for (int n = 0; n < 4; ++n) { if (jlo < 2) st.o[4 * half + n] = MFMA16(pa0, TR_PK(vl[n][0], vh[n][0]), st.o[4 * half + n]); if (jhi > 2) st.o[4 * half + n] = MFMA16(pa1, TR_PK(vl[n][1], vh[n][1]), st.o[4 * half + n]); }
        __builtin_amdgcn_sched_barrier(0); }
}
__device__ __forceinline__ void load_qfrag(bf16x8 (&qf)[4], const bf16* qrow0, size_t qld, int lane) {
#pragma unroll
    for (int ks = 0; ks < 4; ++ks) qf[ks] = *(const bf16x8*)(qrow0 + (size_t)(lane & 15) * qld + 32 * ks + 8 * (lane >> 4));
}
struct NoBias { __device__ __forceinline__ float operator()(int, int) const { return 0.f; } };

struct NaBias { const LAS float* rpb; int dr  , w0  ; int lane;
    __device__ __forceinline__ float operator()(int i, int j) const { const int w = w0 + i, col = 16 * j + (lane & 15); int c0 = w - 8; c0 = c0 < 0 ? 0 : (c0 > 48 ? 48 : c0);
        return (col >= c0 && col < c0 + 16) ? rpb[dr * 31 + (col - w + 15)] : NEG_BIG; } };
__device__ __forceinline__ void p_na_l0(const Ctx& C0, int qsel) { const Ctx C = phase_ctx(C0);
    LAS bf16* sK = (LAS bf16*)C.lds; LAS bf16* sV = sK + 64 * LDK; LAS bf16* sP = sV + 64 * LDK + C.wave * (16 * LDT); LAS float* sRpb = (LAS float*)(C.lds + 65536);
    const bf16* PB = WSP(const bf16, WS_PROJ); const bf16* QN = WSP(const bf16, WS_QK); const bf16* KN = QN + (size_t)M0 * 1024; bf16* AO = WSP(bf16, WS_AO);
    const float scale = 0.08838834764831845f; const int lane = C.lane, wave = C.wave;
    LAS int* sUnit = (LAS int*)(C.lds + 65536 + 2048);
    const int sj = C.tid >> 4, sq = C.tid & 15;
    unsigned* naq = WSP(unsigned, WS_CTL) + CW_NAQ + 64 * qsel;
    __syncthreads();
    if (C.tid == 0) sUnit[0] = (int)atomicAdd(naq, 1u);
    __syncthreads();
    int u = sUnit[0];
    while (u < 512 + 32) {
        unsigned nxtu = 0u; if (C.tid == 0) nxtu = atomicAdd(naq, 1u);
        const bool ctxq = u >= 512; const int v = ctxq ? u - 512 : u; const int b = ctxq ? v / 16 : v / 256, h = ctxq ? (v / 2) % 8 : (v / 32) % 8, rp = v % 32;
        const size_t rowb = (size_t)b * TT;
        int r = 0, q0; if (ctxq) q0 = 128 * (v & 1) + 16 * wave; else { r = 2 * rp + (wave >> 2); q0 = LCTX + r * 64 + 16 * (wave & 3); }
        bf16x8 qf[4]; load_qfrag(qf, QN + (rowb + q0) * 1024 + h * 128, 1024, lane);
        AttnState<128> st; st.init(); const int gq = wave & 3, jl = gq < 2 ? 0 : gq - 1, jh = gq > 1 ? 4 : gq + 2;
        int kr0 = r - 4; kr0 = kr0 < 0 ? 0 : (kr0 > 56 ? 56 : kr0);
        int lo = 2 * rp - 4; lo = lo < 0 ? 0 : (lo > 56 ? 56 : lo); int hi = 2 * rp + 1 - 4; hi = (hi < 0 ? 0 : (hi > 56 ? 56 : hi)) + 7;
        const int nloc = ctxq ? 0 : hi - lo + 1, ntile = nloc + 4;
        if (!ctxq) for (int i = C.tid; i < 15 * 31; i += NTHR) sRpb[i] = C.in[I_L0 + E_RPB][h * 465 + i];
#define NA_KROW(tl) (rowb + ((tl) < nloc ? LCTX + (lo + (tl)) * 64 : ((tl) - nloc) * 64))
#define NA_LOAD(tl) do { const size_t kr_ = NA_KROW(tl); const bf16* kp = KN + kr_ * 1024 + h * 128 + 8 * sq; const bf16* vp = PB + kr_ * NIN0P + C_NAV + h * 128 + 8 * sq; \
            pk0 = *(const v4u*)(kp + (size_t)sj * 1024); pk1 = *(const v4u*)(kp + (size_t)(32 + sj) * 1024); pv0 = *(const v4u*)(vp + (size_t)sj * NIN0P); pv1 = *(const v4u*)(vp + (size_t)(32 + sj) * NIN0P); } while (0)
        v4u pk0, pk1, pv0, pv1; NA_LOAD(0);
        for (int tl = 0; tl < ntile; ++tl) {
            const bool loc = tl < nloc; const int kr = lo + tl;
            int lz = lane; asm volatile("" : "+v"(lz));
            __syncthreads();
            *(LAS v4u*)(sK + sj * LDK + 8 * sq) = pk0; *(LAS v4u*)(sK + (32 + sj) * LDK + 8 * sq) = pk1; *(LAS v4u*)(sV + sj * LDK + 8 * sq) = pv0; *(LAS v4u*)(sV + (32 + sj) * LDK + 8 * sq) = pv1;
            if (tl + 1 < ntile) NA_LOAD(tl + 1);
            __syncthreads();
            if (loc) { if (kr >= kr0 && kr < kr0 + 8) { NaBias nb{sRpb, kr - r + 7, 16 * (wave & 3) + 4 * (lz >> 4), lz}; attn_tile<128>(st, qf, sK, sV, sP, scale, nb, lz, jl, jh); } }
            else attn_tile<128>(st, qf, sK, sV, sP, scale, NoBias(), lz, 0, 4);
        }
#undef NA_LOAD
#undef NA_KROW
#pragma unroll
        for (int i = 0; i < 4; ++i) { const float inv = 1.f / grp16_sum(st.l[i]); bf16* dst = AO + (rowb + q0 + 4 * (lane >> 4) + i) * D + h * 128 + (lane & 15);
#pragma unroll
            for (int n = 0; n < 8; ++n) dst[16 * n] = (bf16)f2bf(st.o[n][i] * inv); }
        __syncthreads();
        if (C.tid == 0) sUnit[0] = (int)nxtu;
        __syncthreads();
        u = sUnit[0];
    }
}
__device__ __forceinline__ void p_da_l1(const Ctx& C0) { const Ctx C = phase_ctx(C0);
    const bf16* PB = WSP(const bf16, WS_PROJ); const bf16* Q1 = WSP(const bf16, WS_QK); const bf16* K1 = Q1 + (size_t)32 * SEQ * 128; bf16* AO = WSP(bf16, WS_AO);
    float* S0 = WSP(float, WS_HM) + (size_t)C.bid * (2 * 256 * 128); float* S1 = S0 + 256 * 128;
    const float linit = 0.35550906759096926f;
    float lamf; { const float* lm = C.in[I_L1 + O_LAM]; float a = 0.f, bq = 0.f; for (int i = 0; i < 128; ++i) { a += lm[i] * lm[128 + i]; bq += lm[256 + i] * lm[384 + i]; } lamf = expf(a) - expf(bq) + linit; }
    for (int u = C.bid; u < 256; u += C.G) { const int b = u / 128, h = (u / 16) % 8, qb = u % 16;
        for (int call = 0; call < 4; ++call) { const int i = call & 1, vh = call >> 1, mode = call == 3 ? 2 : i; const size_t hi = (size_t)b * 16 + h * 2 + i;
            __syncthreads();
            da::attn_dense_body<128, 128, NIN1, D>(Q1 + (hi * SEQ + 256 * qb) * 128, K1 + hi * TT * 128, PB + (size_t)b * TT * NIN1 + 4096 + h * 256 + 128 * vh,
                mode, vh ? S1 : S0, S0, AO + ((size_t)b * SEQ + 256 * qb) * D + h * 256, C.in[I_L1 + O_SUB], lamf, 1.f - linit, TT, (char*)C.lds); } }
}
constexpr int LDV = 56;
__device__ __forceinline__ void p_mlstm_l0(const Ctx& C0) { const Ctx C = phase_ctx(C0);
    LAS bf16* sQ = (LAS bf16*)C.lds; LAS bf16* sK = sQ + 64 * LDK; LAS bf16* sKw = sK + 64 * LDK; LAS bf16* sV = sKw + 64 * LDK; LAS bf16* sP = sV + 64 * LDV; LAS bf16* sCt = sP + 64 * LDT;
    const bf16* PB = WSP(const bf16, WS_PROJ); const bf16* MQ = WSP(const bf16, WS_QK) + (size_t)2 * M0 * 1024; const bf16* MK = MQ + (size_t)M0 * 1024;
    const float* LI = WSP(const float, WS_GATE); const float* LF = LI + 2 * NB * 8 * TT; float* HM = WSP(float, WS_HM);
    const int lane = C.lane, wave = C.wave, tid = C.tid;
    for (int u = C.bid; u < 128; u += C.G) { const int sl = u & 3, dir = (u >> 2) & 1, h = (u >> 3) & 7, b = u >> 6; const size_t rowb = (size_t)b * TT;
        const float* li = LI + (((size_t)dir * NB + b) * 8 + h) * TT; const float* lf = LF + (((size_t)dir * NB + b) * 8 + h) * TT;
        f32x4 cT[2][3]; float m = 0.f;
#pragma unroll
        for (int x = 0; x < 2; ++x)
#pragma unroll
            for (int nt = 0; nt < 3; ++nt) cT[x][nt] = (f32x4){0.f, 0.f, 0.f, 0.f};
        __syncthreads();
        for (int i = tid; i < 48 * LDK; i += NTHR) sCt[i] = 0;
        for (int i = tid; i < 64 * 16; i += NTHR) sV[(i >> 4) * LDV + 32 + (i & 15)] = ((i & 15) == 0) ? (bf16)0x3F80 : (bf16)0;
#define TOK(p) (dir == 0 ? (p) : ((p) < LCTX ? LCTX - 1 - (p) : TT - 1 - ((p) - LCTX)))
        const int j0 = tid >> 4, cq = tid & 15, jv = tid >> 2, cv = tid & 3;
        float* GS = WSP(float, WS_GS) + (size_t)u * (3 * TT);
        for (int c2 = wave; c2 < TT / 64; c2 += NWAVES) { const int p = 64 * c2 + lane, t = TOK(p); float bc = lf[t]; const float fi = li[t];
#pragma unroll
            for (int o = 1; o < 64; o <<= 1) { const float x = __shfl_up(bc, o); if (lane >= o) bc += x; }
            const float a = fi - bc; float pm = a;
#pragma unroll
            for (int o = 1; o < 64; o <<= 1) { const float x = __shfl_up(pm, o); if (lane >= o) pm = fmaxf(pm, x); }
            GS[p] = a; GS[TT + p] = pm; GS[2 * TT + p] = bc; }
        asm volatile("s_waitcnt vmcnt(0)" ::: "memory"); __syncthreads();
        v4u pq0, pq1, pk0, pk1, pv = (v4u){0u, 0u, 0u, 0u}; float pa_, ppm_, pbc_;
#define PREFETCH(p0) do { const size_t r0 = rowb + TOK((p0) + j0), r1 = rowb + TOK((p0) + 32 + j0); \
            pq0 = *(const v4u*)(MQ + r0 * 1024 + h * 128 + 8 * cq); pq1 = *(const v4u*)(MQ + r1 * 1024 + h * 128 + 8 * cq); \
            pk0 = *(const v4u*)(MK + r0 * 1024 + h * 128 + 8 * cq); pk1 = *(const v4u*)(MK + r1 * 1024 + h * 128 + 8 * cq); \
            if (tid < 256) pv = *(const v4u*)(PB + (rowb + TOK((p0) + jv)) * NIN0P + C_MLV + h * 128 + 32 * sl + 8 * cv); \
            { const int p_ = (p0) + lane; pa_ = __hip_atomic_load(GS + p_, __ATOMIC_RELAXED, __HIP_MEMORY_SCOPE_AGENT); ppm_ = __hip_atomic_load(GS + TT + p_, __ATOMIC_RELAXED, __HIP_MEMORY_SCOPE_AGENT); pbc_ = __hip_atomic_load(GS + 2 * TT + p_, __ATOMIC_RELAXED, __HIP_MEMORY_SCOPE_AGENT); } } while (0)
        PREFETCH(0);
        for (int ch = 0; ch < TT / 64; ++ch) { const int p0 = 64 * ch;
            const float a = pa_, bc = pbc_, Mt = fmaxf(m, ppm_);
            const float M63 = __builtin_bit_cast(float, __builtin_amdgcn_readlane(__builtin_bit_cast(int, Mt), 63)), bl = __builtin_bit_cast(float, __builtin_amdgcn_readlane(__builtin_bit_cast(int, bc), 63));
            const float wi = __expf(m - Mt), fl = __expf(-bc - Mt), wg = __expf(a - M63), dec = __expf(m - M63); m = bl + M63;
            __syncthreads();
            { const float w0 = __shfl(wg, j0), w1 = __shfl(wg, 32 + j0);
              *(LAS v4u*)(sQ + j0 * LDK + 8 * cq) = pq0; *(LAS v4u*)(sQ + (32 + j0) * LDK + 8 * cq) = pq1; *(LAS v4u*)(sK + j0 * LDK + 8 * cq) = pk0; *(LAS v4u*)(sK + (32 + j0) * LDK + 8 * cq) = pk1;
              const unsigned x0[4] = {pk0.x, pk0.y, pk0.z, pk0.w}, x1[4] = {pk1.x, pk1.y, pk1.z, pk1.w}; unsigned y0[4], y1[4];
#pragma unroll
              for (int i = 0; i < 4; ++i) { y0[i] = pk2(bf2f(x0[i] & 0xffffu) * w0, bf2f(x0[i] >> 16) * w0); y1[i] = pk2(bf2f(x1[i] & 0xffffu) * w1, bf2f(x1[i] >> 16) * w1); }
              *(LAS v4u*)(sKw + j0 * LDK + 8 * cq) = (v4u){y0[0], y0[1], y0[2], y0[3]}; *(LAS v4u*)(sKw + (32 + j0) * LDK + 8 * cq) = (v4u){y1[0], y1[1], y1[2], y1[3]};
              if (tid < 256) *(LAS v4u*)(sV + jv * LDV + 8 * cv) = pv; }
            if (ch + 1 < TT / 64) PREFETCH(p0 + 64);
            __syncthreads();
#pragma unroll
            for (int q = 0; q < 2; ++q) { const int tt = wave >> 1, stl = 2 * (wave & 1) + q; f32x4 s = (f32x4){0.f, 0.f, 0.f, 0.f};
                if (stl <= tt) {
#pragma unroll
                    for (int ks = 0; ks < 4; ++ks) s = MFMA16(ld_frag(sQ, LDK, 16 * tt, 32 * ks, lane), ld_frag(sK, LDK, 16 * stl, 32 * ks, lane), s); }
                const int sc = 16 * stl + (lane & 15); const float as = __shfl(a, sc);
#pragma unroll
                for (int i = 0; i < 4; ++i) { const int tr = 16 * tt + 4 * (lane >> 4) + i; const float mtr = __shfl(Mt, tr); const float p = (sc <= tr) ? s[i] * __expf(as - mtr) : 0.f; sP[tr * LDT + sc] = (bf16)f2bf(p); } }
            __syncthreads();
            const LAS bf16* sCr = sCt + (ch & 1) * (48 * LDK); LAS bf16* sCw = sCt + ((ch + 1) & 1) * (48 * LDK);
            if (wave < 4) {
                const int tt = wave; s16x4 vl[3][2], vh[3][2];
#pragma unroll
                for (int nt = 0; nt < 3; ++nt)
#pragma unroll
                    for (int ks = 0; ks < 2; ++ks) tr_frag_issue(vl[nt][ks], vh[nt][ks], sV, LDV, 32 * ks, 16 * nt, lane);
                f32x4 aq[3], ap[3];
#pragma unroll
                for (int nt = 0; nt < 3; ++nt) { aq[nt] = (f32x4){0.f, 0.f, 0.f, 0.f};
#pragma unroll
                    for (int ks = 0; ks < 4; ++ks) aq[nt] = MFMA16(ld_frag(sQ, LDK, 16 * tt, 32 * ks, lane), ld_frag(sCr, LDK, 16 * nt, 32 * ks, lane), aq[nt]); }
                const bf16x8 pa0 = ld_frag(sP, LDT, 16 * tt, 0, lane), pa1 = ld_frag(sP, LDT, 16 * tt, 32, lane);
                asm volatile("s_waitcnt lgkmcnt(0)" ::: "memory"); __builtin_amdgcn_sched_barrier(0);
#pragma unroll
                for (int nt = 0; nt < 3; ++nt) { ap[nt] = (f32x4){0.f, 0.f, 0.f, 0.f}; ap[nt] = MFMA16(pa0, TR_PK(vl[nt][0], vh[nt][0]), ap[nt]); ap[nt] = MFMA16(pa1, TR_PK(vl[nt][1], vh[nt][1]), ap[nt]); }
#pragma unroll
                for (int i = 0; i < 4; ++i) { const int tr = 16 * tt + 4 * (lane >> 4) + i; const float wit = __shfl(wi, tr), flt = __shfl(fl, tr);
                    const float den = __shfl(wit * aq[2][i] + ap[2][i], lane & 48);
                    const float inv = 1.f / fmaxf(fabsf(den), flt); float* hp = HM + ((size_t)dir * M0 + rowb + TOK(p0 + tr)) * 1024 + h * 128 + 32 * sl + (lane & 15);
                    hp[0] = (wit * aq[0][i] + ap[0][i]) * inv; hp[16] = (wit * aq[1][i] + ap[1][i]) * inv; }
            } else {
                s16x4 vl[3][2], vh[3][2], kl[2][2], kh[2][2];
#pragma unroll
                for (int nt = 0; nt < 3; ++nt)
#pragma unroll
                    for (int ks = 0; ks < 2; ++ks) tr_frag_issue(vl[nt][ks], vh[nt][ks], sV, LDV, 32 * ks, 16 * nt, lane);
#pragma unroll
                for (int x = 0; x < 2; ++x)
#pragma unroll
                    for (int ks = 0; ks < 2; ++ks) tr_frag_issue(kl[x][ks], kh[x][ks], sKw, LDK, 32 * ks, 16 * (2 * (wave - 4) + x), lane);
                asm volatile("s_waitcnt lgkmcnt(0)" ::: "memory"); __builtin_amdgcn_sched_barrier(0);
#pragma unroll
                for (int x = 0; x < 2; ++x)
#pragma unroll
                    for (int nt = 0; nt < 3; ++nt) { cT[x][nt] = cT[x][nt] * dec;
#pragma unroll
                        for (int ks = 0; ks < 2; ++ks) cT[x][nt] = MFMA16(TR_PK(vl[nt][ks], vh[nt][ks]), TR_PK(kl[x][ks], kh[x][ks]), cT[x][nt]);
#pragma unroll
                        for (int i = 0; i < 4; ++i) sCw[(16 * nt + 4 * (lane >> 4) + i) * LDK + 16 * (2 * (wave - 4) + x) + (lane & 15)] = (bf16)f2bf(cT[x][nt][i]); }
            }
        }
#undef PREFETCH
#undef TOK
    }
}
template <int MODE> struct EpiResid { static constexpr bool PERM = false, AFTER_DRAIN = false; Ctx C;
    __device__ __forceinline__ void operator()(const pg8::f32x4 (&acc)[2][2][4][2], const pg8::Unit& u, int wr, int wc, int fr, int fq) const {
        const int row0 = u.pm * 256 + wr * 64 + fr, col0 = u.pn * 256 + wc * 32 + 4 * fq; float* X = WSP(float, WS_X);
#pragma unroll
        for (int ai = 0; ai < 2; ++ai)
#pragma unroll
            for (int m = 0; m < 4; ++m) { const int r = row0 + ai * 128 + m * 16; int xr; const float* base; const float* gate;
                if (MODE == 0) { xr = r; base = in_row(C, r); gate = mod_row(C, 0, r) + 2 * D; }
                else { const int b = r / SEQ; xr = b * TT + LCTX + (r - b * SEQ); base = X + (size_t)xr * D; gate = WSP(const float, WS_MOD) + ((size_t)3 + b) * (6 * D) + 2 * D; }
#pragma unroll
                for (int bj = 0; bj < 2; ++bj)
#pragma unroll
                    for (int n = 0; n < 2; ++n) { const int c = col0 + bj * 128 + n * 16; const f32x4 bv = *(const f32x4*)(base + c), gv = *(const f32x4*)(gate + c);
                        *(f32x4*)(X + (size_t)xr * D + c) = bv + gv * acc[ai][bj][m][n]; } }
    } };
struct EpiSwiglu { static constexpr bool PERM = false, AFTER_DRAIN = false; bf16* act;
    __device__ __forceinline__ void operator()(const pg8::f32x4 (&acc)[2][2][4][2], const pg8::Unit& u, int wr, int wc, int fr, int fq) const {
        const int row0 = u.pm * 256 + wr * 64 + fr, col0 = (u.pn & 3) * 128 + wc * 32 + 4 * fq;
#pragma unroll
        for (int ai = 0; ai < 2; ++ai)
#pragma unroll
            for (int m = 0; m < 4; ++m) { bf16* rowp = act + (size_t)(row0 + ai * 128 + m * 16) * DE + col0;
#pragma unroll
                for (int n = 0; n < 2; ++n) { const f32x4 g = acc[ai][0][m][n], up = acc[ai][1][m][n]; v2u w; w.x = pg8::cvt_pk_bf16(siluf(g[0]) * up[0], siluf(g[1]) * up[1]); w.y = pg8::cvt_pk_bf16(siluf(g[2]) * up[2], siluf(g[3]) * up[3]);
                    *(v2u*)(rowp + n * 16) = w; } }
    } };
struct EpiBf16Mod { static constexpr bool PERM = true, AFTER_DRAIN = false; bf16* O; int ldc; int ntile_mask;
    __device__ __forceinline__ void operator()(const pg8::f32x4 (&acc)[2][2][4][2], const pg8::Unit& u, int wr, int wc, int fr, int fq) const {
        const int row0 = u.pm * 256 + wr * 64 + fr, col0 = (u.pn & ntile_mask) * 256 + wc * 32 + 8 * fq;
#pragma unroll
        for (int ai = 0; ai < 2; ++ai)
#pragma unroll
            for (int m = 0; m < 4; ++m) { bf16* rowp = O + (size_t)(row0 + ai * 128 + m * 16) * ldc + col0;
#pragma unroll
                for (int bj = 0; bj < 2; ++bj) { const f32x4 z4 = (f32x4){0.f, 0.f, 0.f, 0.f}; const f32x4 v0 = acc[ai][bj][m][0] + z4, v1 = acc[ai][bj][m][1] + z4;
                    v4u w; w.x = pg8::cvt_pk_bf16(v0[0], v0[1]); w.y = pg8::cvt_pk_bf16(v0[2], v0[3]); w.z = pg8::cvt_pk_bf16(v1[0], v1[1]); w.w = pg8::cvt_pk_bf16(v1[2], v1[3]);
                    *(v4u*)(rowp + bj * 128) = w; } }
    } };
constexpr int TBL_OFF = MISC_OFF + 1024, TBL_CNT = MISC_OFF + 1536, TBL_TEXP = MISC_OFF + 2048;
struct MoeOrder { const LAS int* sOff; const LAS int* sCnt; const LAS int* sTexp; const int* tokidx; int nunits, NT, G, c;
    __device__ __forceinline__ bool next(int i, pg8::Unit& u) const { const int L = i * G + c; if (L >= nunits) return false; const int mt = L / NT; u.pm = mt; u.pn = NT * sTexp[mt] + (L - mt * NT); return true; }
    __device__ __forceinline__ unsigned a_voff(const pg8::Unit& u, int half, int R, int K) const { const int e = u.pn / NT, r = (u.pm - (sOff[e] >> 8)) * 256 + 128 * half + R; int tok = r;
        if (e < NE) { const int last = sCnt[e] - 1; tok = tokidx[e * M0 + (r < last ? r : last)]; }
        return (unsigned)tok * (unsigned)(K * 2); }
    __device__ __forceinline__ void a_ready(const pg8::Unit&) const {}
    __device__ __forceinline__ void done(const pg8::Unit&) const {} };
template <int LAYER> __device__ __forceinline__ MoeOrder moe_tables(const Ctx& C, int NT) {
    constexpr int ntok = LAYER ? M1 : M0; LAS int* sOff = (LAS int*)(C.lds + TBL_OFF); LAS int* sCnt = (LAS int*)(C.lds + TBL_CNT); LAS int* sTexp = (LAS int*)(C.lds + TBL_TEXP);
    const unsigned* cnt = WSP(const unsigned, WS_CTL) + (LAYER ? CW_CNT1 : CW_CNT0); const int tid = threadIdx.x;
    __syncthreads();
    if (tid < 64) {
        const int c = (int)__hip_atomic_load(cnt + tid, __ATOMIC_RELAXED, __HIP_MEMORY_SCOPE_AGENT); const int pad = (c + 255) & ~255; int inc = pad;
#pragma unroll
        for (int o = 1; o < 64; o <<= 1) { const int x = __shfl_up(inc, o); if (tid >= o) inc += x; }
        sCnt[tid] = c; sOff[tid] = inc - pad;
        if (tid == 63) { sOff[NE] = inc; sCnt[NE] = ntok; sOff[NE + 1] = inc + ntok; } }
    __syncthreads();
    if (tid <= NE) for (int mt = sOff[tid] >> 8; mt < (sOff[tid + 1] >> 8); ++mt) sTexp[mt] = tid;
    __syncthreads();
    const int cx = (C.G % 8 == 0) ? (C.bid % 8) * (C.G / 8) + C.bid / 8 : C.bid;
    return MoeOrder{sOff, sCnt, sTexp, WSP(const int, WS_TOK), (sOff[NE + 1] >> 8) * NT, NT, C.G, cx};
}

template <int LAYER> __device__ __forceinline__ void p_norm2_route(const Ctx& C0) { const Ctx C = phase_ctx(C0);
    constexpr int ntok = LAYER ? M1 : M0; constexpr int IL = LAYER ? I_L1 : I_L0, RW = LAYER ? O_RW : E_RW;
    constexpr int LDH = D + 8;
    LAS bf16* sHh = (LAS bf16*)C.lds; LAS bf16* sHl = sHh + 8 * LDH;
    LAS float* sPart = (LAS float*)(sHl + 8 * LDH);
    const bf16* RWh = WSP(const bf16, WS_RWT) + (size_t)LAYER * 2 * NE * D; const bf16* RWl = RWh + (size_t)NE * D;
    LAS int* sHist = (LAS int*)(sPart + 8 * 8 * 64);
    LAS int* sBase = sHist + 64;
    LAS int* sSel = sBase + 64;
    constexpr int MAXIT = (ntok / 8 + 255) / 256 + 1;
    const float* X = WSP(const float, WS_X); bf16* H2 = WSP(bf16, WS_H2); unsigned* cnt = WSP(unsigned, WS_CTL) + (LAYER ? CW_CNT1 : CW_CNT0);
    int* TE = WSP(int, WS_ROUTE); int* TP = TE + M0 * TOPK; float* TW = (float*)(TP + M0 * TOPK);
    const float* rw = C.in[IL + RW]; const float* rb = C.in[IL + RW + 1]; const int lane = C.lane, wave = C.wave;
    if (C.tid < 64) sHist[C.tid] = 0;
    int slot = 0;
    for (int it = C.bid; it < ntok / 8; it += C.G, ++slot) { const int i = it * 8 + wave; int xr; if (LAYER) { const int b = i / SEQ; xr = b * TT + LCTX + (i - b * SEQ); } else xr = i;
        __syncthreads();
        { f32x4 v[8]; const float* x = X + (size_t)xr * D;
#pragma unroll
          for (int j = 0; j < 8; ++j) v[j] = *(const f32x4*)(x + 4 * lane + 256 * j);
          const float* md = mod_row(C, LAYER, xr); norm_mod_row(v, C.in[IL + N2], md + 3 * D, md + 4 * D, lane);
          store_row_bf16(H2 + (size_t)i * D, v, lane);
#pragma unroll
          for (int j = 0; j < 8; ++j) { const unsigned x0 = __float_as_uint(v[j].x), x1 = __float_as_uint(v[j].y), x2 = __float_as_uint(v[j].z), x3 = __float_as_uint(v[j].w);
              const unsigned l0 = __float_as_uint(v[j].x - __uint_as_float(x0 & 0xffff0000u)), l1 = __float_as_uint(v[j].y - __uint_as_float(x1 & 0xffff0000u)), l2 = __float_as_uint(v[j].z - __uint_as_float(x2 & 0xffff0000u)), l3 = __float_as_uint(v[j].w - __uint_as_float(x3 & 0xffff0000u));
              *(LAS v2u*)(sHh + wave * LDH + 4 * lane + 256 * j) = (v2u){(x0 >> 16) | (x1 & 0xffff0000u), (x2 >> 16) | (x3 & 0xffff0000u)};
              *(LAS v2u*)(sHl + wave * LDH + 4 * lane + 256 * j) = (v2u){(l0 >> 16) | (l1 & 0xffff0000u), (l2 >> 16) | (l3 & 0xffff0000u)}; } }
        __syncthreads();
        {
          const int k0 = wave * 256; f32x4 acc[4] = {(f32x4){0.f, 0.f, 0.f, 0.f}, (f32x4){0.f, 0.f, 0.f, 0.f}, (f32x4){0.f, 0.f, 0.f, 0.f}, (f32x4){0.f, 0.f, 0.f, 0.f}};
          const LAS bf16* ah = sHh + (lane & 7) * LDH + k0 + 8 * (lane >> 4); const LAS bf16* al = sHl + (lane & 7) * LDH + k0 + 8 * (lane >> 4);
          const bf16* bh = RWh + (size_t)(lane & 15) * D + k0 + 8 * (lane >> 4); const bf16* bl = RWl + (size_t)(lane & 15) * D + k0 + 8 * (lane >> 4);
#pragma unroll 2
          for (int ks = 0; ks < 8; ++ks) { const bf16x8 Ah = *(const LAS bf16x8*)(ah + 32 * ks), Al = *(const LAS bf16x8*)(al + 32 * ks);
#pragma unroll
              for (int nt = 0; nt < 4; ++nt) { const bf16x8 Bh = *(const bf16x8*)(bh + (size_t)16 * nt * D + 32 * ks), Bl = *(const bf16x8*)(bl + (size_t)16 * nt * D + 32 * ks);
                  acc[nt] = MFMA16(Ah, Bh, acc[nt]); acc[nt] = MFMA16(Ah, Bl, acc[nt]); acc[nt] = MFMA16(Al, Bh, acc[nt]); } }
          if (lane < 32) {
#pragma unroll
              for (int nt = 0; nt < 4; ++nt)
#pragma unroll
                  for (int i = 0; i < 4; ++i) sPart[(wave * 8 + 4 * (lane >> 4) + i) * 64 + 16 * nt + (lane & 15)] = acc[nt][i]; } }
        __syncthreads();
        { float s = 0.f;
#pragma unroll
          for (int w = 0; w < 8; ++w) s += sPart[(w * 8 + wave) * 64 + lane];
          const float score = 1.f / (1.f + expf(-s)); const float sel = score + rb[lane];
          float m1 = sel, m2 = -3e38f;
#pragma unroll
          for (int o = 1; o < 8; o <<= 1) { const float a1 = __shfl_xor(m1, o), a2 = __shfl_xor(m2, o); const float hi = fmaxf(m1, a1), lo = fminf(m1, a1); m2 = fmaxf(lo, fmaxf(m2, a2)); m1 = hi; }
          const float gs = m1 + m2;
          int grank = 0; const int g = lane >> 3;
#pragma unroll
          for (int q = 0; q < 8; ++q) { const float og = __builtin_bit_cast(float, __builtin_amdgcn_readlane(__builtin_bit_cast(int, gs), q * 8)); grank += (og > gs || (og == gs && q < g)) ? 1 : 0; }
          const float cand = grank < 4 ? sel : -3e38f;
          int erank = 0;
#pragma unroll
          for (int q = 0; q < 64; ++q) { const float oc = __builtin_bit_cast(float, __builtin_amdgcn_readlane(__builtin_bit_cast(int, cand), q)); erank += (oc > cand || (oc == cand && q < lane)) ? 1 : 0; }
          const int myj = (grank < 4 && erank < TOPK) ? erank : -1;
          float wsum = wave_sum(myj >= 0 ? score : 0.f);
          if (myj >= 0) { const float wgt = score / wsum * 2.5f;
              if (slot < MAXIT) { const int lr = atomicAdd((int*)&sHist[lane], 1); LAS int* q = sSel + ((slot * 8 + wave) * TOPK + myj) * 3; q[0] = lane; q[1] = lr; q[2] = __float_as_int(wgt); }
              else { const unsigned pos = atomicAdd(&cnt[lane], 1u); TE[(size_t)i * TOPK + myj] = lane; TP[(size_t)i * TOPK + myj] = (int)pos; WSP(int, WS_TOK)[(size_t)lane * M0 + pos] = i; TW[(size_t)i * TOPK + myj] = wgt; } } }
    }
    __syncthreads();
    if (C.tid < 64) { const int h = sHist[C.tid]; sBase[C.tid] = h ? (int)atomicAdd(&cnt[C.tid], (unsigned)h) : 0; }
    __syncthreads();
    { const int nslot = slot < MAXIT ? slot : MAXIT;
      for (int x = C.tid; x < nslot * 8 * TOPK; x += NTHR) { const int sl = x / (8 * TOPK), w8 = (x / TOPK) % 8, j = x % TOPK; const int i = (C.bid + sl * C.G) * 8 + w8;
          const LAS int* q = sSel + x * 3; const int e = q[0], pos = sBase[e] + q[1];
          TE[(size_t)i * TOPK + j] = e; TP[(size_t)i * TOPK + j] = pos; WSP(int, WS_TOK)[(size_t)e * M0 + pos] = i; TW[(size_t)i * TOPK + j] = __int_as_float(q[2]); } }
}
template <int LAYER> __device__ __forceinline__ void p_moe_combine(const Ctx& C0) { const Ctx C = phase_ctx(C0);
    constexpr int ntok = LAYER ? M1 : M0;
    const MoeOrder T = moe_tables<LAYER>(C, 1);
    const int* TE = WSP(const int, WS_ROUTE); const int* TP = TE + M0 * TOPK; const float* TW = (const float*)(WSP(const int, WS_ROUTE) + 2 * M0 * TOPK);
    const bf16* Y = WSP(const bf16, WS_Y); const bf16* YS = Y + (size_t)T.sOff[NE] * D; float* X = WSP(float, WS_X);
    const int gw = C.bid * NWAVES + C.wave, NGW = C.G * NWAVES, lane = C.lane;
    for (int i = gw; i < ntok; i += NGW) { int xr; if (LAYER) { const int b = i / SEQ; xr = b * TT + LCTX + (i - b * SEQ); } else xr = i;
        f32x4 acc[8];
#pragma unroll
        for (int j = 0; j < 8; ++j) { const v2u a = *(const v2u*)(YS + (size_t)i * D + 4 * lane + 256 * j); acc[j] = (f32x4){bf2f(a.x & 0xffffu), bf2f(a.x >> 16), bf2f(a.y & 0xffffu), bf2f(a.y >> 16)}; }
#pragma unroll 2
        for (int s = 0; s < TOPK; ++s) { const float w = TW[(size_t)i * TOPK + s]; const bf16* yr = Y + (size_t)(T.sOff[TE[(size_t)i * TOPK + s]] + TP[(size_t)i * TOPK + s]) * D;
#pragma unroll
            for (int j = 0; j < 8; ++j) { const v2u a = *(const v2u*)(yr + 4 * lane + 256 * j); acc[j] += (f32x4){bf2f(a.x & 0xffffu), bf2f(a.x >> 16), bf2f(a.y & 0xffffu), bf2f(a.y >> 16)} * w; } }
        const float* gate = mod_row(C, LAYER, xr) + 5 * D; f32x4 v[8];
#pragma unroll
        for (int j = 0; j < 8; ++j) { const int c = 4 * lane + 256 * j; v[j] = *(const f32x4*)(X + (size_t)xr * D + c) + *(const f32x4*)(gate + c) * acc[j]; }
        if (LAYER) {
#pragma unroll
            for (int j = 0; j < 8; ++j) *(f32x4*)(C.out + (size_t)i * D + 4 * lane + 256 * j) = v[j]; }
        else {
#pragma unroll
            for (int j = 0; j < 8; ++j) *(f32x4*)(X + (size_t)xr * D + 4 * lane + 256 * j) = v[j];
            const float* md = mod_row(C, 1, xr); norm_mod_row(v, C.in[I_L1 + N1], md + 0 * D, md + 1 * D, lane); store_row_bf16(WSP(bf16, WS_HB) + (size_t)xr * D, v, lane); } }
}

__device__ __forceinline__ int slack_slots(int nunits, int G, int c) { const int maxr = (nunits + G - 1) / G, mine = nunits > c ? (nunits - c - 1) / G + 1 : 0; return maxr - mine; }
constexpr int NPHASE = 21;
struct Args { const float* in[43]; float* out; unsigned char* ws; int ph_lo, ph_hi, li, pad; };
__global__ void __launch_bounds__(NTHR, 2) fwd_kernel(Args args) {
    extern __shared__ __attribute__((aligned(16))) unsigned char lds_raw[];
    Ctx C; C.lds = (LAS unsigned char*)lds_raw; C.in = args.in; C.out = args.out; C.ws = args.ws;
    C.tid = threadIdx.x; C.lane = C.tid & 63; C.wave = __builtin_amdgcn_readfirstlane(C.tid >> 6); C.G = gridDim.x; C.bid = blockIdx.x;
    volatile LAS unsigned* MISC = (volatile LAS unsigned*)(C.lds + MISC_OFF);
    if (C.tid < 64) MISC[C.tid] = 0u;
    __syncthreads();
    const int lo = args.ph_lo, hi = args.ph_hi; const bool one = (hi - lo) > 1;
    XcdBarrier bar; bar.bar = WSP(unsigned, WS_CTL) + CW_BAR + args.li * XCD_BAR_WORDS; bar.x = 0; bar.st = nullptr;
    if (one) bar = xcd_barrier_post(WSP(unsigned, WS_CTL) + CW_BAR + args.li * XCD_BAR_WORDS, MISC + 8);
#ifndef PHASE_MASK
#define PHASE_MASK 0x1fffff
#endif
#define IN(k) (((PHASE_MASK >> (k)) & 1) && lo <= (k) && (k) < hi)
#define SEAM(k) do { if (IN(k) && IN((k) + 1)) xcd_barrier(bar); } while (0)
    LAS unsigned char* ring = C.lds;
#ifndef PROBE_REP0
#define PROBE_REP0 1
#endif
    if (IN(0)) { for (int rep = 0; rep < PROBE_REP0; ++rep) { p0_prologue(C); __syncthreads(); } } SEAM(0);
    if (IN(1)) { p_norm1_l0(C); } SEAM(1);
    if (IN(2)) { pg8::Gemm g{WSP(const bf16, WS_HB), WSP(const bf16, WS_WIN0), M0, NIN0P, D}; pg8::StaticOrder S; S.init(M0, NIN0P, C.G, C.bid);
        pg8::EpiBf16<0> E{WSP(bf16, WS_PROJ), NIN0P, nullptr, 0, 0}; pg8::gemm_phase<pg8::EpiBf16<0>, pg8::StaticOrder>(ring, g, S, E, nullptr);
        convert_chunks(C, 2 * slack_slots((M0 / 256) * (NIN0P / 256), C.G, C.bid)); } SEAM(2);
    if (IN(3)) { p_prep_l0(C); } SEAM(3);
    #ifndef PROBE_REP4
#define PROBE_REP4 1
#endif
    if (IN(4)) { for (int rep = 0; rep < PROBE_REP4; ++rep) { p_mlstm_l0(C); p_na_l0(C, rep); __syncthreads(); } } SEAM(4);
    if (IN(5)) { p_mlfin_l0(C); } SEAM(5);
    if (IN(6)) { pg8::Gemm g{WSP(const bf16, WS_AO), WSP(const bf16, WS_WOUT0), M0, D, D}; pg8::StaticOrder S; S.init(M0, D, C.G, C.bid);
        EpiResid<0> E{C}; pg8::gemm_phase<EpiResid<0>, pg8::StaticOrder>(ring, g, S, E, nullptr);
        convert_chunks(C, 2 * slack_slots((M0 / 256) * (D / 256), C.G, C.bid)); } SEAM(6);
    if (IN(7)) { p_norm2_route<0>(C); } SEAM(7);
    if (IN(9)) { const MoeOrder S = moe_tables<0>(C, 4); pg8::Gemm g{WSP(const bf16, WS_H2), WSP(const bf16, WS_W1T), M0, 65 * 1024, D}; EpiSwiglu E{WSP(bf16, WS_ACT)};
        pg8::gemm_phase_g<EpiSwiglu, MoeOrder>(ring, g, S, E, nullptr); convert_chunks(C, 2 * slack_slots(S.nunits, C.G, S.c)); } SEAM(9);
    if (IN(10)) { const MoeOrder S = moe_tables<0>(C, 8); pg8::Gemm g{WSP(const bf16, WS_ACT), WSP(const bf16, WS_W2T), RMAX + M0, 65 * 2048, DE}; EpiBf16Mod E{WSP(bf16, WS_Y), D, 7};
        pg8::gemm_phase<EpiBf16Mod, MoeOrder>(ring, g, S, E, nullptr); convert_chunks(C, slack_slots(S.nunits, C.G, S.c)); } SEAM(10);
    if (IN(11)) { p_moe_combine<0>(C); } SEAM(11);
    if (IN(12)) { pg8::Gemm g{WSP(const bf16, WS_HB), WSP(const bf16, WS_WIN1), M0, NIN1, D}; pg8::StaticOrder S; S.init(M0, NIN1, C.G, C.bid);
        pg8::EpiBf16<0> E{WSP(bf16, WS_PROJ), NIN1, nullptr, 0, 0}; pg8::gemm_phase<pg8::EpiBf16<0>, pg8::StaticOrder>(ring, g, S, E, nullptr);
        convert_chunks(C, 2 * slack_slots((M0 / 256) * (NIN1 / 256), C.G, C.bid)); } SEAM(12);
    if (IN(13)) { p_prep_l1(C); } SEAM(13);
    if (IN(14)) { p_da_l1(C); } SEAM(14);
    if (IN(15)) { pg8::Gemm g{WSP(const bf16, WS_AO), WSP(const bf16, WS_WOUT1), M1, D, D}; pg8::StaticOrder S; S.init(M1, D, C.G, C.bid);
        EpiResid<1> E{C}; pg8::gemm_phase<EpiResid<1>, pg8::StaticOrder>(ring, g, S, E, nullptr); } SEAM(15);
    if (IN(16)) { p_norm2_route<1>(C); convert_chunks(C, 1 << 30); } SEAM(16);
    if (IN(18)) { const MoeOrder S = moe_tables<1>(C, 4); pg8::Gemm g{WSP(const bf16, WS_H2), WSP(const bf16, WS_W1T) + (size_t)65 * 1024 * D, M1, 65 * 1024, D}; EpiSwiglu E{WSP(bf16, WS_ACT)};
        pg8::gemm_phase_g<EpiSwiglu, MoeOrder>(ring, g, S, E, nullptr); } SEAM(18);
    if (IN(19)) { const MoeOrder S = moe_tables<1>(C, 8); pg8::Gemm g{WSP(const bf16, WS_ACT), WSP(const bf16, WS_W2T) + (size_t)65 * D * DE, RMAX + M1, 65 * 2048, DE}; EpiBf16Mod E{WSP(bf16, WS_Y), D, 7};
        pg8::gemm_phase<EpiBf16Mod, MoeOrder>(ring, g, S, E, nullptr); } SEAM(19);
    if (IN(20)) { p_moe_combine<1>(C); }
#undef IN
#undef SEAM
}
#ifndef MK_ONE_LAUNCH
#define MK_ONE_LAUNCH 1
#endif
extern "C" void kernel_launch(void* const* d_in, const int* in_sizes, int n_in, void* d_out, int out_size, void* d_ws, size_t ws_size, hipStream_t stream) {
    static int grid = 0;
    if (grid == 0) {
        if (n_in != 43 || out_size != M1 * D || ws_size < WS_END) { fprintf(stderr, "kernel_launch: unexpected problem shape (n_in %d out %d ws %zu)\n", n_in, out_size, ws_size); grid = -1; return; }
        int dev = 0, cus = 0, per_cu = 0;
        if (hipGetDevice(&dev) != hipSuccess || hipDeviceGetAttribute(&cus, hipDeviceAttributeMultiprocessorCount, dev) != hipSuccess) { grid = -1; return; }
        if (hipFuncSetAttribute((const void*)fwd_kernel, hipFuncAttributeMaxDynamicSharedMemorySize, LDS_BYTES) != hipSuccess) { fprintf(stderr, "kernel_launch: hipFuncSetAttribute failed\n"); grid = -1; return; }
        if (hipOccupancyMaxActiveBlocksPerMultiprocessor(&per_cu, (const void*)fwd_kernel, NTHR, LDS_BYTES) != hipSuccess || per_cu < 1) { fprintf(stderr, "kernel_launch: occupancy query says %d workgroups per CU\n", per_cu); grid = -1; (void)hipGetLastError(); return; }
        grid = cus;
    }
    if (grid < 0) return;
    if (hipMemsetAsync((char*)d_ws + WS_CTL, 0, CTL_BYTES, stream) != hipSuccess) return;
    Args a{}; for (int i = 0; i < 43; ++i) a.in[i] = (const float*)d_in[i]; a.out = (float*)d_out; a.ws = (unsigned char*)d_ws;
#if defined(PROBE_LO)
    a.ph_lo = 0; a.ph_hi = PROBE_HI; a.li = 0; hipLaunchKernelGGL(fwd_kernel, dim3(grid), dim3(NTHR), LDS_BYTES, stream, a);
    a.ph_lo = PROBE_LO; a.ph_hi = NPHASE; a.li = 1; hipLaunchKernelGGL(fwd_kernel, dim3(grid), dim3(NTHR), LDS_BYTES, stream, a);
#elif MK_ONE_LAUNCH
    a.ph_lo = 0; a.ph_hi = NPHASE; hipLaunchKernelGGL(fwd_kernel, dim3(grid), dim3(NTHR), LDS_BYTES, stream, a);
#else
    for (int p = 0; p < NPHASE; ++p) { a.ph_lo = p; a.ph_hi = p + 1; hipLaunchKernelGGL(fwd_kernel, dim3(grid), dim3(NTHR), LDS_BYTES, stream, a); }
#endif
}
```

```cpp
#include <hip/hip_runtime.h>
#include <cstdio>
#include <cstdint>
namespace pg8 {
#define PG8_LAS __attribute__((address_space(3)))
typedef unsigned short bf16_t;
typedef short bf16x8 __attribute__((ext_vector_type(8)));
typedef float f32x4 __attribute__((ext_vector_type(4)));
typedef unsigned u32x4 __attribute__((ext_vector_type(4)));
constexpr int BM = 256, BK = 64, HALF = 128, HTB = HALF * BK * 2  , STAGE_BYTES = 8 * HTB, NXCD = 8, WGM = 8;

__host__ __device__ __forceinline__ int lds_byte(int r, int c) { const int st = (r >> 4) * 2 + (c >> 5), rr = r & 15, cc = c & 31, ob = rr * 64 + cc * 2; return st * 1024 + (ob ^ (((ob >> 9) & 1) << 5)); }
__host__ __device__ __forceinline__ void stage_rc(int b, int& R, int& C) { const int st = b / 1024, sb = b % 1024, swz = sb ^ (((sb >> 9) & 1) << 5); R = (st >> 1) * 16 + swz / 64; C = (st & 1) * 32 + (swz % 64) / 2; }
__host__ __device__ __forceinline__ int perm32(int rho) { const int n = rho >> 4, i = rho & 15; return 8 * (i >> 2) + 4 * n + (i & 3); }

struct Unit { int pm, pn; };
struct Gemm { const bf16_t* A; const bf16_t* Bt; int M, N, K; };

struct StaticOrder {
    int nM, nN, nwg, G, c;
    __host__ __device__ void init(int M, int N, int G_, int c_) { nM = M / BM; nN = N / BM; nwg = nM * nN; G = G_; c = c_; }
    __host__ __device__ bool next(int i, Unit& u) const {
        const long L = (long)i * G + c; if (L >= nwg) return false;
        int wgid = (int)L; { const int q = nwg / NXCD, r = nwg % NXCD, xcd = wgid % NXCD, off = wgid / NXCD; wgid = (xcd < r ? xcd * (q + 1) : r * (q + 1) + (xcd - r) * q) + off; }
        const int nig = WGM * nN, gid = wgid / nig, fm = gid * WGM, gsz = (nM - fm) < WGM ? (nM - fm) : WGM;
        u.pm = fm + ((wgid % nig) % gsz); u.pn = (wgid % nig) / gsz; return true;
    }
    __device__ __forceinline__ void a_ready(const Unit&) const {}
    __device__ __forceinline__ void done(const Unit&) const {}
};
struct CountedOrder : StaticOrder {
    const unsigned* ready; unsigned need; unsigned* tmo;
    __device__ __forceinline__ void a_ready(const Unit& u) const {
        if (threadIdx.x < 64) {
            const unsigned long long t0 = __builtin_amdgcn_s_memrealtime(); unsigned polls = 0;
            while ((unsigned)__builtin_amdgcn_readfirstlane(__hip_atomic_load(ready + 64 * u.pm, __ATOMIC_RELAXED, __HIP_MEMORY_SCOPE_AGENT)) < need) {
                if ((++polls & 255u) == 0u && __builtin_amdgcn_readfirstlane(__hip_atomic_load(tmo, __ATOMIC_RELAXED, __HIP_MEMORY_SCOPE_AGENT)) != 0u) break;
                if (__builtin_amdgcn_s_memrealtime() - t0 > 2000000ull) {
                    if (threadIdx.x == 0) { unsigned expect = 0u; __hip_atomic_compare_exchange_strong(tmo + 1, &expect, 0x600u | (unsigned)(u.pm & 0xff), __ATOMIC_RELAXED, __ATOMIC_RELAXED, __HIP_MEMORY_SCOPE_AGENT); __hip_atomic_store(tmo, 1u, __ATOMIC_RELAXED, __HIP_MEMORY_SCOPE_AGENT); }
                    break; }
                __builtin_amdgcn_s_sleep(2); }
            __builtin_amdgcn_fence(__ATOMIC_ACQUIRE, "agent");
            asm volatile("s_waitcnt vmcnt(0)" ::: "memory");
        }
#if !defined(BROKEN_HOOK_NO_BARRIER)
        asm volatile("" ::: "memory"); __builtin_amdgcn_s_barrier(); asm volatile("" ::: "memory");
#endif
    }
};

__device__ __forceinline__ unsigned cvt_pk_bf16(float lo, float hi) { unsigned r; asm volatile("v_cvt_pk_bf16_f32 %0, %1, %2" : "=v"(r) : "v"(lo), "v"(hi)); return r; }
typedef float f32x2 __attribute__((ext_vector_type(2)));
__device__ __forceinline__ f32x2 gelu_pk(f32x2 v) {
    const f32x2 av = __builtin_elementwise_abs(v), d = av * 0.2316418882f + 1.0f;
    f32x2 t; t.x = __builtin_amdgcn_rcpf(d.x); t.y = __builtin_amdgcn_rcpf(d.y);
    f32x2 q = t * 0.5307027145f + (-0.7265760135f); q = q * t + 0.7107068705f; q = q * t + (-0.142248368f); q = q * t + 0.127414796f; q = q * t;
    const f32x2 s = (v * v) * (-0.72134752044f);
    f32x2 e; e.x = __builtin_amdgcn_exp2f(s.x); e.y = __builtin_amdgcn_exp2f(s.y);
    const f32x2 m = v * (q * e), r = v - m;
    f32x2 o; o.x = v.x < 0.f ? m.x : r.x; o.y = v.y < 0.f ? m.y : r.y; return o;
}

struct EpiF32 {
    static constexpr bool PERM = false, AFTER_DRAIN = false;
    float* C; int ldc; const float* bias;
    __device__ __forceinline__ void operator()(const f32x4 (&acc)[2][2][4][2], const Unit& u, int wr, int wc, int fr, int fq) const {
        const int row0 = u.pm * BM + wr * 64 + fr, col0 = u.pn * BM + wc * 32 + 4 * fq;
        f32x4 bv[2][2];
#pragma unroll
        for (int bj = 0; bj < 2; ++bj)
#pragma unroll
            for (int n = 0; n < 2; ++n) bv[bj][n] = bias ? *(const f32x4*)(bias + col0 + bj * HALF + n * 16) : (f32x4){0.f, 0.f, 0.f, 0.f};
#pragma unroll
        for (int ai = 0; ai < 2; ++ai)
#pragma unroll
            for (int m = 0; m < 4; ++m) { float* rowp = C + (size_t)(row0 + ai * HALF + m * 16) * ldc + col0;
#pragma unroll
                for (int bj = 0; bj < 2; ++bj)
#pragma unroll
                    for (int n = 0; n < 2; ++n) *(f32x4*)(rowp + bj * HALF + n * 16) = acc[ai][bj][m][n] + bv[bj][n]; }
    }
};
template <int ACT  > struct EpiBf16 {
    static constexpr bool PERM = true, AFTER_DRAIN = false;
    bf16_t* O; int ldc; const float* bias; int split_cols; size_t split_stride;
    __device__ __forceinline__ void operator()(const f32x4 (&acc)[2][2][4][2], const Unit& u, int wr, int wc, int fr, int fq) const {
        const int row0 = u.pm * BM + wr * 64 + fr; int colt = u.pn * BM; bf16_t* base = O;
        if (split_cols) { const int t = colt / split_cols; base += (size_t)t * split_stride; colt -= t * split_cols; }
        const int col0 = colt + wc * 32 + 8 * fq, bcol0 = u.pn * BM + wc * 32 + 8 * fq;
        f32x4 bv[2][2];
#pragma unroll
        for (int bj = 0; bj < 2; ++bj)
#pragma unroll
            for (int n = 0; n < 2; ++n) bv[bj][n] = bias ? *(const f32x4*)(bias + bcol0 + bj * HALF + 4 * n) : (f32x4){0.f, 0.f, 0.f, 0.f};
#pragma unroll
        for (int ai = 0; ai < 2; ++ai)
#pragma unroll
            for (int m = 0; m < 4; ++m) { bf16_t* rowp = base + (size_t)(row0 + ai * HALF + m * 16) * ldc + col0;
#pragma unroll
                for (int bj = 0; bj < 2; ++bj) { f32x4 v0 = acc[ai][bj][m][0] + bv[bj][0], v1 = acc[ai][bj][m][1] + bv[bj][1];
                    if (ACT == 1) { f32x2 a = gelu_pk((f32x2){v0[0], v0[1]}), b = gelu_pk((f32x2){v0[2], v0[3]}), c = gelu_pk((f32x2){v1[0], v1[1]}), d = gelu_pk((f32x2){v1[2], v1[3]});
                        v0 = (f32x4){a.x, a.y, b.x, b.y}; v1 = (f32x4){c.x, c.y, d.x, d.y}; }
                    if (ACT == 2) {
#pragma unroll
                        for (int j = 0; j < 4; ++j) { v0[j] = 0.5f * v0[j] * (1.0f + erff(v0[j] * 0.70710678f)); v1[j] = 0.5f * v1[j] * (1.0f + erff(v1[j] * 0.70710678f)); } }
                    u32x4 w; w.x = cvt_pk_bf16(v0[0], v0[1]); w.y = cvt_pk_bf16(v0[2], v0[3]); w.z = cvt_pk_bf16(v1[0], v1[1]); w.w = cvt_pk_bf16(v1[2], v1[3]);
                    *(u32x4*)(rowp + bj * HALF) = w; } }
    }
};
template <class Epi, class Sched, bool STAMP = false>
__device__ __forceinline__ void gemm_phase(PG8_LAS unsigned char* lds, const Gemm g, const Sched& S, const Epi& E, unsigned long long* stamps) {
    const int tid = threadIdx.x, wid = __builtin_amdgcn_readfirstlane(tid >> 6), lane = tid & 63, wr = wid >> 2, wc = wid & 3, fr = lane & 15, fq = lane >> 4;
    const int K = g.K, nt = K / BK;
    int ts_lo = 0, ts_hi = 0, nts = 0; const unsigned long long rt_entry = STAMP ? (unsigned long long)wall_clock64() : 0ull;
#define PG8_STAMP() do { if (STAMP && wid == 0 && nts < 64) { const unsigned long long _c = (unsigned long long)clock64(); \
        ts_lo = (lane == nts) ? (int)(unsigned)_c : ts_lo; ts_hi = (lane == nts) ? (int)(unsigned)(_c >> 32) : ts_hi; ++nts; } } while (0)
    PG8_STAMP();
    unsigned voffA[2], voffB[2];
#pragma unroll
    for (int i = 0; i < 2; ++i) { int R, C; stage_rc(tid * 16 + i * 8192, R, C); const int Rb = Epi::PERM ? ((R & ~31) + perm32(R & 31)) : R;
        voffA[i] = (unsigned)(R * K + C) * 2u; voffB[i] = (unsigned)(Rb * K + C) * 2u; }
    const size_t kstep = (size_t)(BK * 2);
    const size_t hstep = (size_t)HALF * K * 2;
    const size_t tstep = 2 * hstep;
    const unsigned ldsw = (unsigned)wid * 1024u;
    const int aoff = lds_byte(wr * 64 + fr, fq * 8), boff = lds_byte(wc * 32 + fr, fq * 8);
#define PG8_SA(b, h) (((b) * 2 + (h)) * HTB)
#define PG8_SB(b, h) ((4 + (b) * 2 + (h)) * HTB)
#define PG8_STAGE(bufoff, gbase, voff) do { _Pragma("unroll") for (int _i = 0; _i < 2; ++_i) \
        __builtin_amdgcn_global_load_lds((const unsigned*)((const char*)(gbase) + (voff)[_i]), (PG8_LAS unsigned*)(lds + (bufoff) + ldsw + _i * 8192), 16, 0, 0); } while (0)
#define PG8_LDA(dst, b, h) do { _Pragma("unroll") for (int m = 0; m < 4; ++m) _Pragma("unroll") for (int k = 0; k < 2; ++k) dst[m][k] = *(const PG8_LAS bf16x8*)(lds + PG8_SA(b, h) + aoff + m * 2048 + k * 1024); } while (0)
#define PG8_LDB(dst, b, h) do { _Pragma("unroll") for (int n = 0; n < 2; ++n) _Pragma("unroll") for (int k = 0; k < 2; ++k) dst[n][k] = *(const PG8_LAS bf16x8*)(lds + PG8_SB(b, h) + boff + n * 2048 + k * 1024); } while (0)
#define PG8_MMA(ai, bj, At, Bt) do { __builtin_amdgcn_s_setprio(1); _Pragma("unroll") for (int m = 0; m < 4; ++m) _Pragma("unroll") for (int n = 0; n < 2; ++n) _Pragma("unroll") for (int k = 0; k < 2; ++k) \
        acc[ai][bj][m][n] = __builtin_amdgcn_mfma_f32_16x16x32_bf16(Bt[n][k], At[m][k], acc[ai][bj][m][n], 0, 0, 0); __builtin_amdgcn_s_setprio(0); } while (0)
#define PG8_WAIT_V(n) asm volatile("s_waitcnt vmcnt(" #n ")" ::: "memory")
#define PG8_WAIT_L(n) asm volatile("s_waitcnt lgkmcnt(" #n ")" ::: "memory")
#define PG8_BAR __builtin_amdgcn_s_barrier()
#define PG8_SCHED __builtin_amdgcn_sched_barrier(0)
    Unit cur, nxt; int ui = 0;
    if (!S.next(0, cur)) return;
    f32x4 acc[2][2][4][2];
#pragma unroll
    for (int a = 0; a < 2; ++a)
#pragma unroll
        for (int b = 0; b < 2; ++b)
#pragma unroll
            for (int m = 0; m < 4; ++m)
#pragma unroll
                for (int n = 0; n < 2; ++n) acc[a][b][m][n] = (f32x4){0.f, 0.f, 0.f, 0.f};
    bf16x8 At[4][2], B0[2][2], B1[2][2];
    const char* cA = (const char*)g.A + (size_t)cur.pm * tstep; const char* cB = (const char*)g.Bt + (size_t)cur.pn * tstep;
    S.a_ready(cur);
    PG8_STAGE(PG8_SB(0, 0), cB, voffB); PG8_STAGE(PG8_SA(0, 0), cA, voffA); PG8_STAGE(PG8_SB(0, 1), cB + hstep, voffB); PG8_STAGE(PG8_SA(0, 1), cA + hstep, voffA);
    if (wr == 1) PG8_BAR;
    PG8_WAIT_V(4); PG8_BAR;
    PG8_STAGE(PG8_SB(1, 0), cB + kstep, voffB); PG8_STAGE(PG8_SA(1, 0), cA + kstep, voffA); PG8_STAGE(PG8_SB(1, 1), cB + hstep + kstep, voffB);
    PG8_WAIT_V(6); PG8_BAR;
    PG8_STAMP();
    for (;;) {
        const bool has_next = S.next(ui + 1, nxt);
        const char* nA = has_next ? (const char*)g.A + (size_t)nxt.pm * tstep : cA; const char* nB = has_next ? (const char*)g.Bt + (size_t)nxt.pn * tstep : cB;
        for (int t = 0; t < nt; t += 2) {
            const bool last = (t == nt - 2);
            const char* a1 = cA + (size_t)(t + 1) * kstep;
            const char* a2 = last ? nA : cA + (size_t)(t + 2) * kstep; const char* b2 = last ? nB : cB + (size_t)(t + 2) * kstep;
            const char* a3 = a2 + kstep; const char* b3 = b2 + kstep;
            if (last && has_next) S.a_ready(nxt);
            PG8_LDB(B0, 0, 0); PG8_SCHED; PG8_LDA(At, 0, 0); PG8_STAGE(PG8_SA(1, 1), a1 + hstep, voffA);
            PG8_WAIT_L(8); PG8_BAR; PG8_WAIT_L(0); PG8_MMA(0, 0, At, B0); PG8_BAR; PG8_SCHED;
            PG8_LDB(B1, 0, 1); PG8_STAGE(PG8_SB(0, 0), b2, voffB);
            PG8_BAR; PG8_WAIT_L(0); PG8_MMA(0, 1, At, B1); PG8_BAR;
            PG8_LDA(At, 0, 1); PG8_STAGE(PG8_SA(0, 0), a2, voffA);
            PG8_BAR; PG8_WAIT_L(0); PG8_MMA(1, 0, At, B0); PG8_BAR; PG8_SCHED;
            PG8_STAGE(PG8_SB(0, 1), b2 + hstep, voffB);
            PG8_WAIT_V(6); PG8_BAR; PG8_MMA(1, 1, At, B1); PG8_BAR;
            PG8_LDB(B0, 1, 0); PG8_SCHED; PG8_LDA(At, 1, 0); PG8_STAGE(PG8_SA(0, 1), a2 + hstep, voffA);
            PG8_WAIT_L(8); PG8_BAR; PG8_WAIT_L(0); PG8_MMA(0, 0, At, B0); PG8_BAR; PG8_SCHED;
            PG8_LDB(B1, 1, 1); PG8_STAGE(PG8_SB(1, 0), b3, voffB);
            PG8_BAR; PG8_WAIT_L(0); PG8_MMA(0, 1, At, B1); PG8_BAR;
            PG8_LDA(At, 1, 1); PG8_STAGE(PG8_SA(1, 0), a3, voffA);
            PG8_BAR; PG8_WAIT_L(0); PG8_MMA(1, 0, At, B0); PG8_BAR; PG8_SCHED;
            PG8_STAGE(PG8_SB(1, 1), b3 + hstep, voffB);
            PG8_WAIT_V(6); PG8_BAR; PG8_MMA(1, 1, At, B1); PG8_BAR;
        }
        PG8_STAMP();
        if constexpr (!Epi::AFTER_DRAIN) { E(acc, cur, wr, wc, fr, fq); S.done(cur); }
        PG8_STAMP();
        if (!has_next) break;
#pragma unroll
        for (int a = 0; a < 2; ++a)
#pragma unroll
            for (int b = 0; b < 2; ++b)
#pragma unroll
                for (int m = 0; m < 4; ++m)
#pragma unroll
                    for (int n = 0; n < 2; ++n) acc[a][b][m][n] = (f32x4){0.f, 0.f, 0.f, 0.f};
        cur = nxt; cA = nA; cB = nB; ++ui;
    }
    PG8_WAIT_V(0);
    if (wr == 0) PG8_BAR;
    PG8_BAR;
    if constexpr (Epi::AFTER_DRAIN) { E.fused(acc, cur, wr, wc, fr, fq, lds, wid, lane); S.done(cur); }
    PG8_STAMP();
    if (STAMP && wid == 0) { stamps[lane] = lane < nts ? (((unsigned long long)(unsigned)ts_hi << 32) | (unsigned)ts_lo) : 0ull;
        if (lane == 62) stamps[62] = rt_entry; if (lane == 63) stamps[63] = (unsigned long long)wall_clock64(); }
#undef PG8_STAMP
#undef PG8_SA
#undef PG8_SB
#undef PG8_STAGE
#undef PG8_LDA
#undef PG8_LDB
#undef PG8_MMA
#undef PG8_WAIT_V
#undef PG8_WAIT_L
#undef PG8_BAR
#undef PG8_SCHED
}
template <class Epi, class Sched, bool STAMP = false>
__device__ __forceinline__ void gemm_phase_g(PG8_LAS unsigned char* lds, const Gemm g, const Sched& S, const Epi& E, unsigned long long* stamps) {
    const int tid = threadIdx.x, wid = __builtin_amdgcn_readfirstlane(tid >> 6), lane = tid & 63, wr = wid >> 2, wc = wid & 3, fr = lane & 15, fq = lane >> 4;
    const int K = g.K, nt = K / BK;
    int ts_lo = 0, ts_hi = 0, nts = 0; const unsigned long long rt_entry = STAMP ? (unsigned long long)wall_clock64() : 0ull;
#define PG8_STAMP() do { if (STAMP && wid == 0 && nts < 64) { const unsigned long long _c = (unsigned long long)clock64(); \
        ts_lo = (lane == nts) ? (int)(unsigned)_c : ts_lo; ts_hi = (lane == nts) ? (int)(unsigned)(_c >> 32) : ts_hi; ++nts; } } while (0)
    PG8_STAMP();
    unsigned voffB[2]; int RpA[2], CbA[2];
#pragma unroll
    for (int i = 0; i < 2; ++i) { int R, C; stage_rc(tid * 16 + i * 8192, R, C); const int Rb = Epi::PERM ? ((R & ~31) + perm32(R & 31)) : R;
        RpA[i] = R; CbA[i] = C * 2; voffB[i] = (unsigned)(Rb * K + C) * 2u; }
    const size_t kstep = (size_t)(BK * 2);
    const size_t hstep = (size_t)HALF * K * 2;
    const size_t tstep = 2 * hstep;
    const unsigned ldsw = (unsigned)wid * 1024u;
    const int aoff = lds_byte(wr * 64 + fr, fq * 8), boff = lds_byte(wc * 32 + fr, fq * 8);
#define PG8_SA(b, h) (((b) * 2 + (h)) * HTB)
#define PG8_SB(b, h) ((4 + (b) * 2 + (h)) * HTB)
#define PG8_STAGE(bufoff, gbase, voff) do { _Pragma("unroll") for (int _i = 0; _i < 2; ++_i) \
        __builtin_amdgcn_global_load_lds((const unsigned*)((const char*)(gbase) + (voff)[_i]), (PG8_LAS unsigned*)(lds + (bufoff) + ldsw + _i * 8192), 16, 0, 0); } while (0)
#define PG8_LDA(dst, b, h) do { _Pragma("unroll") for (int m = 0; m < 4; ++m) _Pragma("unroll") for (int k = 0; k < 2; ++k) dst[m][k] = *(const PG8_LAS bf16x8*)(lds + PG8_SA(b, h) + aoff + m * 2048 + k * 1024); } while (0)
#define PG8_LDB(dst, b, h) do { _Pragma("unroll") for (int n = 0; n < 2; ++n) _Pragma("unroll") for (int k = 0; k < 2; ++k) dst[n][k] = *(const PG8_LAS bf16x8*)(lds + PG8_SB(b, h) + boff + n * 2048 + k * 1024); } while (0)
#define PG8_MMA(ai, bj, At, Bt) do { __builtin_amdgcn_s_setprio(1); _Pragma("unroll") for (int m = 0; m < 4; ++m) _Pragma("unroll") for (int n = 0; n < 2; ++n) _Pragma("unroll") for (int k = 0; k < 2; ++k) \
        acc[ai][bj][m][n] = __builtin_amdgcn_mfma_f32_16x16x32_bf16(Bt[n][k], At[m][k], acc[ai][bj][m][n], 0, 0, 0); __builtin_amdgcn_s_setprio(0); } while (0)
#define PG8_WAIT_V(n) asm volatile("s_waitcnt vmcnt(" #n ")" ::: "memory")
#define PG8_WAIT_L(n) asm volatile("s_waitcnt lgkmcnt(" #n ")" ::: "memory")
#define PG8_BAR __builtin_amdgcn_s_barrier()
#define PG8_SCHED __builtin_amdgcn_sched_barrier(0)
    Unit cur, nxt; int ui = 0;
    if (!S.next(0, cur)) return;
    f32x4 acc[2][2][4][2];
#pragma unroll
    for (int a = 0; a < 2; ++a)
#pragma unroll
        for (int b = 0; b < 2; ++b)
#pragma unroll
            for (int m = 0; m < 4; ++m)
#pragma unroll
                for (int n = 0; n < 2; ++n) acc[a][b][m][n] = (f32x4){0.f, 0.f, 0.f, 0.f};
    bf16x8 At[4][2], B0[2][2], B1[2][2];
    const char* cA = (const char*)g.A; const char* cB = (const char*)g.Bt + (size_t)cur.pn * tstep;
    unsigned vA[2][2], vN[2][2];
#pragma unroll
    for (int h = 0; h < 2; ++h)
#pragma unroll
        for (int i = 0; i < 2; ++i) vA[h][i] = S.a_voff(cur, h, RpA[i], K) + (unsigned)CbA[i];
    S.a_ready(cur);
    PG8_STAGE(PG8_SB(0, 0), cB, voffB); PG8_STAGE(PG8_SA(0, 0), cA, vA[0]); PG8_STAGE(PG8_SB(0, 1), cB + hstep, voffB); PG8_STAGE(PG8_SA(0, 1), cA, vA[1]);
    if (wr == 1) PG8_BAR;
    PG8_WAIT_V(4); PG8_BAR;
    PG8_STAGE(PG8_SB(1, 0), cB + kstep, voffB); PG8_STAGE(PG8_SA(1, 0), cA + kstep, vA[0]); PG8_STAGE(PG8_SB(1, 1), cB + hstep + kstep, voffB);
    PG8_WAIT_V(6); PG8_BAR;
    PG8_STAMP();
    for (;;) {
        const bool has_next = S.next(ui + 1, nxt);
#pragma unroll
        for (int h = 0; h < 2; ++h)
#pragma unroll
            for (int i = 0; i < 2; ++i) vN[h][i] = has_next ? S.a_voff(nxt, h, RpA[i], K) + (unsigned)CbA[i] : vA[h][i];
        const char* nA = cA; const char* nB = has_next ? (const char*)g.Bt + (size_t)nxt.pn * tstep : cB;
        for (int t = 0; t < nt; t += 2) {
            const bool last = (t == nt - 2);
            const char* a1 = cA + (size_t)(t + 1) * kstep;
            const char* a2 = last ? nA : cA + (size_t)(t + 2) * kstep; const char* b2 = last ? nB : cB + (size_t)(t + 2) * kstep;
            const char* a3 = a2 + kstep; const char* b3 = b2 + kstep;
            if (last && has_next) S.a_ready(nxt);
            unsigned vX0[2], vX1[2];
#pragma unroll
            for (int i = 0; i < 2; ++i) { vX0[i] = last ? vN[0][i] : vA[0][i]; vX1[i] = last ? vN[1][i] : vA[1][i]; }
            PG8_LDB(B0, 0, 0); PG8_SCHED; PG8_LDA(At, 0, 0); PG8_STAGE(PG8_SA(1, 1), a1, vA[1]);
            PG8_WAIT_L(8); PG8_BAR; PG8_WAIT_L(0); PG8_MMA(0, 0, At, B0); PG8_BAR; PG8_SCHED;
            PG8_LDB(B1, 0, 1); PG8_STAGE(PG8_SB(0, 0), b2, voffB);
            PG8_BAR; PG8_WAIT_L(0); PG8_MMA(0, 1, At, B1); PG8_BAR;
            PG8_LDA(At, 0, 1); PG8_STAGE(PG8_SA(0, 0), a2, vX0);
            PG8_BAR; PG8_WAIT_L(0); PG8_MMA(1, 0, At, B0); PG8_BAR; PG8_SCHED;
            PG8_STAGE(PG8_SB(0, 1), b2 + hstep, voffB);
            PG8_WAIT_V(6); PG8_BAR; PG8_MMA(1, 1, At, B1); PG8_BAR;
            PG8_LDB(B0, 1, 0); PG8_SCHED; PG8_LDA(At, 1, 0); PG8_STAGE(PG8_SA(0, 1), a2, vX1);
            PG8_WAIT_L(8); PG8_BAR; PG8_WAIT_L(0); PG8_MMA(0, 0, At, B0); PG8_BAR; PG8_SCHED;
            PG8_LDB(B1, 1, 1); PG8_STAGE(PG8_SB(1, 0), b3, voffB);
            PG8_BAR; PG8_WAIT_L(0); PG8_MMA(0, 1, At, B1); PG8_BAR;
            PG8_LDA(At, 1, 1); PG8_STAGE(PG8_SA(1, 0), a3, vX0);
            PG8_BAR; PG8_WAIT_L(0); PG8_MMA(1, 0, At, B0); PG8_BAR; PG8_SCHED;
            PG8_STAGE(PG8_SB(1, 1), b3 + hstep, voffB);
            PG8_WAIT_V(6); PG8_BAR; PG8_MMA(1, 1, At, B1); PG8_BAR;
        }
        PG8_STAMP();
        if constexpr (!Epi::AFTER_DRAIN) { E(acc, cur, wr, wc, fr, fq); S.done(cur); }
        PG8_STAMP();
        if (!has_next) break;
#pragma unroll
        for (int a = 0; a < 2; ++a)
#pragma unroll
            for (int b = 0; b < 2; ++b)
#pragma unroll
                for (int m = 0; m < 4; ++m)
#pragma unroll
                    for (int n = 0; n < 2; ++n) acc[a][b][m][n] = (f32x4){0.f, 0.f, 0.f, 0.f};
        cur = nxt; cA = nA; cB = nB; ++ui;
#pragma unroll
        for (int h = 0; h < 2; ++h)
#pragma unroll
            for (int i = 0; i < 2; ++i) vA[h][i] = vN[h][i];
    }
    PG8_WAIT_V(0);
    if (wr == 0) PG8_BAR;
    PG8_BAR;
    if constexpr (Epi::AFTER_DRAIN) { E.fused(acc, cur, wr, wc, fr, fq, lds, wid, lane); S.done(cur); }
    PG8_STAMP();
    if (STAMP && wid == 0) { stamps[lane] = lane < nts ? (((unsigned long long)(unsigned)ts_hi << 32) | (unsigned)ts_lo) : 0ull;
        if (lane == 62) stamps[62] = rt_entry; if (lane == 63) stamps[63] = (unsigned long long)wall_clock64(); }
#undef PG8_STAMP
#undef PG8_SA
#undef PG8_SB
#undef PG8_STAGE
#undef PG8_LDA
#undef PG8_LDB
#undef PG8_MMA
#undef PG8_WAIT_V
#undef PG8_WAIT_L
#undef PG8_BAR
#undef PG8_SCHED
}
}
#define GAS __attribute__((address_space(1)))
#define LAS __attribute__((address_space(3)))
typedef unsigned short bf16;
typedef unsigned v4u __attribute__((ext_vector_type(4)));
typedef unsigned v2u __attribute__((ext_vector_type(2)));
typedef float f32x4 __attribute__((ext_vector_type(4)));
typedef short bf16x8 __attribute__((ext_vector_type(8)));
#define LDS_WAIT() asm volatile("s_waitcnt lgkmcnt(0)" ::: "memory")
constexpr int NWAVES = 8, NTHR = 512;
constexpr int D = 2048, NB = 2, SEQ = 4096, LCTX = 256, TT = SEQ + LCTX  , M0 = NB * TT  , M1 = NB * SEQ  ;
constexpr int NIN0 = 7200, NIN0P = 7424, NIN1 = 6144, NE = 64, DE = 512, TOPK = 6, GW = 64, GROWS = 64;
constexpr int C_NAQ = 0, C_NAK = 1024, C_NAV = 2048, C_MLQK = 3072, C_MLV = 5120, C_MLO = 6144, C_MLG = 7168;
constexpr int RMAX = 68608;
constexpr float EPS = 1e-6f;
constexpr size_t MiB = 1u << 20;
constexpr size_t WS_CTL = 0, CTL_BYTES = 1 * MiB;
constexpr size_t WS_MOD = 1 * MiB;
constexpr size_t WS_ROPE = WS_MOD + 512 * 1024;
constexpr size_t WS_GATE = 4 * MiB;
constexpr size_t WS_ROUTE = 6 * MiB;
constexpr size_t WS_WIN0 = 8 * MiB, WS_WOUT0 = 37 * MiB, WS_WIN1 = 45 * MiB, WS_WOUT1 = 69 * MiB;
constexpr size_t WS_W1T = 77 * MiB;
constexpr size_t WS_W2T = WS_W1T + 520 * MiB;
constexpr size_t WS_X = WS_W2T + 260 * MiB;
constexpr size_t WS_HB = WS_X + 68 * MiB;
constexpr size_t WS_H2 = WS_HB + 34 * MiB;
constexpr size_t WS_MIX = WS_H2 + 34 * MiB;
constexpr size_t WS_PROJ = WS_MIX, WS_QK = WS_PROJ + 124 * MiB, WS_HM = WS_QK + 68 * MiB, WS_AO = WS_HM + 68 * MiB, WS_SA = WS_MIX;
constexpr size_t WS_ACT = WS_MIX + 294 * MiB;
constexpr size_t WS_ACTS = WS_ACT + 67 * MiB;
constexpr size_t WS_Y = WS_ACTS + 9 * MiB;
constexpr size_t WS_YS = WS_Y + 268 * MiB;
constexpr size_t WS_GS = WS_YS + 34 * MiB;
constexpr size_t WS_TOK = WS_GS + 7 * MiB;
constexpr size_t WS_END = WS_TOK + 3 * MiB;
static_assert(WS_END <= 1900 * MiB, "d_ws map must stay under the guaranteed workspace (sum of inputs = 1957 MiB)");
static_assert((size_t)RMAX * D * 2 <= 294 * MiB && (size_t)M0 * NIN0P * 2 <= 124 * MiB, "overlay sizes");
constexpr int CW_CNT0 = 64, CW_CNT1 = 192, CW_NAQ = 320, CW_CVQ = 512, CW_CVQ0 = 576, CW_BAR = 4096;
constexpr int RING_BYTES = 131072, MISC_OFF = RING_BYTES, LDS_BYTES = 147456;
__device__ __forceinline__ float bf2f(unsigned v) { return __uint_as_float(v << 16); }
__device__ __forceinline__ unsigned f2bf(float f) { unsigned u = __float_as_uint(f); return (u + 0x7fffu + ((u >> 16) & 1u)) >> 16; }
__device__ __forceinline__ unsigned pk2(float lo, float hi) { return f2bf(lo) | (f2bf(hi) << 16); }
__device__ __forceinline__ float wave_sum(float v) {
#pragma unroll
    for (int o = 1; o < 64; o <<= 1) v += __shfl_xor(v, o);
    return v; }
__device__ __forceinline__ float siluf(float x) { return x / (1.f + __expf(-x)); }
__device__ __forceinline__ float sigmf(float x) { return 1.f / (1.f + __expf(-x)); }
#define XB_TMO      128
#define XB_XCNT(j)  (256  + 64 * (j))
#define XB_XSUB(j)  (1280 + 64 * (j))
#define XB_XGEN(j)  (2304 + 64 * (j))
#define XB_TOP      3328
#define XB_TOPGEN   3392
#define XCD_BAR_WORDS 3456
#define XB_SPIN_CAP (1u << 18)
#define LAS __attribute__((address_space(3)))

__device__ __forceinline__ unsigned xb_ld(unsigned* p)              { return __hip_atomic_load(p, __ATOMIC_RELAXED, __HIP_MEMORY_SCOPE_AGENT); }
__device__ __forceinline__ unsigned xb_add(unsigned* p, unsigned v) { return __hip_atomic_fetch_add(p, v, __ATOMIC_RELAXED, __HIP_MEMORY_SCOPE_AGENT); }
__device__ __forceinline__ unsigned xb_xcc_id() { return (unsigned)__builtin_amdgcn_s_getreg((3 << 11) | 20) & 0xFu; }
#define XB_SPIN(cond, bar) do { unsigned _sp = 0; while (cond) { __builtin_amdgcn_s_sleep(1); \
    if ((++_sp & 255u) == 0u) { if (xb_ld(&(bar)[XB_TMO])) break; if (_sp > XB_SPIN_CAP) { atomicAdd(&(bar)[XB_TMO], 1u); break; } } } } while (0)

struct XcdBarrier {
    unsigned* bar; unsigned x;
    volatile LAS unsigned* st;
};

__device__ __forceinline__ XcdBarrier xcd_barrier_post(unsigned* bar, volatile LAS unsigned* st) {
    XcdBarrier b; b.bar = bar; b.x = xb_xcc_id(); b.st = st;
    if (threadIdx.x == 0) (void)xb_add(&bar[XB_XCNT(b.x)], 1u);
    return b;
}
__device__ __forceinline__ void xcd_barrier_complete(unsigned* bar, unsigned x, unsigned& nloc, unsigned& nx) {
    const unsigned G = gridDim.x * gridDim.y * gridDim.z;
    unsigned sum, cnt, mine, sp = 0u;
    for (;;) {
        sum = 0u; cnt = 0u; mine = 0u;
#pragma unroll
        for (unsigned j = 0; j < 16; ++j) { const unsigned c = xb_ld(&bar[XB_XCNT(j)]); sum += c; cnt += (c > 0u) ? 1u : 0u; mine = (j == x) ? c : mine; }
        if (sum == G) break;
        __builtin_amdgcn_s_sleep(1);
        if ((++sp & 255u) == 0u) { if (xb_ld(&bar[XB_TMO])) break; if (sp > XB_SPIN_CAP) { atomicAdd(&bar[XB_TMO], 1u); break; } }
    }
    nloc = mine > 0u ? mine : 1u; nx = cnt > 0u ? cnt : 1u;
}

__device__ __forceinline__ void xcd_barrier(const XcdBarrier& b) {
    asm volatile("s_waitcnt vmcnt(0)" ::: "memory");
    __syncthreads();
    if (threadIdx.x == 0) {
        unsigned* bar = b.bar;
        __builtin_amdgcn_s_waitcnt(0);
        unsigned nloc = b.st[0], nx = b.st[1];
        if (nloc == 0u) { xcd_barrier_complete(bar, b.x, nloc, nx); b.st[0] = nloc; b.st[1] = nx; }
        const unsigned old = xb_add(&bar[XB_XSUB(b.x)], 1u);
        const unsigned gen = old / nloc;
        if (old + 1u == (gen + 1u) * nloc) {
            __builtin_amdgcn_fence(__ATOMIC_RELEASE, "agent");
            asm volatile("s_waitcnt vmcnt(0)" ::: "memory");
            const unsigned og = xb_add(&bar[XB_TOP], 1u);
            const unsigned tg = og / nx;
            if (og + 1u == (tg + 1u) * nx) xb_add(&bar[XB_TOPGEN], 1u);
            else XB_SPIN(xb_ld(&bar[XB_TOPGEN]) == tg, bar);
            __builtin_amdgcn_fence(__ATOMIC_ACQUIRE, "agent");
            xb_add(&bar[XB_XGEN(b.x)], 1u);
            asm volatile("s_waitcnt vmcnt(0)" ::: "memory");
        } else {
            XB_SPIN(xb_ld(&bar[XB_XGEN(b.x)]) == gen, bar);
            __builtin_amdgcn_fence(__ATOMIC_ACQUIRE, "agent");
            asm volatile("s_waitcnt vmcnt(0)" ::: "memory");
        }
    }
    __syncthreads();
}

struct Ctx {
    LAS unsigned char* lds; const float* const* in; float* out; unsigned char* ws;
    int tid, lane, wave, G, bid;
};
#define WSP(T, off) ((T*)(C.ws + (off)))
__device__ __forceinline__ Ctx phase_ctx(const Ctx& C0) { Ctx C = C0; int t = threadIdx.x; asm volatile("" : "+v"(t)); C.tid = t; C.lane = t & 63; C.wave = __builtin_amdgcn_readfirstlane(t >> 6);
    return C; }
enum { I_X = 0, I_C = 1, I_CTX = 2, I_CCTX = 3, I_L0 = 4, I_L1 = 25 };
enum { A_W = 0, A_B = 1, N1 = 2, N2 = 3, W_IN = 4 };
enum { E_QN = 5, E_KN = 6, E_RPB = 7, E_CW = 8, E_CB = 9, E_GB = 10, E_HN = 11, E_WOUT = 12, E_RW = 13 };
enum { O_QN = 5, O_KN = 6, O_LAM = 7, O_SUB = 8, O_WOUT = 9, O_RW = 10 };
__device__ __forceinline__ const float* in_row(const Ctx& C, int r) { const int b = r / TT, t = r - b * TT;
    return t < LCTX ? C.in[I_CTX] + ((size_t)b * LCTX + t) * D : C.in[I_X] + ((size_t)b * SEQ + (t - LCTX)) * D; }
__device__ __forceinline__ const float* mod_row(const Ctx& C, int layer, int r) { const int b = r / TT, t = r - b * TT;
    return WSP(const float, WS_MOD) + ((size_t)layer * 3 + (t < LCTX ? 2 : b)) * (6 * D); }

struct TItem { const float* W; bf16* WT; int N, K, k0, n0, drow; };
__device__ __forceinline__ void titem_load(f32x4 (&v)[8], const TItem& it, int lane) {
#pragma unroll
    for (int i = 0; i < 8; ++i) v[i] = __builtin_nontemporal_load((const f32x4*)(it.W + (size_t)(it.k0 + 8 * i + (lane >> 3)) * it.N + it.n0 + 4 * (lane & 7)));
}
__device__ __forceinline__ void titem_to_lds(const f32x4 (&v)[8], LAS float* scr, int lane) {
#pragma unroll
    for (int i = 0; i < 8; ++i) { LAS float* p = scr + (8 * i + (lane >> 3)) * 33 + 4 * (lane & 7); p[0] = v[i].x; p[1] = v[i].y; p[2] = v[i].z; p[3] = v[i].w; }
    LDS_WAIT(); asm volatile("" ::: "memory");
}
__device__ __forceinline__ void titem_store(const TItem& it, LAS float* scr, int lane) {
    const int c = lane & 7;
#pragma unroll
    for (int j = 0; j < 4; ++j) { const int n = (lane >> 3) + 8 * j; const LAS float* s = scr + (8 * c) * 33 + n;
        v4u o; o.x = pg8::cvt_pk_bf16(s[0 * 33], s[1 * 33]); o.y = pg8::cvt_pk_bf16(s[2 * 33], s[3 * 33]); o.z = pg8::cvt_pk_bf16(s[4 * 33], s[5 * 33]); o.w = pg8::cvt_pk_bf16(s[6 * 33], s[7 * 33]);
        *(v4u*)(it.WT + (size_t)(it.drow + n) * it.K + it.k0 + 8 * c) = o; }
    LDS_WAIT(); asm volatile("" ::: "memory");
}
constexpr int I_IN0 = 32 * (NIN0 / 32), I_OUT = 32 * 64, I_IN1 = 32 * (NIN1 / 32), I_GU = 32 * 16  , I_DN = 8 * 64;
constexpr int PER_L = 65 * (2 * I_GU + I_DN), NIT_EARLY = I_IN0 + I_OUT + I_IN1 + I_OUT + PER_L, NIT_ALL = NIT_EARLY + PER_L;
constexpr int CV_CHUNK = 32, CV_NCHUNK = PER_L / CV_CHUNK;
static_assert(PER_L % CV_CHUNK == 0, "chunking");
__device__ __forceinline__ TItem item_desc(const Ctx& C, int it) { TItem d; int r = it;
    if (r < I_IN0) { const int nb = NIN0 / 32; d = TItem{C.in[I_L0 + W_IN], WSP(bf16, WS_WIN0), NIN0, D, (r / nb) * 64, (r % nb) * 32, (r % nb) * 32}; return d; } r -= I_IN0;
    if (r < I_OUT) { d = TItem{C.in[I_L0 + E_WOUT], WSP(bf16, WS_WOUT0), D, D, (r / 64) * 64, (r % 64) * 32, (r % 64) * 32}; return d; } r -= I_OUT;
    if (r < I_IN1) { const int nb = NIN1 / 32; d = TItem{C.in[I_L1 + W_IN], WSP(bf16, WS_WIN1), NIN1, D, (r / nb) * 64, (r % nb) * 32, (r % nb) * 32}; return d; } r -= I_IN1;
    if (r < I_OUT) { d = TItem{C.in[I_L1 + O_WOUT], WSP(bf16, WS_WOUT1), D, D, (r / 64) * 64, (r % 64) * 32, (r % 64) * 32}; return d; } r -= I_OUT;
    const int layer = r / PER_L; r -= layer * PER_L; const int rb = (layer ? I_L1 + O_RW : I_L0 + E_RW);
    const int e = r / (2 * I_GU + I_DN); r -= e * (2 * I_GU + I_DN);
    if (r < 2 * I_GU) { const int sgu = r / I_GU, q = r % I_GU, n0 = (q % 16) * 32;
        d = TItem{e < NE ? C.in[rb + 2 + sgu] + (size_t)e * D * DE : C.in[rb + 5 + sgu], WSP(bf16, WS_W1T) + ((size_t)layer * 65 + e) * (1024 * (size_t)D), DE, D, (q / 16) * 64, n0, 256 * (n0 / 128) + 128 * sgu + (n0 % 128)}; return d; }
    r -= 2 * I_GU;
    d = TItem{e < NE ? C.in[rb + 4] + (size_t)e * DE * D : C.in[rb + 7], WSP(bf16, WS_W2T) + ((size_t)layer * 65 + e) * ((size_t)D * DE), D, DE, (r / 64) * 64, (r % 64) * 32, (r % 64) * 32}; return d; }
__device__ __forceinline__ void convert_items(const Ctx& C, int first, int last, int stride, LAS float* scr) {
    f32x4 va[8], vb[8]; int it = first; TItem cur{}; if (it < last) { cur = item_desc(C, it); titem_load(va, cur, C.lane); }
    while (it < last) { const int itn = it + stride; TItem nxt = cur; if (itn < last) { nxt = item_desc(C, itn); titem_load(vb, nxt, C.lane); }
        titem_to_lds(va, scr, C.lane); titem_store(cur, scr, C.lane); it = itn; cur = nxt;
#pragma unroll
        for (int i = 0; i < 8; ++i) va[i] = vb[i]; }
}
__device__ __forceinline__ void convert_queue(const Ctx& C0, int max_chunks, int qword, int item0, int nchunk) { const Ctx C = phase_ctx(C0);
    LAS int* sPop = (LAS int*)(C.lds + MISC_OFF + 512); LAS float* scr = (LAS float*)(C.lds + C.wave * 16384);
    if (max_chunks <= 0) return;
    unsigned* q = WSP(unsigned, WS_CTL) + qword;
    __syncthreads();
    if (C.tid == 0) sPop[0] = (int)atomicAdd(q, 1u);
    __syncthreads();
    int ch = sPop[0];
    for (int n = 0; n < max_chunks && ch < nchunk; ++n) {
        const bool more = n + 1 < max_chunks; unsigned nxt = 0u;
        if (C.tid == 0 && more) nxt = atomicAdd(q, 1u);
        const int base = item0 + ch * CV_CHUNK + C.wave * (CV_CHUNK / NWAVES); convert_items(C, base, base + CV_CHUNK / NWAVES, 1, scr);
        __syncthreads();
        if (C.tid == 0) sPop[0] = more ? (int)nxt : nchunk;
        __syncthreads();
        ch = sPop[0]; }
    __syncthreads();
}
__device__ __forceinline__ void p0_prologue(const Ctx& C0) { const Ctx C = phase_ctx(C0);
    LAS float* sv = (LAS float*)C.lds;
    LAS float* red = sv + 3 * D;
    for (int i = C.tid; i < 3 * D; i += NTHR) { const int r = i / D, k = i - r * D; const float v = r < 2 ? C.in[I_C][r * D + k] : C.in[I_CCTX][k]; sv[i] = v / (1.f + expf(-v)); }
    __syncthreads();
    for (int item = C.bid; item < 2 * 192; item += C.G) {
        const int layer = item / 192, c0 = (item % 192) * 64; const float* W = C.in[(layer ? I_L1 : I_L0) + A_W]; const float* bia = C.in[(layer ? I_L1 : I_L0) + A_B];
        const int cg = C.tid & 15, ks = C.tid >> 4; float acc[3][4] = {};
#pragma unroll 8
        for (int k = ks * 64; k < ks * 64 + 64; ++k) { const f32x4 w = __builtin_nontemporal_load((const f32x4*)(W + (size_t)k * (6 * D) + c0 + cg * 4));
#pragma unroll
            for (int r = 0; r < 3; ++r) { const float s = sv[r * D + k]; acc[r][0] += s * w.x; acc[r][1] += s * w.y; acc[r][2] += s * w.z; acc[r][3] += s * w.w; } }
#pragma unroll
        for (int r = 0; r < 3; ++r)
#pragma unroll
            for (int j = 0; j < 4; ++j) red[(ks * 3 + r) * 64 + cg * 4 + j] = acc[r][j];
        __syncthreads();
        if (C.tid < 192) { const int r = C.tid / 64, cc = C.tid % 64; float s = 0.f; for (int q = 0; q < 32; ++q) s += red[(q * 3 + r) * 64 + cc];
            WSP(float, WS_MOD)[((size_t)layer * 3 + r) * (6 * D) + c0 + cc] = s + bia[c0 + cc]; }
        __syncthreads();
    }
    for (int i = C.bid * NTHR + C.tid; i < SEQ * 64; i += C.G * NTHR) { const int t = i >> 6, f = i & 63; const float inv = powf(10000.f, -(float)(f & 31) / 32.f);
        const float ang = (float)(f < 32 ? t / GW : t % GW) * inv; WSP(float, WS_ROPE)[i] = cosf(ang); WSP(float, WS_ROPE)[SEQ * 64 + i] = sinf(ang); }
    LAS float* scr = (LAS float*)(C.lds + C.wave * 16384);
    const int gw = C.bid * NWAVES + C.wave, NGW = C.G * NWAVES;
    __syncthreads();
    static_assert(NIT_EARLY % CV_CHUNK == 0, "chunking");
    convert_queue(C, 1 << 30, CW_CVQ0, 0, NIT_EARLY / CV_CHUNK);
}

__device__ __forceinline__ void convert_chunks(const Ctx& C, int max_chunks) { convert_queue(C, max_chunks, CW_CVQ, NIT_EARLY, CV_NCHUNK); }

__device__ __forceinline__ void norm_mod_row(f32x4 (&v)[8], const float* gain, const float* shift, const float* scale, int lane) {
    float s = 0.f;
#pragma unroll
    for (int j = 0; j < 8; ++j) s += (v[j].x * v[j].x + v[j].y * v[j].y) + (v[j].z * v[j].z + v[j].w * v[j].w);
    const float r = 1.f / sqrtf(wave_sum(s) * (1.f / D) + EPS);
#pragma unroll
    for (int j = 0; j < 8; ++j) { const int c = 4 * lane + 256 * j; const f32x4 g = *(const f32x4*)(gain + c), sh = *(const f32x4*)(shift + c), sc = *(const f32x4*)(scale + c);
        v[j] = v[j] * r * g * (sc + 1.f) + sh; }
}
__device__ __forceinline__ void store_row_bf16(bf16* o, const f32x4 (&v)[8], int lane) {
#pragma unroll
    for (int j = 0; j < 8; ++j) { v2u w; w.x = pk2(v[j].x, v[j].y); w.y = pk2(v[j].z, v[j].w); *(v2u*)(o + 4 * lane + 256 * j) = w; }
}
__device__ __forceinline__ void p_norm1_l0(const Ctx& C0) { const Ctx C = phase_ctx(C0);
    const int gw = C.bid * NWAVES + C.wave, NGW = C.G * NWAVES;
    for (int r = gw; r < M0; r += NGW) { const float* x = in_row(C, r); f32x4 v[8];
#pragma unroll
        for (int j = 0; j < 8; ++j) v[j] = *(const f32x4*)(x + 4 * C.lane + 256 * j);
        const float* md = mod_row(C, 0, r); norm_mod_row(v, C.in[I_L0 + N1], md + 0 * D, md + 1 * D, C.lane);
        store_row_bf16(WSP(bf16, WS_HB) + (size_t)r * D, v, C.lane); }
}
__device__ __forceinline__ void p_prep_l0(const Ctx& C0) { const Ctx C = phase_ctx(C0);
    const int gw = C.bid * NWAVES + C.wave, NGW = C.G * NWAVES, lane = C.lane;
    const bf16* PB = WSP(const bf16, WS_PROJ); bf16* QN = WSP(bf16, WS_QK); bf16* KN = QN + (size_t)M0 * 1024; bf16* MQ = KN + (size_t)M0 * 1024; bf16* MK = MQ + (size_t)M0 * 1024;
    float* LI = WSP(float, WS_GATE); float* LF = LI + 2 * NB * 8 * TT;
    {
      const float* gqp = C.in[I_L0 + E_QN] + (16 * lane) % 128; const float* gkp = C.in[I_L0 + E_KN] + (16 * lane) % 128;
      const f32x4 gq0 = *(const f32x4*)(gqp), gq1 = *(const f32x4*)(gqp + 4), gq2 = *(const f32x4*)(gqp + 8), gq3 = *(const f32x4*)(gqp + 12);
      const f32x4 gk0 = *(const f32x4*)(gkp), gk1 = *(const f32x4*)(gkp + 4), gk2 = *(const f32x4*)(gkp + 8), gk3 = *(const f32x4*)(gkp + 12);
      const float gbias = C.in[I_L0 + E_GB][lane & 31];
      for (int r = gw; r < M0; r += NGW) { const int b = r / TT, t = r - b * TT; const bf16* pr = PB + (size_t)r * NIN0P;
        const v4u qa = *(const v4u*)(pr + C_NAQ + 16 * lane), qb = *(const v4u*)(pr + C_NAQ + 16 * lane + 8), ka = *(const v4u*)(pr + C_NAK + 16 * lane), kb = *(const v4u*)(pr + C_NAK + 16 * lane + 8);
        const float graw = bf2f(pr[C_MLG + (lane & 31)]);
#define HEADNORM(XA, XB, G0, G1, G2, G3, DST) do { const unsigned w_[8] = {XA.x, XA.y, XA.z, XA.w, XB.x, XB.y, XB.z, XB.w}; float f_[16]; float s_ = 0.f; \
            _Pragma("unroll") for (int i = 0; i < 8; ++i) { f_[2 * i] = bf2f(w_[i] & 0xffffu); f_[2 * i + 1] = bf2f(w_[i] >> 16); s_ += f_[2 * i] * f_[2 * i] + f_[2 * i + 1] * f_[2 * i + 1]; } \
            s_ += __shfl_xor(s_, 1); s_ += __shfl_xor(s_, 2); s_ += __shfl_xor(s_, 4); const float rr_ = 1.f / sqrtf(s_ * (1.f / 128.f) + EPS); \
            const v4u o0_ = (v4u){pk2(f_[0] * rr_ * G0.x, f_[1] * rr_ * G0.y), pk2(f_[2] * rr_ * G0.z, f_[3] * rr_ * G0.w), pk2(f_[4] * rr_ * G1.x, f_[5] * rr_ * G1.y), pk2(f_[6] * rr_ * G1.z, f_[7] * rr_ * G1.w)}; \
            const v4u o1_ = (v4u){pk2(f_[8] * rr_ * G2.x, f_[9] * rr_ * G2.y), pk2(f_[10] * rr_ * G2.z, f_[11] * rr_ * G2.w), pk2(f_[12] * rr_ * G3.x, f_[13] * rr_ * G3.y), pk2(f_[14] * rr_ * G3.z, f_[15] * rr_ * G3.w)}; \
            *(v4u*)(DST) = o0_; *(v4u*)((DST) + 8) = o1_; } while (0)
        HEADNORM(qa, qb, gq0, gq1, gq2, gq3, QN + (size_t)r * 1024 + 16 * lane);
        HEADNORM(ka, kb, gk0, gk1, gk2, gk3, KN + (size_t)r * 1024 + 16 * lane);
#undef HEADNORM
        if (lane < 32) { const float g = graw + gbias; const int dir = lane >> 4, isf = (lane >> 3) & 1, h = lane & 7;
            const size_t idx = (((size_t)dir * NB + b) * 8 + h) * TT + t;
            if (isf) LF[idx] = fminf(g, 0.f) - log1pf(expf(-fabsf(g))); else LI[idx] = g; } } }
    { const int sc = gw & 3, nblk = NGW >> 2, RB = (M0 + nblk - 1) / nblk, c0 = 512 * sc + 8 * lane; const float* cw = C.in[I_L0 + E_CW] + c0; const float* cb = C.in[I_L0 + E_CB] + c0;
      const f32x4 wa0 = *(const f32x4*)(cw), wb0 = *(const f32x4*)(cw + 4), wa1 = *(const f32x4*)(cw + 2048), wb1 = *(const f32x4*)(cw + 2048 + 4), wa2 = *(const f32x4*)(cw + 4096), wb2 = *(const f32x4*)(cw + 4096 + 4);
      const f32x4 wa3 = *(const f32x4*)(cw + 6144), wb3 = *(const f32x4*)(cw + 6144 + 4), wa4 = *(const f32x4*)(cw + 8192), wb4 = *(const f32x4*)(cw + 8192 + 4), ba = *(const f32x4*)(cb), bb = *(const f32x4*)(cb + 4);
      const float ksc = sc >= 2 ? 0.08838834764831845f : 1.f;
      const int r0 = (gw >> 2) * RB, r1 = (r0 + RB < M0) ? r0 + RB : M0;
      if (r0 < M0) {
#define LDROW(rr_) (*(const v4u*)(PB + (size_t)((rr_) < 0 ? 0 : ((rr_) >= M0 ? M0 - 1 : (rr_))) * NIN0P + C_MLQK + c0))
#define SEGID(rr_) (((rr_) < 0 || (rr_) >= M0) ? -1 : 2 * ((rr_) / TT) + (((rr_) % TT) >= LCTX ? 1 : 0))
        v4u x0 = LDROW(r0 - 2), x1 = LDROW(r0 - 1), x2 = LDROW(r0), x3 = LDROW(r0 + 1), x4 = LDROW(r0 + 2);
        int g0 = SEGID(r0 - 2), g1 = SEGID(r0 - 1), g2 = SEGID(r0), g3 = SEGID(r0 + 1), g4 = SEGID(r0 + 2);
        for (int r = r0; r < r1; ++r) { const v4u xn = LDROW(r + 3); const int gn = SEGID(r + 3);
            f32x4 aa = ba, ab = bb;
#define TAP(X, G, WA, WB) do { const unsigned m_ = (G == g2) ? 0xffffffffu : 0u; const unsigned x_ = X.x & m_, y_ = X.y & m_, z_ = X.z & m_, w_ = X.w & m_; \
                aa += WA * (f32x4){bf2f(x_ & 0xffffu), bf2f(x_ >> 16), bf2f(y_ & 0xffffu), bf2f(y_ >> 16)}; ab += WB * (f32x4){bf2f(z_ & 0xffffu), bf2f(z_ >> 16), bf2f(w_ & 0xffffu), bf2f(w_ >> 16)}; } while (0)
            TAP(x0, g0, wa0, wb0); TAP(x1, g1, wa1, wb1); TAP(x2, g2, wa2, wb2); TAP(x3, g3, wa3, wb3); TAP(x4, g4, wa4, wb4);
#undef TAP
            const v4u o = (v4u){pk2(siluf(aa.x) * ksc, siluf(aa.y) * ksc), pk2(siluf(aa.z) * ksc, siluf(aa.w) * ksc), pk2(siluf(ab.x) * ksc, siluf(ab.y) * ksc), pk2(siluf(ab.z) * ksc, siluf(ab.w) * ksc)};
            bf16* dst = (sc >= 2 ? MK + (size_t)r * 1024 + (c0 - 1024) : MQ + (size_t)r * 1024 + c0); *(v4u*)dst = o;
            x0 = x1; x1 = x2; x2 = x3; x3 = x4; x4 = xn; g0 = g1; g1 = g2; g2 = g3; g3 = g4; g4 = gn; }
#undef SEGID
#undef LDROW
      } }
}
__device__ __forceinline__ void p_mlfin_l0(const Ctx& C0) { const Ctx C = phase_ctx(C0);
    const int gw = C.bid * NWAVES + C.wave, NGW = C.G * NWAVES, lane = C.lane;
    const float* HM = WSP(const float, WS_HM); const bf16* PB = WSP(const bf16, WS_PROJ); bf16* AO = WSP(bf16, WS_AO);
    for (int r = gw; r < M0; r += NGW) { float f[16]; float s = 0.f;
#pragma unroll
        for (int q = 0; q < 4; ++q) { const f32x4 a = *(const f32x4*)(HM + (size_t)r * 1024 + 16 * lane + 4 * q), bq = *(const f32x4*)(HM + (size_t)(M0 + r) * 1024 + 16 * lane + 4 * q);
            f[4 * q] = a.x + bq.x; f[4 * q + 1] = a.y + bq.y; f[4 * q + 2] = a.z + bq.z; f[4 * q + 3] = a.w + bq.w; }
#pragma unroll
        for (int i = 0; i < 16; ++i) s += f[i] * f[i];
        s += __shfl_xor(s, 1); s += __shfl_xor(s, 2); s += __shfl_xor(s, 4);
        const float rr = 1.f / sqrtf(s * (1.f / 128.f) + EPS); const float* g = C.in[I_L0 + E_HN] + 16 * lane; const bf16* mo = PB + (size_t)r * NIN0P + C_MLO + 16 * lane; unsigned o[8];
#pragma unroll
        for (int i = 0; i < 8; ++i) o[i] = pk2(f[2 * i] * rr * g[2 * i] * sigmf(bf2f(mo[2 * i])), f[2 * i + 1] * rr * g[2 * i + 1] * sigmf(bf2f(mo[2 * i + 1])));
        bf16* dst = AO + (size_t)r * D + 1024 + 16 * lane; *(v4u*)dst = (v4u){o[0], o[1], o[2], o[3]}; *(v4u*)(dst + 8) = (v4u){o[4], o[5], o[6], o[7]}; }
}
__device__ __forceinline__ void p_prep_l1(const Ctx& C0) { const Ctx C = phase_ctx(C0);
    const int gw = C.bid * NWAVES + C.wave, NGW = C.G * NWAVES, lane = C.lane, grp = lane >> 2, dA = 16 * (lane & 3);
    const bf16* PB = WSP(const bf16, WS_PROJ); bf16* Q1 = WSP(bf16, WS_QK); bf16* K1 = Q1 + (size_t)32 * SEQ * 128;
    const float* rc = WSP(const float, WS_ROPE); const float* rs = rc + SEQ * 64;
    f32x4 gq[8], gk[8];
#pragma unroll
    for (int q = 0; q < 4; ++q) { gq[q] = *(const f32x4*)(C.in[I_L1 + O_QN] + dA + 4 * q); gq[4 + q] = *(const f32x4*)(C.in[I_L1 + O_QN] + 64 + dA + 4 * q);
                                  gk[q] = *(const f32x4*)(C.in[I_L1 + O_KN] + dA + 4 * q); gk[4 + q] = *(const f32x4*)(C.in[I_L1 + O_KN] + 64 + dA + 4 * q); }
    for (int r = gw; r < M0; r += NGW) { const int b = r / TT, t = r - b * TT; const bool lat = t >= LCTX; const int s = lat ? t - LCTX : 0;
        const bf16* src = PB + (size_t)r * NIN1 + grp * 128 + dA;
        v4u xq[4], xk[4]; f32x4 cs[4], sn[4];
#pragma unroll
        for (int q = 0; q < 2; ++q) { xk[q] = *(const v4u*)(src + 2048 + 8 * q); xk[2 + q] = *(const v4u*)(src + 2048 + 64 + 8 * q); xq[q] = *(const v4u*)(src + 8 * q); xq[2 + q] = *(const v4u*)(src + 64 + 8 * q); }
#pragma unroll
        for (int q = 0; q < 4; ++q) { cs[q] = *(const f32x4*)(rc + (size_t)s * 64 + dA + 4 * q); sn[q] = *(const f32x4*)(rs + (size_t)s * 64 + dA + 4 * q); }
#pragma unroll
        for (int qk = 0; qk < 2; ++qk) { if (qk == 0 && !lat) continue;
            float f[32]; float ss = 0.f;
#pragma unroll
            for (int q = 0; q < 4; ++q) { const v4u a = qk ? xk[q] : xq[q]; const unsigned w[4] = {a.x, a.y, a.z, a.w};
#pragma unroll
                for (int i = 0; i < 4; ++i) { f[8 * q + 2 * i] = bf2f(w[i] & 0xffffu); f[8 * q + 2 * i + 1] = bf2f(w[i] >> 16); } }
#pragma unroll
            for (int i = 0; i < 32; ++i) ss += f[i] * f[i];
            ss += __shfl_xor(ss, 1); ss += __shfl_xor(ss, 2);
            const float rr = 1.f / sqrtf(ss * (1.f / 128.f) + EPS);
#pragma unroll
            for (int i = 0; i < 32; ++i) f[i] = f[i] * rr * (qk ? gk[i >> 2][i & 3] : gq[i >> 2][i & 3]);
            if (lat) {
#pragma unroll
                for (int i = 0; i < 16; ++i) { const float c = cs[i >> 2][i & 3], sv = sn[i >> 2][i & 3], xa = f[i], xb = f[16 + i]; f[i] = xa * c - xb * sv; f[16 + i] = xb * c + xa * sv; } }
            bf16* dst = qk ? K1 + (((size_t)b * 16 + grp) * TT + t) * 128 + dA : Q1 + (((size_t)b * 16 + grp) * SEQ + s) * 128 + dA;
#pragma unroll
            for (int q = 0; q < 4; ++q) { unsigned ow[4];
#pragma unroll
                for (int i = 0; i < 4; ++i) ow[i] = pk2(f[8 * q + 2 * i], f[8 * q + 2 * i + 1]);
                *(v4u*)(dst + (q >> 1) * 64 + 8 * (q & 1)) = (v4u){ow[0], ow[1], ow[2], ow[3]}; } }
    }
}
namespace da {
typedef unsigned short bf16;
constexpr int D = 128, NW = 8, QBLK = 32, KVBLK = 64, SDEPTH = 2;
constexpr float SCALE = 0.088388347648318440f, THR = 8.f;
constexpr size_t SHM_V = KVBLK * D * 2, SHM_K = KVBLK * D * 2, SHM_ATTN = 2 * SHM_V + 2 * SHM_K + NW * 64 * 4;
using bf16x8 = __attribute__((ext_vector_type(8))) short;
using s16x4  = __attribute__((ext_vector_type(4))) short;
using f32x16 = __attribute__((ext_vector_type(16))) float;
using f32x8  = __attribute__((ext_vector_type(8))) float;
using u32x4  = __attribute__((ext_vector_type(4))) unsigned;
#define KSWZ(row, colB) ((row) * 256 + ((colB) ^ (((row) & 7) << 4)))
#define SBAR() __builtin_amdgcn_sched_barrier(0)
__device__ __forceinline__ int crow(int r, int hi) { return (r & 3) + 8 * (r >> 2) + 4 * hi; }
__device__ __forceinline__ unsigned cvtpk(float lo, float hi) {
  unsigned r; asm volatile("v_cvt_pk_bf16_f32 %0, %1, %2" : "=v"(r) : "v"(lo), "v"(hi)); return r;
}

__device__ __forceinline__ void partialSM(f32x16& p0, f32x16& p1, float& m_reg, float& mn, float& alpha) {
  constexpr float C = SCALE * 1.4426950408889634f;
  float pmax = p0[0]; for (int r = 1; r < 16; ++r) pmax = fmaxf(pmax, p0[r]); for (int r = 0; r < 16; ++r) pmax = fmaxf(pmax, p1[r]);
  { auto rr = __builtin_amdgcn_permlane32_swap(__float_as_uint(pmax), __float_as_uint(pmax), false, false);
    pmax = fmaxf(__uint_as_float(rr[0]), __uint_as_float(rr[1])); }
  if (__builtin_expect(__all(pmax - m_reg <= THR / SCALE), 1)) { mn = m_reg; alpha = 1.f; }
  else { mn = fmaxf(m_reg, pmax); alpha = __builtin_amdgcn_exp2f((m_reg - mn) * C); m_reg = mn; }
  float mnC = -mn * C;
  for (int r = 0; r < 16; ++r) p0[r] = fmaf(p0[r], C, mnC); for (int r = 0; r < 16; ++r) p1[r] = fmaf(p1[r], C, mnC);
  for (int r = 0; r < 16; ++r) p0[r] = __builtin_amdgcn_exp2f(p0[r]);
}
__device__ __forceinline__ void finishSM(f32x16& p0, f32x16& p1, float alpha, float& l_reg, bf16x8& pa0, bf16x8& pa1, bf16x8& pa2, bf16x8& pa3) {
  for (int r = 0; r < 16; ++r) p1[r] = __builtin_amdgcn_exp2f(p1[r]);
  float ps = 0; for (int r = 0; r < 16; ++r) ps += p0[r]; for (int r = 0; r < 16; ++r) ps += p1[r];
  { auto rr = __builtin_amdgcn_permlane32_swap(__float_as_uint(ps), __float_as_uint(ps), false, false);
    ps = __uint_as_float(rr[0]) + __uint_as_float(rr[1]); }
  l_reg = l_reg * alpha + ps;
#define PK4(P, BASE, OUT) do { unsigned a0 = cvtpk(P[BASE + 0], P[BASE + 1]), a1 = cvtpk(P[BASE + 2], P[BASE + 3]);   \
    unsigned b0 = cvtpk(P[BASE + 4], P[BASE + 5]), b1 = cvtpk(P[BASE + 6], P[BASE + 7]);                              \
    auto r0 = __builtin_amdgcn_permlane32_swap(a0, b0, false, false); auto r1 = __builtin_amdgcn_permlane32_swap(a1, b1, false, false); \
    u32x4 w = {r0[0], r1[0], r0[1], r1[1]}; OUT = *reinterpret_cast<bf16x8*>(&w); } while (0)
  PK4(p0, 0, pa0); PK4(p0, 8, pa1); PK4(p1, 0, pa2); PK4(p1, 8, pa3);
#undef PK4
}
__device__ __forceinline__ void qkt(f32x16& p0, f32x16& p1, const bf16* Ks, const bf16x8* qr, int r32, int hi) {
  p0 = f32x16{}; p1 = f32x16{};
  for (int d0 = 0; d0 < 8; ++d0) { int cb = (d0 * 16 + hi * 8) * 2;
    bf16x8 b0 = *reinterpret_cast<const bf16x8*>((const char*)Ks + KSWZ(r32, cb));
    bf16x8 b1 = *reinterpret_cast<const bf16x8*>((const char*)Ks + KSWZ(32 + r32, cb));
    p0 = __builtin_amdgcn_mfma_f32_32x32x16_bf16(b0, qr[d0], p0, 0, 0, 0);
    p1 = __builtin_amdgcn_mfma_f32_32x32x16_bf16(b1, qr[d0], p1, 0, 0, 0); }
}
__device__ __forceinline__ int v_st(int k, int c) { const int kk = (k & ~0xC) | ((k & 4) << 1) | ((k & 8) >> 1); return ((kk >> 3) * 4 + (c >> 5)) * 512 + ((kk & 7) * 32 + (c & 31)) * 2; }
__device__ __forceinline__ int v_rd_base(int lane) { return ((lane & 3) << 3) | (((lane >> 2) & 3) << 6) | (((lane >> 4) & 1) << 5) | (((lane >> 5) & 1) << 8); }
constexpr int v_rd_off(int d0, int ks, int half) { return d0 * 512 + ks * 4096 + half * 2048; }
template <int OFF> __device__ __forceinline__ s16x4 tr_read(int vb) {
  s16x4 r; asm volatile("ds_read_b64_tr_b16 %0, %1 offset:%2" : "=&v"(r) : "v"(vb), "i"(OFF) : "memory"); return r;
}
template <int D0> __device__ __forceinline__ void pv_one(f32x16& od, int vb, bf16x8 pa0, bf16x8 pa1, bf16x8 pa2, bf16x8 pa3) {
  const s16x4 l0 = tr_read<v_rd_off(D0, 0, 0)>(vb), h0 = tr_read<v_rd_off(D0, 0, 1)>(vb), l1 = tr_read<v_rd_off(D0, 1, 0)>(vb), h1 = tr_read<v_rd_off(D0, 1, 1)>(vb);
  const s16x4 l2 = tr_read<v_rd_off(D0, 2, 0)>(vb), h2 = tr_read<v_rd_off(D0, 2, 1)>(vb), l3 = tr_read<v_rd_off(D0, 3, 0)>(vb), h3 = tr_read<v_rd_off(D0, 3, 1)>(vb);
  asm volatile("s_waitcnt lgkmcnt(0)" ::: "memory"); SBAR();
#define PK(L, H) (bf16x8){L[0], L[1], L[2], L[3], H[0], H[1], H[2], H[3]}
  od = __builtin_amdgcn_mfma_f32_32x32x16_bf16(pa0, PK(l0, h0), od, 0, 0, 0);
  od = __builtin_amdgcn_mfma_f32_32x32x16_bf16(pa1, PK(l1, h1), od, 0, 0, 0);
  od = __builtin_amdgcn_mfma_f32_32x32x16_bf16(pa2, PK(l2, h2), od, 0, 0, 0);
  od = __builtin_amdgcn_mfma_f32_32x32x16_bf16(pa3, PK(l3, h3), od, 0, 0, 0);
#undef PK
}
__device__ __forceinline__ void pv_d0(f32x16* o, int vb, bf16x8 pa0, bf16x8 pa1, bf16x8 pa2, bf16x8 pa3) {
  pv_one<0>(o[0], vb, pa0, pa1, pa2, pa3); pv_one<1>(o[1], vb, pa0, pa1, pa2, pa3); pv_one<2>(o[2], vb, pa0, pa1, pa2, pa3); pv_one<3>(o[3], vb, pa0, pa1, pa2, pa3);
}

template <int LDQ, int LDK, int LDV, int LDO>
__device__ __forceinline__ void attn_dense_body(const bf16* __restrict__ Qb, const bf16* __restrict__ Kh, const bf16* __restrict__ Vh,
                                                int mode, float* Sw, const float* Sa, bf16* __restrict__ Ob, const float* __restrict__ gain, float lam, float post, int seq, char* lds) {
  int tz = threadIdx.x; asm volatile("" : "+v"(tz));
  const int tid = tz, wid = tid >> 6, lane = tid & 63, r32 = lane & 31, hi = lane >> 5;
  bf16* V_lds = (bf16*)lds; bf16* K_lds = (bf16*)(lds + 2 * SHM_V);
  float* ws = (float*)(lds + 2 * SHM_V + 2 * SHM_K) + wid * 64; float* li_l = ws; float* al_l = ws + 32;
  float m_reg = -1e30f, l_reg = 0; f32x16 o[4] = {}; bf16x8 qr[8];
  const bf16* Qw = Qb + (long)(wid * QBLK + r32) * LDQ + hi * 8;
#pragma unroll
  for (int d0 = 0; d0 < 8; ++d0) qr[d0] = *reinterpret_cast<const bf16x8*>(Qw + d0 * 16);
  const int sr = tid >> 4, sc = (tid & 15) * 8, vst0 = v_st(sr, sc), vst1 = v_st(32 + sr, sc);
  const int vb0 = (int)(uintptr_t)V_lds + v_rd_base(lane);
  struct { bf16x8 vs0, vs1, ks0, ks1; } sr_[SDEPTH];
#define SLOAD(i, k0) do { sr_[i].vs0 = *reinterpret_cast<const bf16x8*>(&Vh[(long)((k0) + sr) * LDV + sc]); sr_[i].vs1 = *reinterpret_cast<const bf16x8*>(&Vh[(long)((k0) + 32 + sr) * LDV + sc]); \
    sr_[i].ks0 = *reinterpret_cast<const bf16x8*>(&Kh[(long)((k0) + sr) * LDK + sc]); sr_[i].ks1 = *reinterpret_cast<const bf16x8*>(&Kh[(long)((k0) + 32 + sr) * LDK + sc]); } while (0)
#define SWRITE(b, i) do { *(bf16x8*)((char*)V_lds + (b) * SHM_V + vst0) = sr_[i].vs0;          \
    *(bf16x8*)((char*)V_lds + (b) * SHM_V + vst1) = sr_[i].vs1; int kc = sc * 2;               \
    *(bf16x8*)((char*)K_lds + (b) * SHM_K + KSWZ(sr, kc)) = sr_[i].ks0;                       \
    *(bf16x8*)((char*)K_lds + (b) * SHM_K + KSWZ(32 + sr, kc)) = sr_[i].ks1; } while (0)
#define SWAIT() do { if constexpr (SDEPTH == 2) asm volatile("s_waitcnt vmcnt(4)" ::: "memory"); else asm volatile("s_waitcnt vmcnt(0)" ::: "memory"); } while (0)
#define RESC(a) do { if (__any((a) < 1.f)) { if (hi == 0) al_l[r32] = (a); asm volatile("s_waitcnt lgkmcnt(0)" ::: "memory"); \
    for (int d = 0; d < 4; ++d) for (int r = 0; r < 16; ++r) o[d][r] *= al_l[crow(r, hi)]; } } while (0)
  f32x16 pA0, pA1, pB0, pB1; float mnA, mnB, alA, alB; bf16x8 pa0, pa1, pa2, pa3; const int NT = seq / KVBLK;
  constexpr int SE = 0, SO = SDEPTH - 1;
  SLOAD(SE, 0); asm volatile("s_waitcnt vmcnt(0)" ::: "memory"); SWRITE(0, SE); __syncthreads();
  qkt(pA0, pA1, K_lds, qr, r32, hi); partialSM(pA0, pA1, m_reg, mnA, alA);
  SLOAD(SO, KVBLK); if constexpr (SDEPTH == 2) { if (2 < NT) SLOAD(SE, 2 * KVBLK); }
  SWAIT(); SWRITE(1, SO); __syncthreads();
  for (int j = 1; j + 1 < NT; j += 2) {
    SBAR(); qkt(pB0, pB1, (bf16*)((char*)K_lds + SHM_K), qr, r32, hi);
    finishSM(pA0, pA1, alA, l_reg, pa0, pa1, pa2, pa3); SBAR();
    SLOAD(SO, (j + SDEPTH) * KVBLK); SBAR();
    pv_d0(o, vb0, pa0, pa1, pa2, pa3); partialSM(pB0, pB1, m_reg, mnB, alB);
    __syncthreads(); SWAIT(); SWRITE(0, SE);
    RESC(alB); __syncthreads();
    SBAR(); qkt(pA0, pA1, K_lds, qr, r32, hi);
    finishSM(pB0, pB1, alB, l_reg, pa0, pa1, pa2, pa3); SBAR();
    if (SDEPTH == 1 || j + 3 < NT) SLOAD(SE, (j + 1 + SDEPTH) * KVBLK); SBAR();
    pv_d0(o, vb0 + (int)SHM_V, pa0, pa1, pa2, pa3); partialSM(pA0, pA1, m_reg, mnA, alA);
    __syncthreads(); SWAIT(); SWRITE(1, SO);
    RESC(alA); __syncthreads();
  }
  SBAR(); qkt(pB0, pB1, (bf16*)((char*)K_lds + SHM_K), qr, r32, hi);
  finishSM(pA0, pA1, alA, l_reg, pa0, pa1, pa2, pa3); SBAR();
  pv_d0(o, vb0, pa0, pa1, pa2, pa3); partialSM(pB0, pB1, m_reg, mnB, alB);
  __syncthreads(); RESC(alB);
  finishSM(pB0, pB1, alB, l_reg, pa0, pa1, pa2, pa3); SBAR();
  pv_d0(o, vb0 + (int)SHM_V, pa0, pa1, pa2, pa3);
  if (hi == 0) li_l[r32] = l_reg; asm volatile("s_waitcnt lgkmcnt(0)" ::: "memory");
  float rli[16];
#pragma unroll
  for (int r = 0; r < 16; ++r) rli[r] = __builtin_amdgcn_rcpf(li_l[crow(r, hi)]);
  __syncthreads();
  { float* Ls = (float*)lds + wid * (QBLK * 128);
#pragma unroll
    for (int r = 0; r < 16; ++r) { const int orow = crow(r, hi);
#pragma unroll
      for (int d0 = 0; d0 < 4; ++d0) Ls[orow * 128 + d0 * 32 + r32] = o[d0][r] * rli[r]; }
    asm volatile("s_waitcnt lgkmcnt(0)" ::: "memory"); __builtin_amdgcn_wave_barrier();
    for (int r0 = 0; r0 < QBLK; r0 += 4) { float vx[4], vy[4];
      const long ob = (wid * QBLK + r0) * 128L + 2 * lane;
#pragma unroll
      for (int x = 0; x < 4; ++x) { vx[x] = Ls[(r0 + x) * 128 + 2 * lane]; vy[x] = Ls[(r0 + x) * 128 + 2 * lane + 1]; }
      if (mode == 0) {
#pragma unroll
        for (int x = 0; x < 4; ++x) { Sw[ob + 128 * x] = vx[x]; Sw[ob + 128 * x + 1] = vy[x]; } }
      else if (mode == 1) { float s0[4], s1[4];
#pragma unroll
        for (int x = 0; x < 4; ++x) { s0[x] = Sw[ob + 128 * x]; s1[x] = Sw[ob + 128 * x + 1]; }
#pragma unroll
        for (int x = 0; x < 4; ++x) { Sw[ob + 128 * x] = s0[x] - lam * vx[x]; Sw[ob + 128 * x + 1] = s1[x] - lam * vy[x]; } }
      else { float s0[4], s1[4], a0[4], a1[4], b0[4], b1[4], ss[4];
#pragma unroll
        for (int x = 0; x < 4; ++x) { s0[x] = Sw[ob + 128 * x]; s1[x] = Sw[ob + 128 * x + 1]; a0[x] = Sa[ob + 128 * x]; a1[x] = Sa[ob + 128 * x + 1]; }
#pragma unroll
        for (int x = 0; x < 4; ++x) { b0[x] = s0[x] - lam * vx[x]; b1[x] = s1[x] - lam * vy[x]; ss[x] = a0[x] * a0[x] + a1[x] * a1[x] + b0[x] * b0[x] + b1[x] * b1[x]; }
#pragma unroll
        for (int off = 1; off < 64; off <<= 1) {
#pragma unroll
          for (int x = 0; x < 4; ++x) ss[x] += __shfl_xor(ss[x], off); }
#pragma unroll
        for (int x = 0; x < 4; ++x) { const float rn = post / sqrtf(ss[x] * (1.f / 256.f) + 1e-6f); bf16* orp = Ob + (wid * QBLK + r0 + x) * (long)LDO + 2 * lane;
          *(unsigned*)orp = cvtpk(a0[x] * rn * gain[2 * lane], a1[x] * rn * gain[2 * lane + 1]); *(unsigned*)(orp + 128) = cvtpk(b0[x] * rn * gain[128 + 2 * lane], b1[x] * rn * gain[128 + 2 * lane + 1]); } } } }
#undef SLOAD
#undef SWRITE
#undef SWAIT
#undef RESC
}

#undef KSWZ
#undef SBAR
}
__device__ __forceinline__ bf16x8 ld_frag(const LAS bf16* base, int ld, int x0, int k0, int lane) { return *(const LAS bf16x8*)(base + (x0 + (lane & 15)) * ld + k0 + 8 * (lane >> 4)); }
#define MFMA16(a, b, c) __builtin_amdgcn_mfma_f32_16x16x32_bf16((a), (b), (c), 0, 0, 0)
__device__ __forceinline__ float grp16_max(float v) { v = fmaxf(v, __shfl_xor(v, 1)); v = fmaxf(v, __shfl_xor(v, 2)); v = fmaxf(v, __shfl_xor(v, 4)); v = fmaxf(v, __shfl_xor(v, 8)); return v; }
__device__ __forceinline__ float grp16_sum(float v) { v += __shfl_xor(v, 1); v += __shfl_xor(v, 2); v += __shfl_xor(v, 4); v += __shfl_xor(v, 8); return v; }
typedef short s16x4 __attribute__((ext_vector_type(4)));
__device__ __forceinline__ int lds_addr(const LAS void* p) { return (int)(unsigned)(unsigned long)p; }
__device__ __forceinline__ void tr_frag_issue(s16x4& lo, s16x4& hi, const LAS bf16* T, int ld, int k0, int n0, int lane) {
    const int g = lane >> 4, q = (lane >> 2) & 3, p = lane & 3; const int addr = lds_addr(T + (k0 + 8 * g + q) * ld + n0 + 4 * p);
    asm volatile("ds_read_b64_tr_b16 %0, %1" : "=&v"(lo) : "v"(addr) : "memory");
    asm volatile("ds_read_b64_tr_b16 %0, %1" : "=&v"(hi) : "v"(addr + 4 * ld * 2) : "memory");
}
#define TR_PK(L, H) (bf16x8){L[0], L[1], L[2], L[3], H[0], H[1], H[2], H[3]}
constexpr int LDK = 136, LDT = 72;
constexpr float NEG_BIG = -1e30f;

template <int DV> struct AttnState { f32x4 o[DV / 16]; float m[4], l[4];
    __device__ __forceinline__ void init() {
#pragma unroll
        for (int n = 0; n < DV / 16; ++n) o[n] = (f32x4){0.f, 0.f, 0.f, 0.f};
#pragma unroll
        for (int i = 0; i < 4; ++i) { m[i] = NEG_BIG; l[i] = 0.f; } } };
template <int DV, class Bias> __device__ __forceinline__ void attn_tile(AttnState<DV>& st, const bf16x8 (&qf)[4], const LAS bf16* sK, const LAS bf16* sV, LAS bf16* sP, float scale, const Bias& bias, int lane, int jlo, int jhi) {
    f32x4 s[4];
#pragma unroll
    for (int j = 0; j < 4; ++j) { s[j] = (f32x4){0.f, 0.f, 0.f, 0.f};
        if (j >= jlo && j < jhi) {
#pragma unroll
            for (int ks = 0; ks < 4; ++ks) s[j] = MFMA16(qf[ks], ld_frag(sK, LDK, 16 * j, 32 * ks, lane), s[j]); } }
    float alpha[4];
#pragma unroll
    for (int i = 0; i < 4; ++i) { float v[4]; bool ok[4]; float mx = NEG_BIG;
#pragma unroll
        for (int j = 0; j < 4; ++j) { ok[j] = false; v[j] = 0.f; if (j >= jlo && j < jhi) { const float bb = bias(i, j); ok[j] = bb > -1e29f; v[j] = s[j][i] * scale + bb; mx = ok[j] ? fmaxf(mx, v[j]) : mx; } }
        mx = grp16_max(mx); const float mn = fmaxf(st.m[i], mx); alpha[i] = __expf(st.m[i] - mn); st.m[i] = mn; float ps = 0.f;
#pragma unroll
        for (int j = 0; j < 4; ++j) { float p = 0.f; if (j >= jlo && j < jhi) p = ok[j] ? __expf(v[j] - mn) : 0.f; ps += p; sP[(4 * (lane >> 4) + i) * LDT + 16 * j + (lane & 15)] = (bf16)f2bf(p); }
        st.l[i] = st.l[i] * alpha[i] + ps; }
#pragma unroll
    for (int n = 0; n < DV / 16; ++n) { st.o[n][0] *= alpha[0]; st.o[n][1] *= alpha[1]; st.o[n][2] *= alpha[2]; st.o[n][3] *= alpha[3]; }
    LDS_WAIT(); __builtin_amdgcn_wave_barrier();
    const bf16x8 pa0 = ld_frag(sP, LDT, 0, 0, lane), pa1 = ld_frag(sP, LDT, 0, 32, lane);
#pragma unroll
    for (int half = 0; half < DV / 64; ++half) {
        s16x4 vl[4][2], vh[4][2];
#pragma unroll
        for (int n = 0; n < 4; ++n)
#pragma unroll
            for (int ks = 0; ks < 2; ++ks) tr_frag_issue(vl[n][ks], vh[n][ks], sV, LDK, 32 * ks, 16 * (4 * half + n), lane);
        asm volatile("s_waitcnt lgkmcnt(0)" ::: "memory"); __builtin_amdgcn_sched_barrier(0);
#pragma unroll
        for (int n = 0; n < 4; ++n) { if (jlo < 2) st.o[4 * half + n] = MFMA16(pa0, TR_PK(vl[n][0], vh[n][0]), st.o[4 * half + n]); if (jhi > 2) st.o[4 * half + n] = MFMA16(pa1, TR_PK(vl[n][1], vh[n][1]), st.o[4 * half + n]); }
        __builtin_amdgcn_sched_barrier(0); }
}
__device__ __forceinline__ void load_qfrag(bf16x8 (&qf)[4], const bf16* qrow0, size_t qld, int lane) {
#pragma unroll
    for (int ks = 0; ks < 4; ++ks) qf[ks] = *(const bf16x8*)(qrow0 + (size_t)(lane & 15) * qld + 32 * ks + 8 * (lane >> 4));
}
struct NoBias { __device__ __forceinline__ float operator()(int, int) const { return 0.f; } };

struct NaBias { const LAS float* rpb; int dr  , w0  ; int lane;
    __device__ __forceinline__ float operator()(int i, int j) const { const int w = w0 + i, col = 16 * j + (lane & 15); int c0 = w - 8; c0 = c0 < 0 ? 0 : (c0 > 48 ? 48 : c0);
        return (col >= c0 && col < c0 + 16) ? rpb[dr * 31 + (col - w + 15)] : NEG_BIG; } };
__device__ __forceinline__ void p_na_l0(const Ctx& C0, int qsel) { const Ctx C = phase_ctx(C0);
    LAS bf16* sK = (LAS bf16*)C.lds; LAS bf16* sV = sK + 64 * LDK; LAS bf16* sP = sV + 64 * LDK + C.wave * (16 * LDT); LAS float* sRpb = (LAS float*)(C.lds + 65536);
    const bf16* PB = WSP(const bf16, WS_PROJ); const bf16* QN = WSP(const bf16, WS_QK); const bf16* KN = QN + (size_t)M0 * 1024; bf16* AO = WSP(bf16, WS_AO);
    const float scale = 0.08838834764831845f; const int lane = C.lane, wave = C.wave;
    LAS int* sUnit = (LAS int*)(C.lds + 65536 + 2048);
    const int sj = C.tid >> 4, sq = C.tid & 15;
    unsigned* naq = WSP(unsigned, WS_CTL) + CW_NAQ + 64 * qsel;
    __syncthreads();
    if (C.tid == 0) sUnit[0] = (int)atomicAdd(naq, 1u);
    __syncthreads();
    int u = sUnit[0];
    while (u < 512 + 32) {
        unsigned nxtu = 0u; if (C.tid == 0) nxtu = atomicAdd(naq, 1u);
        const bool ctxq = u >= 512; const int v = ctxq ? u - 512 : u; const int b = ctxq ? v / 16 : v / 256, h = ctxq ? (v / 2) % 8 : (v / 32) % 8, rp = v % 32;
        const size_t rowb = (size_t)b * TT;
        int r = 0, q0; if (ctxq) q0 = 128 * (v & 1) + 16 * wave; else { r = 2 * rp + (wave >> 2); q0 = LCTX + r * 64 + 16 * (wave & 3); }
        bf16x8 qf[4]; load_qfrag(qf, QN + (rowb + q0) * 1024 + h * 128, 1024, lane);
        AttnState<128> st; st.init(); const int gq = wave & 3, jl = gq < 2 ? 0 : gq - 1, jh = gq > 1 ? 4 : gq + 2;
        int kr0 = r - 4; kr0 = kr0 < 0 ? 0 : (kr0 > 56 ? 56 : kr0);
        int lo = 2 * rp - 4; lo = lo < 0 ? 0 : (lo > 56 ? 56 : lo); int hi = 2 * rp + 1 - 4; hi = (hi < 0 ? 0 : (hi > 56 ? 56 : hi)) + 7;
        const int nloc = ctxq ? 0 : hi - lo + 1, ntile = nloc + 4;
        if (!ctxq) for (int i = C.tid; i < 15 * 31; i += NTHR) sRpb[i] = C.in[I_L0 + E_RPB][h * 465 + i];
#define NA_KROW(tl) (rowb + ((tl) < nloc ? LCTX + (lo + (tl)) * 64 : ((tl) - nloc) * 64))
#define NA_LOAD(tl) do { const size_t kr_ = NA_KROW(tl); const bf16* kp = KN + kr_ * 1024 + h * 128 + 8 * sq; const bf16* vp = PB + kr_ * NIN0P + C_NAV + h * 128 + 8 * sq; \
            pk0 = *(const v4u*)(kp + (size_t)sj * 1024); pk1 = *(const v4u*)(kp + (size_t)(32 + sj) * 1024); pv0 = *(const v4u*)(vp + (size_t)sj * NIN0P); pv1 = *(const v4u*)(vp + (size_t)(32 + sj) * NIN0P); } while (0)
        v4u pk0, pk1, pv0, pv1; NA_LOAD(0);
        for (int tl = 0; tl < ntile; ++tl) {
            const bool loc = tl < nloc; const int kr = lo + tl;
            int lz = lane; asm volatile("" : "+v"(lz));
            __syncthreads();
            *(LAS v4u*)(sK + sj * LDK + 8 * sq) = pk0; *(LAS v4u*)(sK + (32 + sj) * LDK + 8 * sq) = pk1; *(LAS v4u*)(sV + sj * LDK + 8 * sq) = pv0; *(LAS v4u*)(sV + (32 + sj) * LDK + 8 * sq) = pv1;
            if (tl + 1 < ntile) NA_LOAD(tl + 1);
            __syncthreads();
            if (loc) { if (kr >= kr0 && kr < kr0 + 8) { NaBias nb{sRpb, kr - r + 7, 16 * (wave & 3) + 4 * (lz >> 4), lz}; attn_tile<128>(st, qf, sK, sV, sP, scale, nb, lz, jl, jh); } }
            else attn_tile<128>(st, qf, sK, sV, sP, scale, NoBias(), lz, 0, 4);
        }
#undef NA_LOAD
#undef NA_KROW
#pragma unroll
        for (int i = 0; i < 4; ++i) { const float inv = 1.f / grp16_sum(st.l[i]); bf16* dst = AO + (rowb + q0 + 4 * (lane >> 4) + i) * D + h * 128 + (lane & 15);
#pragma unroll
            for (int n = 0; n < 8; ++n) dst[16 * n] = (bf16)f2bf(st.o[n][i] * inv); }
        __syncthreads();
        if (C.tid == 0) sUnit[0] = (int)nxtu;
        __syncthreads();
        u = sUnit[0];
    }
}
__device__ __forceinline__ void p_da_l1(const Ctx& C0) { const Ctx C = phase_ctx(C0);
    const bf16* PB = WSP(const bf16, WS_PROJ); const bf16* Q1 = WSP(const bf16, WS_QK); const bf16* K1 = Q1 + (size_t)32 * SEQ * 128; bf16* AO = WSP(bf16, WS_AO);
    float* S0 = WSP(float, WS_HM) + (size_t)C.bid * (2 * 256 * 128); float* S1 = S0 + 256 * 128;
    const float linit = 0.35550906759096926f;
    float lamf; { const float* lm = C.in[I_L1 + O_LAM]; float a = 0.f, bq = 0.f; for (int i = 0; i < 128; ++i) { a += lm[i] * lm[128 + i]; bq += lm[256 + i] * lm[384 + i]; } lamf = expf(a) - expf(bq) + linit; }
    for (int u = C.bid; u < 256; u += C.G) { const int b = u / 128, h = (u / 16) % 8, qb = u % 16;
        for (int call = 0; call < 4; ++call) { const int i = call & 1, vh = call >> 1, mode = call == 3 ? 2 : i; const size_t hi = (size_t)b * 16 + h * 2 + i;
            __syncthreads();
            da::attn_dense_body<128, 128, NIN1, D>(Q1 + (hi * SEQ + 256 * qb) * 128, K1 + hi * TT * 128, PB + (size_t)b * TT * NIN1 + 4096 + h * 256 + 128 * vh,
                mode, vh ? S1 : S0, S0, AO + ((size_t)b * SEQ + 256 * qb) * D + h * 256, C.in[I_L1 + O_SUB], lamf, 1.f - linit, TT, (char*)C.lds); } }
}
constexpr int LDV = 56;
__device__ __forceinline__ void p_mlstm_l0(const Ctx& C0) { const Ctx C = phase_ctx(C0);
    LAS bf16* sQ = (LAS bf16*)C.lds; LAS bf16* sK = sQ + 64 * LDK; LAS bf16* sKw = sK + 64 * LDK; LAS bf16* sV = sKw + 64 * LDK; LAS bf16* sP = sV + 64 * LDV; LAS bf16* sCt = sP + 64 * LDT;
    const bf16* PB = WSP(const bf16, WS_PROJ); const bf16* MQ = WSP(const bf16, WS_QK) + (size_t)2 * M0 * 1024; const bf16* MK = MQ + (size_t)M0 * 1024;
    const float* LI = WSP(const float, WS_GATE); const float* LF = LI + 2 * NB * 8 * TT; float* HM = WSP(float, WS_HM);
    const int lane = C.lane, wave = C.wave, tid = C.tid;
    for (int u = C.bid; u < 128; u += C.G) { const int sl = u & 3, dir = (u >> 2) & 1, h = (u >> 3) & 7, b = u >> 6; const size_t rowb = (size_t)b * TT;
        const float* li = LI + (((size_t)dir * NB + b) * 8 + h) * TT; const float* lf = LF + (((size_t)dir * NB + b) * 8 + h) * TT;
        f32x4 cT[2][3]; float m = 0.f;
#pragma unroll
        for (int x = 0; x < 2; ++x)
#pragma unroll
            for (int nt = 0; nt < 3; ++nt) cT[x][nt] = (f32x4){0.f, 0.f, 0.f, 0.f};
        __syncthreads();
        for (int i = tid; i < 48 * LDK; i += NTHR) sCt[i] = 0;
        for (int i = tid; i < 64 * 16; i += NTHR) sV[(i >> 4) * LDV + 32 + (i & 15)] = ((i & 15) == 0) ? (bf16)0x3F80 : (bf16)0;
#define TOK(p) (dir == 0 ? (p) : ((p) < LCTX ? LCTX - 1 - (p) : TT - 1 - ((p) - LCTX)))
        const int j0 = tid >> 4, cq = tid & 15, jv = tid >> 2, cv = tid & 3;
        float* GS = WSP(float, WS_GS) + (size_t)u * (3 * TT);
        for (int c2 = wave; c2 < TT / 64; c2 += NWAVES) { const int p = 64 * c2 + lane, t = TOK(p); float bc = lf[t]; const float fi = li[t];
#pragma unroll
            for (int o = 1; o < 64; o <<= 1) { const float x = __shfl_up(bc, o); if (lane >= o) bc += x; }
            const float a = fi - bc; float pm = a;
#pragma unroll
            for (int o = 1; o < 64; o <<= 1) { const float x = __shfl_up(pm, o); if (lane >= o) pm = fmaxf(pm, x); }
            GS[p] = a; GS[TT + p] = pm; GS[2 * TT + p] = bc; }
        asm volatile("s_waitcnt vmcnt(0)" ::: "memory"); __syncthreads();
        v4u pq0, pq1, pk0, pk1, pv = (v4u){0u, 0u, 0u, 0u}; float pa_, ppm_, pbc_;
#define PREFETCH(p0) do { const size_t r0 = rowb + TOK((p0) + j0), r1 = rowb + TOK((p0) + 32 + j0); \
            pq0 = *(const v4u*)(MQ + r0 * 1024 + h * 128 + 8 * cq); pq1 = *(const v4u*)(MQ + r1 * 1024 + h * 128 + 8 * cq); \
            pk0 = *(const v4u*)(MK + r0 * 1024 + h * 128 + 8 * cq); pk1 = *(const v4u*)(MK + r1 * 1024 + h * 128 + 8 * cq); \
            if (tid < 256) pv = *(const v4u*)(PB + (rowb + TOK((p0) + jv)) * NIN0P + C_MLV + h * 128 + 32 * sl + 8 * cv); \
            { const int p_ = (p0) + lane; pa_ = __hip_atomic_load(GS + p_, __ATOMIC_RELAXED, __HIP_MEMORY_SCOPE_AGENT); ppm_ = __hip_atomic_load(GS + TT + p_, __ATOMIC_RELAXED, __HIP_MEMORY_SCOPE_AGENT); pbc_ = __hip_atomic_load(GS + 2 * TT + p_, __ATOMIC_RELAXED, __HIP_MEMORY_SCOPE_AGENT); } } while (0)
        PREFETCH(0);
        for (int ch = 0; ch < TT / 64; ++ch) { const int p0 = 64 * ch;
            const float a = pa_, bc = pbc_, Mt = fmaxf(m, ppm_);
            const float M63 = __builtin_bit_cast(float, __builtin_amdgcn_readlane(__builtin_bit_cast(int, Mt), 63)), bl = __builtin_bit_cast(float, __builtin_amdgcn_readlane(__builtin_bit_cast(int, bc), 63));
            const float wi = __expf(m - Mt), fl = __expf(-bc - Mt), wg = __expf(a - M63), dec = __expf(m - M63); m = bl + M63;
            __syncthreads();
            { const float w0 = __shfl(wg, j0), w1 = __shfl(wg, 32 + j0);
              *(LAS v4u*)(sQ + j0 * LDK + 8 * cq) = pq0; *(LAS v4u*)(sQ + (32 + j0) * LDK + 8 * cq) = pq1; *(LAS v4u*)(sK + j0 * LDK + 8 * cq) = pk0; *(LAS v4u*)(sK + (32 + j0) * LDK + 8 * cq) = pk1;
              const unsigned x0[4] = {pk0.x, pk0.y, pk0.z, pk0.w}, x1[4] = {pk1.x, pk1.y, pk1.z, pk1.w}; unsigned y0[4], y1[4];
#pragma unroll
              for (int i = 0; i < 4; ++i) { y0[i] = pk2(bf2f(x0[i] & 0xffffu) * w0, bf2f(x0[i] >> 16) * w0); y1[i] = pk2(bf2f(x1[i] & 0xffffu) * w1, bf2f(x1[i] >> 16) * w1); }
              *(LAS v4u*)(sKw + j0 * LDK + 8 * cq) = (v4u){y0[0], y0[1], y0[2], y0[3]}; *(LAS v4u*)(sKw + (32 + j0) * LDK + 8 * cq) = (v4u){y1[0], y1[1], y1[2], y1[3]};
              if (tid < 256) *(LAS v4u*)(sV + jv * LDV + 8 * cv) = pv; }
            if (ch + 1 < TT / 64) PREFETCH(p0 + 64);
            __syncthreads();
#pragma unroll
            for (int q = 0; q < 2; ++q) { const int tt = wave >> 1, stl = 2 * (wave & 1) + q; f32x4 s = (f32x4){0.f, 0.f, 0.f, 0.f};
                if (stl <= tt) {
#pragma unroll
                    for (int ks = 0; ks < 4; ++ks) s = MFMA16(ld_frag(sQ, LDK, 16 * tt, 32 * ks, lane), ld_frag(sK, LDK, 16 * stl, 32 * ks, lane), s); }
                const int sc = 16 * stl + (lane & 15); const float as = __shfl(a, sc);
#pragma unroll
                for (int i = 0; i < 4; ++i) { const int tr = 16 * tt + 4 * (lane >> 4) + i; const float mtr = __shfl(Mt, tr); const float p = (sc <= tr) ? s[i] * __expf(as - mtr) : 0.f; sP[tr * LDT + sc] = (bf16)f2bf(p); } }
            __syncthreads();
            const LAS bf16* sCr = sCt + (ch & 1) * (48 * LDK); LAS bf16* sCw = sCt + ((ch + 1) & 1) * (48 * LDK);
            if (wave < 4) {
                const int tt = wave; s16x4 vl[3][2], vh[3][2];
#pragma unroll
                for (int nt = 0; nt < 3; ++nt)
#pragma unroll
                    for (int ks = 0; ks < 2; ++ks) tr_frag_issue(vl[nt][ks], vh[nt][ks], sV, LDV, 32 * ks, 16 * nt, lane);
                f32x4 aq[3], ap[3];
#pragma unroll
                for (int nt = 0; nt < 3; ++nt) { aq[nt] = (f32x4){0.f, 0.f, 0.f, 0.f};
#pragma unroll
                    for (int ks = 0; ks < 4; ++ks) aq[nt] = MFMA16(ld_frag(sQ, LDK, 16 * tt, 32 * ks, lane), ld_frag(sCr, LDK, 16 * nt, 32 * ks, lane), aq[nt]); }
                const bf16x8 pa0 = ld_frag(sP, LDT, 16 * tt, 0, lane), pa1 = ld_frag(sP, LDT, 16 * tt, 32, lane);
                asm volatile("s_waitcnt lgkmcnt(0)" ::: "memory"); __builtin_amdgcn_sched_barrier(0);
#pragma unroll
                for (int nt = 0; nt < 3; ++nt) { ap[nt] = (f32x4){0.f, 0.f, 0.f, 0.f}; ap[nt] = MFMA16(pa0, TR_PK(vl[nt][0], vh[nt][0]), ap[nt]); ap[nt] = MFMA16(pa1, TR_PK(vl[nt][1], vh[nt][1]), ap[nt]); }
#pragma unroll
                for (int i = 0; i < 4; ++i) { const int tr = 16 * tt + 4 * (lane >> 4) + i; const float wit = __shfl(wi, tr), flt = __shfl(fl, tr);
                    const float den = __shfl(wit * aq[2][i] + ap[2][i], lane & 48);
                    const float inv = 1.f / fmaxf(fabsf(den), flt); float* hp = HM + ((size_t)dir * M0 + rowb + TOK(p0 + tr)) * 1024 + h * 128 + 32 * sl + (lane & 15);
                    hp[0] = (wit * aq[0][i] + ap[0][i]) * inv; hp[16] = (wit * aq[1][i] + ap[1][i]) * inv; }
            } else {
                s16x4 vl[3][2], vh[3][2], kl[2][2], kh[2][2];
#pragma unroll
                for (int nt = 0; nt < 3; ++nt)
#pragma unroll
                    for (int ks = 0; ks < 2; ++ks) tr_frag_issue(vl[nt][ks], vh[nt][ks], sV, LDV, 32 * ks, 16 * nt, lane);
#pragma unroll
                for (int x = 0; x < 2; ++x)
#pragma unroll
                    for (int ks = 0; ks < 2; ++ks) tr_frag_issue(kl[x][ks], kh[x][ks], sKw, LDK, 32 * ks, 16 * (2 * (wave - 4) + x), lane);
                asm volatile("s_waitcnt lgkmcnt(0)" ::: "memory"); __builtin_amdgcn_sched_barrier(0);
#pragma unroll
                for (int x = 0; x < 2; ++x)
#pragma unroll
                    for (int nt = 0; nt < 3; ++nt) { cT[x][nt] = cT[x][nt] * dec;
#pragma unroll
                        for (int ks = 0; ks < 2; ++ks) cT[x][nt] = MFMA16(TR_PK(vl[nt][ks], vh[nt][ks]), TR_PK(kl[x][ks], kh[x][ks]), cT[x][nt]);
#pragma unroll
                        for (int i = 0; i < 4; ++i) sCw[(16 * nt + 4 * (lane >> 4) + i) * LDK + 16 * (2 * (wave - 4) + x) + (lane & 15)] = (bf16)f2bf(cT[x][nt][i]); }
            }
        }
#undef PREFETCH
#undef TOK
    }
}
template <int MODE> struct EpiResid { static constexpr bool PERM = false, AFTER_DRAIN = false; Ctx C;
    __device__ __forceinline__ void operator()(const pg8::f32x4 (&acc)[2][2][4][2], const pg8::Unit& u, int wr, int wc, int fr, int fq) const {
        const int row0 = u.pm * 256 + wr * 64 + fr, col0 = u.pn * 256 + wc * 32 + 4 * fq; float* X = WSP(float, WS_X);
#pragma unroll
        for (int ai = 0; ai < 2; ++ai)
#pragma unroll
            for (int m = 0; m < 4; ++m) { const int r = row0 + ai * 128 + m * 16; int xr; const float* base; const float* gate;
                if (MODE == 0) { xr = r; base = in_row(C, r); gate = mod_row(C, 0, r) + 2 * D; }
                else { const int b = r / SEQ; xr = b * TT + LCTX + (r - b * SEQ); base = X + (size_t)xr * D; gate = WSP(const float, WS_MOD) + ((size_t)3 + b) * (6 * D) + 2 * D; }
#pragma unroll
                for (int bj = 0; bj < 2; ++bj)
#pragma unroll
                    for (int n = 0; n < 2; ++n) { const int c = col0 + bj * 128 + n * 16; const f32x4 bv = *(const f32x4*)(base + c), gv = *(const f32x4*)(gate + c);
                        *(f32x4*)(X + (size_t)xr * D + c) = bv + gv * acc[ai][bj][m][n]; } }
    } };
struct EpiSwiglu { static constexpr bool PERM = false, AFTER_DRAIN = false; bf16* act;
    __device__ __forceinline__ void operator()(const pg8::f32x4 (&acc)[2][2][4][2], const pg8::Unit& u, int wr, int wc, int fr, int fq) const {
        const int row0 = u.pm * 256 + wr * 64 + fr, col0 = (u.pn & 3) * 128 + wc * 32 + 4 * fq;
#pragma unroll
        for (int ai = 0; ai < 2; ++ai)
#pragma unroll
            for (int m = 0; m < 4; ++m) { bf16* rowp = act + (size_t)(row0 + ai * 128 + m * 16) * DE + col0;
#pragma unroll
                for (int n = 0; n < 2; ++n) { const f32x4 g = acc[ai][0][m][n], up = acc[ai][1][m][n]; v2u w; w.x = pg8::cvt_pk_bf16(siluf(g[0]) * up[0], siluf(g[1]) * up[1]); w.y = pg8::cvt_pk_bf16(siluf(g[2]) * up[2], siluf(g[3]) * up[3]);
                    *(v2u*)(rowp + n * 16) = w; } }
    } };
struct EpiBf16Mod { static constexpr bool PERM = true, AFTER_DRAIN = false; bf16* O; int ldc; int ntile_mask;
    __device__ __forceinline__ void operator()(const pg8::f32x4 (&acc)[2][2][4][2], const pg8::Unit& u, int wr, int wc, int fr, int fq) const {
        const int row0 = u.pm * 256 + wr * 64 + fr, col0 = (u.pn & ntile_mask) * 256 + wc * 32 + 8 * fq;
#pragma unroll
        for (int ai = 0; ai < 2; ++ai)
#pragma unroll
            for (int m = 0; m < 4; ++m) { bf16* rowp = O + (size_t)(row0 + ai * 128 + m * 16) * ldc + col0;
#pragma unroll
                for (int bj = 0; bj < 2; ++bj) { const f32x4 z4 = (f32x4){0.f, 0.f, 0.f, 0.f}; const f32x4 v0 = acc[ai][bj][m][0] + z4, v1 = acc[ai][bj][m][1] + z4;
                    v4u w; w.x = pg8::cvt_pk_bf16(v0[0], v0[1]); w.y = pg8::cvt_pk_bf16(v0[2], v0[3]); w.z = pg8::cvt_pk_bf16(v1[0], v1[1]); w.w = pg8::cvt_pk_bf16(v1[2], v1[3]);
                    *(v4u*)(rowp + bj * 128) = w; } }
    } };
constexpr int TBL_OFF = MISC_OFF + 1024, TBL_CNT = MISC_OFF + 1536, TBL_TEXP = MISC_OFF + 2048;
struct MoeOrder { const LAS int* sOff; const LAS int* sCnt; const LAS int* sTexp; const int* tokidx; int nunits, NT, G, c;
    __device__ __forceinline__ bool next(int i, pg8::Unit& u) const { const int L = i * G + c; if (L >= nunits) return false; const int mt = L / NT; u.pm = mt; u.pn = NT * sTexp[mt] + (L - mt * NT); return true; }
    __device__ __forceinline__ unsigned a_voff(const pg8::Unit& u, int half, int R, int K) const { const int e = u.pn / NT, r = (u.pm - (sOff[e] >> 8)) * 256 + 128 * half + R; int tok = r;
        if (e < NE) { const int last = sCnt[e] - 1; tok = tokidx[e * M0 + (r < last ? r : last)]; }
        return (unsigned)tok * (unsigned)(K * 2); }
    __device__ __forceinline__ void a_ready(const pg8::Unit&) const {}
    __device__ __forceinline__ void done(const pg8::Unit&) const {} };
template <int LAYER> __device__ __forceinline__ MoeOrder moe_tables(const Ctx& C, int NT) {
    constexpr int ntok = LAYER ? M1 : M0; LAS int* sOff = (LAS int*)(C.lds + TBL_OFF); LAS int* sCnt = (LAS int*)(C.lds + TBL_CNT); LAS int* sTexp = (LAS int*)(C.lds + TBL_TEXP);
    const unsigned* cnt = WSP(const unsigned, WS_CTL) + (LAYER ? CW_CNT1 : CW_CNT0); const int tid = threadIdx.x;
    __syncthreads();
    if (tid < 64) {
        const int c = (int)__hip_atomic_load(cnt + tid, __ATOMIC_RELAXED, __HIP_MEMORY_SCOPE_AGENT); const int pad = (c + 255) & ~255; int inc = pad;
#pragma unroll
        for (int o = 1; o < 64; o <<= 1) { const int x = __shfl_up(inc, o); if (tid >= o) inc += x; }
        sCnt[tid] = c; sOff[tid] = inc - pad;
        if (tid == 63) { sOff[NE] = inc; sCnt[NE] = ntok; sOff[NE + 1] = inc + ntok; } }
    __syncthreads();
    if (tid <= NE) for (int mt = sOff[tid] >> 8; mt < (sOff[tid + 1] >> 8); ++mt) sTexp[mt] = tid;
    __syncthreads();
    const int cx = (C.G % 8 == 0) ? (C.bid % 8) * (C.G / 8) + C.bid / 8 : C.bid;
    return MoeOrder{sOff, sCnt, sTexp, WSP(const int, WS_TOK), (sOff[NE + 1] >> 8) * NT, NT, C.G, cx};
}

template <int LAYER> __device__ __forceinline__ void p_norm2_route(const Ctx& C0) { const Ctx C = phase_ctx(C0);
    constexpr int ntok = LAYER ? M1 : M0; constexpr int IL = LAYER ? I_L1 : I_L0, RW = LAYER ? O_RW : E_RW;
    LAS float* sH = (LAS float*)C.lds;
    LAS float* sPart = sH + 8 * D;
    LAS int* sHist = (LAS int*)(sPart + 8 * 8 * 64);
    LAS int* sBase = sHist + 64;
    LAS int* sSel = sBase + 64;
    constexpr int MAXIT = (ntok / 8 + 255) / 256 + 1;
    const float* X = WSP(const float, WS_X); bf16* H2 = WSP(bf16, WS_H2); unsigned* cnt = WSP(unsigned, WS_CTL) + (LAYER ? CW_CNT1 : CW_CNT0);
    int* TE = WSP(int, WS_ROUTE); int* TP = TE + M0 * TOPK; float* TW = (float*)(TP + M0 * TOPK);
    const float* rw = C.in[IL + RW]; const float* rb = C.in[IL + RW + 1]; const int lane = C.lane, wave = C.wave;
    if (C.tid < 64) sHist[C.tid] = 0;
    int slot = 0;
    for (int it = C.bid; it < ntok / 8; it += C.G, ++slot) { const int i = it * 8 + wave; int xr; if (LAYER) { const int b = i / SEQ; xr = b * TT + LCTX + (i - b * SEQ); } else xr = i;
        __syncthreads();
        { f32x4 v[8]; const float* x = X + (size_t)xr * D;
#pragma unroll
          for (int j = 0; j < 8; ++j) v[j] = *(const f32x4*)(x + 4 * lane + 256 * j);
          const float* md = mod_row(C, LAYER, xr); norm_mod_row(v, C.in[IL + N2], md + 3 * D, md + 4 * D, lane);
          store_row_bf16(H2 + (size_t)i * D, v, lane);
#pragma unroll
          for (int j = 0; j < 8; ++j) *(LAS f32x4*)(sH + wave * D + 4 * lane + 256 * j) = v[j]; }
        __syncthreads();
        { float acc[8] = {}; const int k0 = wave * 256;
          for (int k = 0; k < 256; k += 16) { float w[16];
#pragma unroll
              for (int q = 0; q < 16; ++q) w[q] = rw[(size_t)(k0 + k + q) * NE + lane];
#pragma unroll
              for (int q = 0; q < 16; q += 4)
#pragma unroll
                  for (int r = 0; r < 8; ++r) { const f32x4 hv = *(const LAS f32x4*)(sH + r * D + k0 + k + q); acc[r] += hv.x * w[q] + hv.y * w[q + 1] + hv.z * w[q + 2] + hv.w * w[q + 3]; } }
#pragma unroll
          for (int r = 0; r < 8; ++r) sPart[(wave * 8 + r) * 64 + lane] = acc[r]; }
        __syncthreads();
        { float s = 0.f;
#pragma unroll
          for (int w = 0; w < 8; ++w) s += sPart[(w * 8 + wave) * 64 + lane];
          const float score = 1.f / (1.f + expf(-s)); const float sel = score + rb[lane];
          float m1 = sel, m2 = -3e38f;
#pragma unroll
          for (int o = 1; o < 8; o <<= 1) { const float a1 = __shfl_xor(m1, o), a2 = __shfl_xor(m2, o); const float hi = fmaxf(m1, a1), lo = fminf(m1, a1); m2 = fmaxf(lo, fmaxf(m2, a2)); m1 = hi; }
          const float gs = m1 + m2;
          int grank = 0; const int g = lane >> 3;
#pragma unroll
          for (int q = 0; q < 8; ++q) { const float og = __builtin_bit_cast(float, __builtin_amdgcn_readlane(__builtin_bit_cast(int, gs), q * 8)); grank += (og > gs || (og == gs && q < g)) ? 1 : 0; }
          const float cand = grank < 4 ? sel : -3e38f;
          int erank = 0;
#pragma unroll
          for (int q = 0; q < 64; ++q) { const float oc = __builtin_bit_cast(float, __builtin_amdgcn_readlane(__builtin_bit_cast(int, cand), q)); erank += (oc > cand || (oc == cand && q < lane)) ? 1 : 0; }
          const int myj = (grank < 4 && erank < TOPK) ? erank : -1;
          float wsum = wave_sum(myj >= 0 ? score : 0.f);
          if (myj >= 0) { const float wgt = score / wsum * 2.5f;
              if (slot < MAXIT) { const int lr = atomicAdd((int*)&sHist[lane], 1); LAS int* q = sSel + ((slot * 8 + wave) * TOPK + myj) * 3; q[0] = lane; q[1] = lr; q[2] = __float_as_int(wgt); }
              else { const unsigned pos = atomicAdd(&cnt[lane], 1u); TE[(size_t)i * TOPK + myj] = lane; TP[(size_t)i * TOPK + myj] = (int)pos; WSP(int, WS_TOK)[(size_t)lane * M0 + pos] = i; TW[(size_t)i * TOPK + myj] = wgt; } } }
    }
    __syncthreads();
    if (C.tid < 64) { const int h = sHist[C.tid]; sBase[C.tid] = h ? (int)atomicAdd(&cnt[C.tid], (unsigned)h) : 0; }
    __syncthreads();
    { const int nslot = slot < MAXIT ? slot : MAXIT;
      for (int x = C.tid; x < nslot * 8 * TOPK; x += NTHR) { const int sl = x / (8 * TOPK), w8 = (x / TOPK) % 8, j = x % TOPK; const int i = (C.bid + sl * C.G) * 8 + w8;
          const LAS int* q = sSel + x * 3; const int e = q[0], pos = sBase[e] + q[1];
          TE[(size_t)i * TOPK + j] = e; TP[(size_t)i * TOPK + j] = pos; WSP(int, WS_TOK)[(size_t)e * M0 + pos] = i; TW[(size_t)i * TOPK + j] = __int_as_float(q[2]); } }
}
template <int LAYER> __device__ __forceinline__ void p_moe_combine(const Ctx& C0) { const Ctx C = phase_ctx(C0);
    constexpr int ntok = LAYER ? M1 : M0;
    const MoeOrder T = moe_tables<LAYER>(C, 1);
    const int* TE = WSP(const int, WS_ROUTE); const int* TP = TE + M0 * TOPK; const float* TW = (const float*)(WSP(const int, WS_ROUTE) + 2 * M0 * TOPK);
    const bf16* Y = WSP(const bf16, WS_Y); const bf16* YS = Y + (size_t)T.sOff[NE] * D; float* X = WSP(float, WS_X);
    const int gw = C.bid * NWAVES + C.wave, NGW = C.G * NWAVES, lane = C.lane;
    for (int i = gw; i < ntok; i += NGW) { int xr; if (LAYER) { const int b = i / SEQ; xr = b * TT + LCTX + (i - b * SEQ); } else xr = i;
        f32x4 acc[8];
#pragma unroll
        for (int j = 0; j < 8; ++j) { const v2u a = *(const v2u*)(YS + (size_t)i * D + 4 * lane + 256 * j); acc[j] = (f32x4){bf2f(a.x & 0xffffu), bf2f(a.x >> 16), bf2f(a.y & 0xffffu), bf2f(a.y >> 16)}; }
#pragma unroll 2
        for (int s = 0; s < TOPK; ++s) { const float w = TW[(size_t)i * TOPK + s]; const bf16* yr = Y + (size_t)(T.sOff[TE[(size_t)i * TOPK + s]] + TP[(size_t)i * TOPK + s]) * D;
#pragma unroll
            for (int j = 0; j < 8; ++j) { const v2u a = *(const v2u*)(yr + 4 * lane + 256 * j); acc[j] += (f32x4){bf2f(a.x & 0xffffu), bf2f(a.x >> 16), bf2f(a.y & 0xffffu), bf2f(a.y >> 16)} * w; } }
        const float* gate = mod_row(C, LAYER, xr) + 5 * D; f32x4 v[8];
#pragma unroll
        for (int j = 0; j < 8; ++j) { const int c = 4 * lane + 256 * j; v[j] = *(const f32x4*)(X + (size_t)xr * D + c) + *(const f32x4*)(gate + c) * acc[j]; }
        if (LAYER) {
#pragma unroll
            for (int j = 0; j < 8; ++j) *(f32x4*)(C.out + (size_t)i * D + 4 * lane + 256 * j) = v[j]; }
        else {
#pragma unroll
            for (int j = 0; j < 8; ++j) *(f32x4*)(X + (size_t)xr * D + 4 * lane + 256 * j) = v[j];
            const float* md = mod_row(C, 1, xr); norm_mod_row(v, C.in[I_L1 + N1], md + 0 * D, md + 1 * D, lane); store_row_bf16(WSP(bf16, WS_HB) + (size_t)xr * D, v, lane); } }
}

__device__ __forceinline__ int slack_slots(int nunits, int G, int c) { const int maxr = (nunits + G - 1) / G, mine = nunits > c ? (nunits - c - 1) / G + 1 : 0; return maxr - mine; }
constexpr int NPHASE = 21;
struct Args { const float* in[43]; float* out; unsigned char* ws; int ph_lo, ph_hi, li, pad; };
__global__ void __launch_bounds__(NTHR, 2) fwd_kernel(Args args) {
    extern __shared__ __attribute__((aligned(16))) unsigned char lds_raw[];
    Ctx C; C.lds = (LAS unsigned char*)lds_raw; C.in = args.in; C.out = args.out; C.ws = args.ws;
    C.tid = threadIdx.x; C.lane = C.tid & 63; C.wave = __builtin_amdgcn_readfirstlane(C.tid >> 6); C.G = gridDim.x; C.bid = blockIdx.x;
    volatile LAS unsigned* MISC = (volatile LAS unsigned*)(C.lds + MISC_OFF);
    if (C.tid < 64) MISC[C.tid] = 0u;
    __syncthreads();
    const int lo = args.ph_lo, hi = args.ph_hi; const bool one = (hi - lo) > 1;
    XcdBarrier bar; bar.bar = WSP(unsigned, WS_CTL) + CW_BAR + args.li * XCD_BAR_WORDS; bar.x = 0; bar.st = nullptr;
    if (one) bar = xcd_barrier_post(WSP(unsigned, WS_CTL) + CW_BAR + args.li * XCD_BAR_WORDS, MISC + 8);
#ifndef PHASE_MASK
#define PHASE_MASK 0x1fffff
#endif
#define IN(k) (((PHASE_MASK >> (k)) & 1) && lo <= (k) && (k) < hi)
#define SEAM(k) do { if (IN(k) && IN((k) + 1)) xcd_barrier(bar); } while (0)
    LAS unsigned char* ring = C.lds;
#ifndef PROBE_REP0
#define PROBE_REP0 1
#endif
    if (IN(0)) { for (int rep = 0; rep < PROBE_REP0; ++rep) { p0_prologue(C); __syncthreads(); } } SEAM(0);
    if (IN(1)) { p_norm1_l0(C); } SEAM(1);
    if (IN(2)) { pg8::Gemm g{WSP(const bf16, WS_HB), WSP(const bf16, WS_WIN0), M0, NIN0P, D}; pg8::StaticOrder S; S.init(M0, NIN0P, C.G, C.bid);
        pg8::EpiBf16<0> E{WSP(bf16, WS_PROJ), NIN0P, nullptr, 0, 0}; pg8::gemm_phase<pg8::EpiBf16<0>, pg8::StaticOrder>(ring, g, S, E, nullptr);
        convert_chunks(C, 2 * slack_slots((M0 / 256) * (NIN0P / 256), C.G, C.bid)); } SEAM(2);
    if (IN(3)) { p_prep_l0(C); } SEAM(3);
    #ifndef PROBE_REP4
#define PROBE_REP4 1
#endif
    if (IN(4)) { for (int rep = 0; rep < PROBE_REP4; ++rep) { p_mlstm_l0(C); p_na_l0(C, rep); __syncthreads(); } } SEAM(4);
    if (IN(5)) { p_mlfin_l0(C); } SEAM(5);
    if (IN(6)) { pg8::Gemm g{WSP(const bf16, WS_AO), WSP(const bf16, WS_WOUT0), M0, D, D}; pg8::StaticOrder S; S.init(M0, D, C.G, C.bid);
        EpiResid<0> E{C}; pg8::gemm_phase<EpiResid<0>, pg8::StaticOrder>(ring, g, S, E, nullptr);
        convert_chunks(C, 2 * slack_slots((M0 / 256) * (D / 256), C.G, C.bid)); } SEAM(6);
    if (IN(7)) { p_norm2_route<0>(C); } SEAM(7);
    if (IN(9)) { const MoeOrder S = moe_tables<0>(C, 4); pg8::Gemm g{WSP(const bf16, WS_H2), WSP(const bf16, WS_W1T), M0, 65 * 1024, D}; EpiSwiglu E{WSP(bf16, WS_ACT)};
        pg8::gemm_phase_g<EpiSwiglu, MoeOrder>(ring, g, S, E, nullptr); convert_chunks(C, 2 * slack_slots(S.nunits, C.G, S.c)); } SEAM(9);
    if (IN(10)) { const MoeOrder S = moe_tables<0>(C, 8); pg8::Gemm g{WSP(const bf16, WS_ACT), WSP(const bf16, WS_W2T), RMAX + M0, 65 * 2048, DE}; EpiBf16Mod E{WSP(bf16, WS_Y), D, 7};
        pg8::gemm_phase<EpiBf16Mod, MoeOrder>(ring, g, S, E, nullptr); convert_chunks(C, slack_slots(S.nunits, C.G, S.c)); } SEAM(10);
    if (IN(11)) { p_moe_combine<0>(C); } SEAM(11);
    if (IN(12)) { pg8::Gemm g{WSP(const bf16, WS_HB), WSP(const bf16, WS_WIN1), M0, NIN1, D}; pg8::StaticOrder S; S.init(M0, NIN1, C.G, C.bid);
        pg8::EpiBf16<0> E{WSP(bf16, WS_PROJ), NIN1, nullptr, 0, 0}; pg8::gemm_phase<pg8::EpiBf16<0>, pg8::StaticOrder>(ring, g, S, E, nullptr);
        convert_chunks(C, 2 * slack_slots((M0 / 256) * (NIN1 / 256), C.G, C.bid)); } SEAM(12);
    if (IN(13)) { p_prep_l1(C); } SEAM(13);
    if (IN(14)) { p_da_l1(C); } SEAM(14);
    if (IN(15)) { pg8::Gemm g{WSP(const bf16, WS_AO), WSP(const bf16, WS_WOUT1), M1, D, D}; pg8::StaticOrder S; S.init(M1, D, C.G, C.bid);
        EpiResid<1> E{C}; pg8::gemm_phase<EpiResid<1>, pg8::StaticOrder>(ring, g, S, E, nullptr); } SEAM(15);
    if (IN(16)) { p_norm2_route<1>(C); convert_chunks(C, 1 << 30); } SEAM(16);
    if (IN(18)) { const MoeOrder S = moe_tables<1>(C, 4); pg8::Gemm g{WSP(const bf16, WS_H2), WSP(const bf16, WS_W1T) + (size_t)65 * 1024 * D, M1, 65 * 1024, D}; EpiSwiglu E{WSP(bf16, WS_ACT)};
        pg8::gemm_phase_g<EpiSwiglu, MoeOrder>(ring, g, S, E, nullptr); } SEAM(18);
    if (IN(19)) { const MoeOrder S = moe_tables<1>(C, 8); pg8::Gemm g{WSP(const bf16, WS_ACT), WSP(const bf16, WS_W2T) + (size_t)65 * D * DE, RMAX + M1, 65 * 2048, DE}; EpiBf16Mod E{WSP(bf16, WS_Y), D, 7};
        pg8::gemm_phase<EpiBf16Mod, MoeOrder>(ring, g, S, E, nullptr); } SEAM(19);
    if (IN(20)) { p_moe_combine<1>(C); }
#undef IN
#undef SEAM
}
#ifndef MK_ONE_LAUNCH
#define MK_ONE_LAUNCH 1
#endif
extern "C" void kernel_launch(void* const* d_in, const int* in_sizes, int n_in, void* d_out, int out_size, void* d_ws, size_t ws_size, hipStream_t stream) {
    static int grid = 0;
    if (grid == 0) {
        if (n_in != 43 || out_size != M1 * D || ws_size < WS_END) { fprintf(stderr, "kernel_launch: unexpected problem shape (n_in %d out %d ws %zu)\n", n_in, out_size, ws_size); grid = -1; return; }
        int dev = 0, cus = 0, per_cu = 0;
        if (hipGetDevice(&dev) != hipSuccess || hipDeviceGetAttribute(&cus, hipDeviceAttributeMultiprocessorCount, dev) != hipSuccess) { grid = -1; return; }
        if (hipFuncSetAttribute((const void*)fwd_kernel, hipFuncAttributeMaxDynamicSharedMemorySize, LDS_BYTES) != hipSuccess) { fprintf(stderr, "kernel_launch: hipFuncSetAttribute failed\n"); grid = -1; return; }
        if (hipOccupancyMaxActiveBlocksPerMultiprocessor(&per_cu, (const void*)fwd_kernel, NTHR, LDS_BYTES) != hipSuccess || per_cu < 1) { fprintf(stderr, "kernel_launch: occupancy query says %d workgroups per CU\n", per_cu); grid = -1; (void)hipGetLastError(); return; }
        grid = cus;
    }
    if (grid < 0) return;
    if (hipMemsetAsync((char*)d_ws + WS_CTL, 0, CTL_BYTES, stream) != hipSuccess) return;
    Args a{}; for (int i = 0; i < 43; ++i) a.in[i] = (const float*)d_in[i]; a.out = (float*)d_out; a.ws = (unsigned char*)d_ws;
#if defined(PROBE_LO)
    a.ph_lo = 0; a.ph_hi = PROBE_HI; a.li = 0; hipLaunchKernelGGL(fwd_kernel, dim3(grid), dim3(NTHR), LDS_BYTES, stream, a);
    a.ph_lo = PROBE_LO; a.ph_hi = NPHASE; a.li = 1; hipLaunchKernelGGL(fwd_kernel, dim3(grid), dim3(NTHR), LDS_BYTES, stream, a);
#elif MK_ONE_LAUNCH
    a.ph_lo = 0; a.ph_hi = NPHASE; hipLaunchKernelGGL(fwd_kernel, dim3(grid), dim3(NTHR), LDS_BYTES, stream, a);
#else
    for (int p = 0; p < NPHASE; ++p) { a.ph_lo = p; a.ph_hi = p + 1; hipLaunchKernelGGL(fwd_kernel, dim3(grid), dim3(NTHR), LDS_BYTES, stream, a); }
#endif
}
```
